# Optimizing an MI355X kernel written in HIP

```python
import math
import jax, jax.numpy as jnp
from jax import lax
import numpy as np

D_MODEL = 2048
BATCH = 2
SEQ = 16384
DEPTH = 1

HEAD_DIM = 64
N_Q_HEADS = (3 * D_MODEL // 4) // HEAD_DIM
N_KV_HEADS = max(1, N_Q_HEADS // 8)
Q_PER_KV = N_Q_HEADS // N_KV_HEADS
ATTN_WIDTH = N_Q_HEADS * HEAD_DIM
KV_WIDTH = N_KV_HEADS * HEAD_DIM
WINDOW = 128
BLOCK = 128
SSM_GROUP = 16
SSM_WIDTH = D_MODEL - ATTN_WIDTH
N_SSM_GROUPS = SSM_WIDTH // SSM_GROUP
STATE = 64
SSM_CHUNK = 128
DT_MIN = 1e-3
DT_MAX = 1e-1
MIX_WIDTH = ATTN_WIDTH + SSM_WIDTH
IN_WIDTH = 2 * ATTN_WIDTH + 2 * KV_WIDTH + 2 * SSM_WIDTH
SPLITS = (ATTN_WIDTH,
          ATTN_WIDTH + KV_WIDTH,
          ATTN_WIDTH + 2 * KV_WIDTH,
          2 * ATTN_WIDTH + 2 * KV_WIDTH,
          2 * ATTN_WIDTH + 2 * KV_WIDTH + SSM_WIDTH)
EPS = 1e-5

kernel_name = 'hybrid_swa_sink_s5_parallel_heads'


def rms_norm(x, gain):
    xf = x.astype(jnp.float32)
    var = jnp.mean(xf * xf, axis=-1, keepdims=True)
    return (xf * lax.rsqrt(var + EPS) * gain.astype(jnp.float32)).astype(x.dtype)


def sliding_window_attention(q, k, v, sinks):
    b, s, _ = q.shape
    nb = s // BLOCK
    q = q.reshape(b, nb, BLOCK, N_KV_HEADS, Q_PER_KV, HEAD_DIM) * (HEAD_DIM ** -0.5)
    k = k.reshape(b, nb, BLOCK, N_KV_HEADS, HEAD_DIM)
    v = v.reshape(b, nb, BLOCK, N_KV_HEADS, HEAD_DIM)
    pad = ((0, 0), (1, 0), (0, 0), (0, 0), (0, 0))
    k_band = jnp.concatenate([jnp.pad(k[:, :-1], pad), k], axis=2)
    v_band = jnp.concatenate([jnp.pad(v[:, :-1], pad), v], axis=2)
    qi = jnp.arange(BLOCK)[:, None]
    kj = jnp.arange(2 * BLOCK)[None, :]
    rel = kj - BLOCK - qi
    band = (rel <= 0) & (rel > -WINDOW)
    sink_logits = sinks.astype(jnp.float32).reshape(N_KV_HEADS, Q_PER_KV)

    def block_fn(args):
        qb, kb, vb, blk = args
        mask = band & ((blk > 0) | (kj >= BLOCK))
        scores = jnp.einsum('bqhgd,bkhd->bhgqk', qb.astype(jnp.float32), kb.astype(jnp.float32))
        scores = jnp.where(mask, scores, -jnp.inf)
        sink = jnp.broadcast_to(sink_logits[None, :, :, None, None], scores.shape[:-1] + (1,))
        probs = jax.nn.softmax(jnp.concatenate([scores, sink], axis=-1), axis=-1)[..., :-1]
        return jnp.einsum('bhgqk,bkhd->bqhgd', probs.astype(vb.dtype), vb)

    out = lax.map(block_fn, (jnp.moveaxis(q, 1, 0), jnp.moveaxis(k_band, 1, 0),
                             jnp.moveaxis(v_band, 1, 0), jnp.arange(nb)))
    return jnp.moveaxis(out, 0, 1).reshape(b, s, ATTN_WIDTH)


def _complex_affine_combine(e1, e2):
    a1r, a1i, b1r, b1i = e1
    a2r, a2i, b2r, b2i = e2
    return (a2r * a1r - a2i * a1i,
            a2r * a1i + a2i * a1r,
            a2r * b1r - a2i * b1i + b2r,
            a2r * b1i + a2i * b1r + b2i)


def s5_ssm(u, lam_re, lam_im, log_step, b_re, b_im, c_re, c_im, d_skip):
    f32 = jnp.float32
    bsz, s, _ = u.shape
    uf = u.astype(f32).reshape(bsz, s, N_SSM_GROUPS, SSM_GROUP)
    lr, li = lam_re.astype(f32), lam_im.astype(f32)
    step = jnp.exp(log_step.astype(f32))[:, None]
    decay = jnp.exp(lr * step)
    abar_re, abar_im = decay * jnp.cos(li * step), decay * jnp.sin(li * step)
    den = lr * lr + li * li
    nr, ni = abar_re - 1.0, abar_im
    coef_re = (nr * lr + ni * li) / den
    coef_im = (ni * lr - nr * li) / den
    br, bi = b_re.astype(f32), b_im.astype(f32)
    bbar_re = coef_re[..., None] * br - coef_im[..., None] * bi
    bbar_im = coef_re[..., None] * bi + coef_im[..., None] * br
    cr, ci = c_re.astype(f32), c_im.astype(f32)
    nc = s // SSM_CHUNK
    u_chunks = jnp.moveaxis(uf.reshape(bsz, nc, SSM_CHUNK, N_SSM_GROUPS, SSM_GROUP), 1, 0)
    a_re = jnp.broadcast_to(abar_re, (bsz, SSM_CHUNK, N_SSM_GROUPS, STATE))
    a_im = jnp.broadcast_to(abar_im, (bsz, SSM_CHUNK, N_SSM_GROUPS, STATE))

    def chunk_fn(carry, uc):
        h0r, h0i = carry
        bu_re = jnp.einsum('btgc,gpc->btgp', uc, bbar_re)
        bu_im = jnp.einsum('btgc,gpc->btgp', uc, bbar_im)
        acc_r, acc_i, hr, hi = lax.associative_scan(
            _complex_affine_combine, (a_re, a_im, bu_re, bu_im), axis=1)
        hr, hi = (hr + acc_r * h0r[:, None] - acc_i * h0i[:, None],
                  hi + acc_r * h0i[:, None] + acc_i * h0r[:, None])
        y = jnp.einsum('btgp,gcp->btgc', hr, cr) - jnp.einsum('btgp,gcp->btgc', hi, ci)
        return (hr[:, -1], hi[:, -1]), y

    init = (jnp.zeros((bsz, N_SSM_GROUPS, STATE), f32), jnp.zeros((bsz, N_SSM_GROUPS, STATE), f32))
    _, y = lax.scan(chunk_fn, init, u_chunks)
    y = jnp.moveaxis(y, 0, 1).reshape(bsz, s, N_SSM_GROUPS, SSM_GROUP)
    y = y + d_skip.astype(f32).reshape(N_SSM_GROUPS, SSM_GROUP) * uf
    return y.reshape(bsz, s, SSM_WIDTH).astype(u.dtype)


def hybrid_layer(x, c, w_ada, b_ada, norm_gain, w_in, b_in, attn_sinks, attn_out_gain,
                 lam_re, lam_im, log_step, b_re, b_im, c_re, c_im, d_skip,
                 glu_w, glu_b, ssm_out_gain, w_out):
    mod = jax.nn.silu(c.astype(jnp.float32)) @ w_ada.astype(jnp.float32) + b_ada.astype(jnp.float32)
    shift, scale, gate = jnp.split(mod, 3, axis=-1)
    h = (rms_norm(x, norm_gain) * (1.0 + scale[:, None]) + shift[:, None]).astype(x.dtype)
    proj = h @ w_in + b_in
    q, k, v, z_attn, u_ssm, z_ssm = jnp.split(proj, SPLITS, axis=-1)
    attn = sliding_window_attention(q, k, v, attn_sinks)
    attn = rms_norm(attn, attn_out_gain) * jax.nn.silu(z_attn)
    ssm = jax.nn.gelu(s5_ssm(u_ssm, lam_re, lam_im, log_step, b_re, b_im, c_re, c_im, d_skip), approximate=False)
    ssm = ssm * jax.nn.sigmoid(ssm @ glu_w + glu_b)
    ssm = rms_norm(ssm, ssm_out_gain) * jax.nn.silu(z_ssm)
    mixed = jnp.concatenate([attn, ssm], axis=-1)
    out = mixed @ w_out
    return (x + gate[:, None].astype(x.dtype) * out).astype(x.dtype)


def setup_inputs(seed: int = 0) -> dict:
    key = jax.random.key(seed)
    ks = jax.random.split(key, 24)
    f32 = jnp.float32
    L, D, G, P = DEPTH, D_MODEL, N_SSM_GROUPS, STATE
    nrm = lambda k, shp, s: jax.random.normal(k, shp, f32) * s
    lam_im = jnp.broadcast_to(math.pi * jnp.arange(P, dtype=f32), (L, G, P))
    return {
        'x': nrm(ks[0], (BATCH, SEQ, D), 1.0),
        'c': nrm(ks[1], (BATCH, D), 1.0),
        'w_ada': nrm(ks[2], (L, D, 3 * D), 0.5 * D ** -0.5),
        'b_ada': nrm(ks[3], (L, 3 * D), 0.01),
        'norm_gain': 1.0 + nrm(ks[4], (L, D), 0.01),
        'w_in': nrm(ks[5], (L, D, IN_WIDTH), D ** -0.5),
        'b_in': nrm(ks[6], (L, IN_WIDTH), 0.01),
        'attn_sinks': nrm(ks[7], (L, N_Q_HEADS), 1.0),
        'attn_out_gain': 1.0 + nrm(ks[8], (L, ATTN_WIDTH), 0.01),
        'ssm_lambda_re': -0.5 + nrm(ks[9], (L, G, P), 0.01),
        'ssm_lambda_im': lam_im + 0.0 * nrm(ks[10], (L, G, P), 1.0) if False else lam_im + nrm(ks[10], (L, G, P), 0.01),
        'ssm_log_step': jax.random.uniform(ks[11], (L, G), f32, math.log(DT_MIN), math.log(DT_MAX)),
        'ssm_b_re': nrm(ks[12], (L, G, P, SSM_GROUP), (2 * SSM_GROUP) ** -0.5),
        'ssm_b_im': nrm(ks[13], (L, G, P, SSM_GROUP), (2 * SSM_GROUP) ** -0.5),
        'ssm_c_re': nrm(ks[14], (L, G, SSM_GROUP, P), P ** -0.5),
        'ssm_c_im': nrm(ks[15], (L, G, SSM_GROUP, P), P ** -0.5),
        'ssm_d': nrm(ks[16], (L, SSM_WIDTH), 1.0),
        'glu_w': nrm(ks[17], (L, SSM_WIDTH, SSM_WIDTH), SSM_WIDTH ** -0.5),
        'glu_b': nrm(ks[18], (L, SSM_WIDTH), 0.01),
        'ssm_out_gain': 1.0 + nrm(ks[19], (L, SSM_WIDTH), 0.01),
        'w_out': nrm(ks[20], (L, MIX_WIDTH, D), MIX_WIDTH ** -0.5),
        'final_gain': 1.0 + nrm(ks[21], (D,), 0.01),
    }


def reference(x, c, w_ada, b_ada, norm_gain, w_in, b_in, attn_sinks, attn_out_gain,
              ssm_lambda_re, ssm_lambda_im, ssm_log_step, ssm_b_re, ssm_b_im,
              ssm_c_re, ssm_c_im, ssm_d, glu_w, glu_b, ssm_out_gain, w_out, final_gain):
    h = x
    for l in range(DEPTH):
        h = hybrid_layer(h, c, w_ada[l], b_ada[l], norm_gain[l], w_in[l], b_in[l],
                         attn_sinks[l], attn_out_gain[l],
                         ssm_lambda_re[l], ssm_lambda_im[l], ssm_log_step[l],
                         ssm_b_re[l], ssm_b_im[l], ssm_c_re[l], ssm_c_im[l], ssm_d[l],
                         glu_w[l], glu_b[l], ssm_out_gain[l], w_out[l])
    return rms_norm(h, final_gain)
```

```cpp
#include <hip/hip_runtime.h>
#include <hip/hip_cooperative_groups.h>
#include <cstdio>
#include <cstdint>
namespace cg = cooperative_groups;
#define MK_ONE_LAUNCH 1
namespace pg8 {
#define PG8_LAS __attribute__((address_space(3)))
typedef unsigned short bf16_t;
typedef short bf16x8 __attribute__((ext_vector_type(8)));
typedef float f32x4 __attribute__((ext_vector_type(4)));
typedef unsigned u32x4 __attribute__((ext_vector_type(4)));
constexpr int BM = 256, BK = 64, HALF = 128, HTB = HALF * BK * 2  , STAGE_BYTES = 8 * HTB, NXCD = 8, WGM = 8;

__host__ __device__ __forceinline__ int lds_byte(int r, int c) { const int st = (r >> 4) * 2 + (c >> 5), rr = r & 15, cc = c & 31, ob = rr * 64 + cc * 2; return st * 1024 + (ob ^ (((ob >> 9) & 1) << 5)); }
__host__ __device__ __forceinline__ void stage_rc(int b, int& R, int& C) { const int st = b / 1024, sb = b % 1024, swz = sb ^ (((sb >> 9) & 1) << 5); R = (st >> 1) * 16 + swz / 64; C = (st & 1) * 32 + (swz % 64) / 2; }
__host__ __device__ __forceinline__ int perm32(int rho) { const int n = rho >> 4, i = rho & 15; return 8 * (i >> 2) + 4 * n + (i & 3); }

struct Unit { int pm, pn; };
struct Gemm { const bf16_t* A; const bf16_t* Bt; int M, N, K; };

struct StaticOrder {
    int nM, nN, nwg, G, c;
    __host__ __device__ void init(int M, int N, int G_, int c_) { nM = M / BM; nN = N / BM; nwg = nM * nN; G = G_; c = c_; }
    __host__ __device__ bool next(int i, Unit& u) const {
        const long L = (long)i * G + c; if (L >= nwg) return false;
        int wgid = (int)L; { const int q = nwg / NXCD, r = nwg % NXCD, xcd = wgid % NXCD, off = wgid / NXCD; wgid = (xcd < r ? xcd * (q + 1) : r * (q + 1) + (xcd - r) * q) + off; }
        const int nig = WGM * nN, gid = wgid / nig, fm = gid * WGM, gsz = (nM - fm) < WGM ? (nM - fm) : WGM;
        u.pm = fm + ((wgid % nig) % gsz); u.pn = (wgid % nig) / gsz; return true;
    }
    __device__ __forceinline__ void a_ready(const Unit&) const {}
    __device__ __forceinline__ void done(const Unit&) const {}
};

__device__ __forceinline__ unsigned cvt_pk_bf16(float lo, float hi) { unsigned r; asm volatile("v_cvt_pk_bf16_f32 %0, %1, %2" : "=v"(r) : "v"(lo), "v"(hi)); return r; }
#ifdef DBG_STAGE
#define DBG_MIX(x) ((f32x4){0.f, 0.f, 0.f, 0.f})
#else
#define DBG_MIX(x) (x)
#endif
typedef unsigned u32x4 __attribute__((ext_vector_type(4)));
__device__ __forceinline__ float silu_f(float v) { return v * __builtin_amdgcn_rcpf(1.0f + __builtin_amdgcn_exp2f(-1.4426950408889634f * v)); }
struct EpiProj {
    static constexpr bool PERM = true, AFTER_DRAIN = false, XCHG = false;
    bf16_t* O; int ldc; const float* bias; float qscale;
    __device__ __forceinline__ void operator()(const f32x4 (&acc)[2][2][4][2], const Unit& u, int wr, int wc, int fr, int fq) const {
        asm volatile("" : "+v"(fr), "+v"(fq));
        const int row0 = u.pm * BM + wr * 64 + fr; const int pn = u.pn;
        const int mode = (pn < 6) ? 1 : (((pn >= 8 && pn < 14) || pn >= 16) ? 2 : 0);
        const float sc = mode == 1 ? qscale : 1.f;
        const int col0 = pn * BM + wc * 32 + 8 * fq;
        f32x4 bv[2][2];
#pragma unroll
        for (int bj = 0; bj < 2; ++bj)
#pragma unroll
            for (int n = 0; n < 2; ++n) bv[bj][n] = *(const f32x4*)(bias + col0 + bj * HALF + 4 * n);
#pragma unroll
        for (int ai = 0; ai < 2; ++ai)
#pragma unroll
            for (int m = 0; m < 4; ++m) { bf16_t* rowp = O + (size_t)(row0 + ai * HALF + m * 16) * ldc + col0;
#pragma unroll
                for (int bj = 0; bj < 2; ++bj) { f32x4 v0 = acc[ai][bj][m][0] + bv[bj][0], v1 = acc[ai][bj][m][1] + bv[bj][1];
                    if (mode == 2) {
#pragma unroll
                        for (int e = 0; e < 4; ++e) { v0[e] = silu_f(v0[e]); v1[e] = silu_f(v1[e]); } }
                    v0 = v0 * sc; v1 = v1 * sc; u32x4 w; w.x = cvt_pk_bf16(v0[0], v0[1]); w.y = cvt_pk_bf16(v0[2], v0[3]); w.z = cvt_pk_bf16(v1[0], v1[1]); w.w = cvt_pk_bf16(v1[2], v1[3]);
                    *(u32x4*)(rowp + bj * HALF) = w; } }
    }
};
struct EpiOut {
    static constexpr bool PERM = true, AFTER_DRAIN = false, XCHG = false;
    const float* x; float* out; const float* gate; const float* ssqa; float* ssqo; int M_, ldc, seq;
    __device__ __forceinline__ void operator()(const f32x4 (&acc)[2][2][4][2], const Unit& u, int wr, int wc, int fr, int fq) const {
        const int col0 = u.pn * BM + wc * 32 + 8 * fq; const int batch = (u.pm * BM) / seq;
        f32x4 gv[2][2];
#pragma unroll
        for (int bj = 0; bj < 2; ++bj)
#pragma unroll
            for (int n = 0; n < 2; ++n) gv[bj][n] = *(const f32x4*)(gate + batch * ldc + col0 + bj * HALF + n * 4);
#pragma unroll
        for (int ai = 0; ai < 2; ++ai)
#pragma unroll
            for (int m = 0; m < 4; ++m) { const int row = u.pm * BM + ai * HALF + wr * 64 + m * 16 + fr; const size_t off = (size_t)row * ldc + col0; float ss = 0.f;
                const float ra = __builtin_amdgcn_rsqf(((ssqa[row] + ssqa[M_ + row]) + ssqa[2 * M_ + row]) * (1.0f / 1536.0f) + 1e-5f);
#pragma unroll
                for (int bj = 0; bj < 2; ++bj)
#pragma unroll
                    for (int n = 0; n < 2; ++n) { const f32x4 xv = *(const f32x4*)(x + off + bj * HALF + n * 4); const f32x4 y = xv + DBG_MIX(gv[bj][n] * (acc[ai][bj][m][n] * ra));
                        *(f32x4*)(out + off + bj * HALF + n * 4) = y; ss += (y[0] * y[0] + y[1] * y[1]) + (y[2] * y[2] + y[3] * y[3]); }
                ss += __shfl_xor(ss, 16); ss += __shfl_xor(ss, 32);
                if (fq == 0) ssqo[(size_t)(u.pn * 4 + wc) * M_ + row] = ss;
                asm volatile("" ::: "memory"); }
    }
};

struct OutOrder {
    int c;
    __device__ __forceinline__ bool next(int i, Unit& u) const { if (i >= 4) return false; const int x = c & 7, j = c >> 3; u.pm = (i * 8 + x) * 4 + (j >> 3); u.pn = j & 7; return true; }
    __device__ __forceinline__ void a_ready(const Unit&) const {}
    __device__ __forceinline__ void done(const Unit&) const {}
};
struct EpiOutFused {
    static constexpr bool PERM = true, AFTER_DRAIN = false, XCHG = true;
    __device__ __forceinline__ void touch(int pm, int pn, int tid) const {
        asm volatile("" : "+v"(tid));
        const unsigned o = (unsigned)((pm * BM + (tid >> 3)) * ldc + pn * BM + (tid & 7) * 32), st = 64u * (unsigned)ldc;
        const float t = (x[o] + x[o + st]) + (x[o + 2u * st] + x[o + 3u * st]);
        if (t == 1.2345678e-33f) out[0] = t;
    }
    const float* x; float* out; const float* gate; const float* ssqa; const float* fgain; float* slots; unsigned* cnt; int M_, ldc, seq;
    __device__ __forceinline__ void xchg(f32x4 (&acc)[2][2][4][2], const Unit& u, int wr, int wc, int fr, int fq, PG8_LAS unsigned char* xl, int wid, int lane) const {
        asm volatile("" : "+v"(fr), "+v"(fq), "+v"(lane));
        PG8_LAS float* P = (PG8_LAS float*)xl;
        PG8_LAS float* S = (PG8_LAS float*)(xl + 4096);
        asm volatile("" ::: "memory");
        const int col0 = u.pn * BM + wc * 32 + 8 * fq; const int batch = (u.pm * BM) / seq;
        {
            f32x4 gv[2][2];
#pragma unroll
            for (int bj = 0; bj < 2; ++bj)
#pragma unroll
                for (int n = 0; n < 2; ++n) gv[bj][n] = *(const f32x4*)(gate + batch * ldc + col0 + bj * HALF + n * 4);
#pragma unroll
            for (int ai = 0; ai < 2; ++ai)
#pragma unroll
                for (int m = 0; m < 4; ++m) { const int lrow = ai * HALF + wr * 64 + m * 16 + fr, row = u.pm * BM + lrow; const size_t off = (size_t)row * ldc + col0; float ss = 0.f;
                    const float ra = __builtin_amdgcn_rsqf(((ssqa[row] + ssqa[M_ + row]) + ssqa[2 * M_ + row]) * (1.0f / 1536.0f) + 1e-5f);
#pragma unroll
                    for (int bj = 0; bj < 2; ++bj)
#pragma unroll
                        for (int n = 0; n < 2; ++n) { const f32x4 xv = *(const f32x4*)(x + off + bj * HALF + n * 4); const f32x4 y = xv + gv[bj][n] * (acc[ai][bj][m][n] * ra);
                            acc[ai][bj][m][n] = y; ss += (y[0] * y[0] + y[1] * y[1]) + (y[2] * y[2] + y[3] * y[3]); }
                    ss += __shfl_xor(ss, 16); ss += __shfl_xor(ss, 32);
                    if (fq == 0) P[lrow * 4 + wc] = ss;
                    asm volatile("" ::: "memory"); }
        }
        asm volatile("s_waitcnt lgkmcnt(0)" ::: "memory"); __builtin_amdgcn_s_barrier(); asm volatile("" ::: "memory");
        const int tid = wid * 64 + lane;
        if (wid < 4) {
            const float s = (P[tid * 4 + 0] + P[tid * 4 + 1]) + (P[tid * 4 + 2] + P[tid * 4 + 3]);
            __hip_atomic_store(slots + ((size_t)(u.pm * BM + tid) * 8 + u.pn), s, __ATOMIC_RELAXED, __HIP_MEMORY_SCOPE_AGENT);
            asm volatile("s_waitcnt vmcnt(0)" ::: "memory");
            if (lane == 0) __hip_atomic_fetch_add(cnt + 64 * u.pm, 1u, __ATOMIC_RELAXED, __HIP_MEMORY_SCOPE_AGENT);
        }
        if (wid == 0) {
            unsigned sp = 0;
            while ((unsigned)__builtin_amdgcn_readfirstlane(__hip_atomic_load(cnt + 64 * u.pm, __ATOMIC_RELAXED, __HIP_MEMORY_SCOPE_AGENT)) < 32u) { __builtin_amdgcn_s_sleep(2); if (++sp > (1u << 22)) break; }
            __builtin_amdgcn_fence(__ATOMIC_ACQUIRE, "agent");
        }
        asm volatile("s_waitcnt vmcnt(0) lgkmcnt(0)" ::: "memory"); __builtin_amdgcn_s_barrier(); asm volatile("" ::: "memory");
        if (wid < 4) {
            const float* sl = slots + (size_t)(u.pm * BM + tid) * 8; float t = 0.f;
#pragma unroll
            for (int k = 0; k < 8; ++k) t += __hip_atomic_load(sl + k, __ATOMIC_RELAXED, __HIP_MEMORY_SCOPE_AGENT);
            S[tid] = __builtin_amdgcn_rsqf(t * (1.0f / 2048.0f) + 1e-5f);
        }
        asm volatile("s_waitcnt lgkmcnt(0)" ::: "memory"); __builtin_amdgcn_s_barrier(); asm volatile("" ::: "memory");
#pragma unroll
        for (int ai = 0; ai < 2; ++ai)
#pragma unroll
            for (int m = 0; m < 4; ++m) { const int lrow = ai * HALF + wr * 64 + m * 16 + fr; const float r = S[lrow]; const size_t off = (size_t)(u.pm * BM + lrow) * ldc + col0;
#pragma unroll
                for (int bj = 0; bj < 2; ++bj)
#pragma unroll
                    for (int n = 0; n < 2; ++n) *(f32x4*)(out + off + bj * HALF + n * 4) = acc[ai][bj][m][n] * r * *(const f32x4*)(fgain + col0 + bj * HALF + n * 4); }
    }
};
template <class Epi, class Sched, bool ALIGN_EPI = false, bool SP2 = false>
__device__ __forceinline__ void gemm_phase(PG8_LAS unsigned char* lds, const Gemm g, const Sched& S, const Epi& E) {
    const int tid = threadIdx.x, wid = __builtin_amdgcn_readfirstlane(tid >> 6), lane = tid & 63, wr = wid >> 2, wc = wid & 3, fr = lane & 15, fq = lane >> 4;
    const int K = g.K, nt = K / BK;
    unsigned voffA[2], voffB[2];
#pragma unroll
    for (int i = 0; i < 2; ++i) { int R, C; stage_rc(tid * 16 + i * 8192, R, C); const int Rb = Epi::PERM ? ((R & ~31) + perm32(R & 31)) : R;
        voffA[i] = (unsigned)(R * K + C) * 2u; voffB[i] = (unsigned)(Rb * K + C) * 2u; }
    const size_t kstep = (size_t)(BK * 2);
    const size_t hstep = (size_t)HALF * K * 2;
    const size_t tstep = 2 * hstep;
    const unsigned ldsw = (unsigned)wid * 1024u;
    const int aoff = lds_byte(wr * 64 + fr, fq * 8), boff = lds_byte(wc * 32 + fr, fq * 8);
#define PG8_SA(b, h) (((b) * 2 + (h)) * HTB)
#define PG8_SB(b, h) ((4 + (b) * 2 + (h)) * HTB)
#define PG8_STAGE(bufoff, gbase, voff) do { _Pragma("unroll") for (int _i = 0; _i < 2; ++_i) \
        __builtin_amdgcn_global_load_lds((const unsigned*)((const char*)(gbase) + (voff)[_i]), (PG8_LAS unsigned*)(lds + (bufoff) + ldsw + _i * 8192), 16, 0, 0); } while (0)
#define PG8_LDA(dst, b, h) do { _Pragma("unroll") for (int m = 0; m < 4; ++m) _Pragma("unroll") for (int k = 0; k < 2; ++k) dst[m][k] = *(const PG8_LAS bf16x8*)(lds + PG8_SA(b, h) + aoff + m * 2048 + k * 1024); } while (0)
#define PG8_LDB(dst, b, h) do { _Pragma("unroll") for (int n = 0; n < 2; ++n) _Pragma("unroll") for (int k = 0; k < 2; ++k) dst[n][k] = *(const PG8_LAS bf16x8*)(lds + PG8_SB(b, h) + boff + n * 2048 + k * 1024); } while (0)
#define PG8_MMA(ai, bj, At, Bt) do { __builtin_amdgcn_s_setprio(1); _Pragma("unroll") for (int m = 0; m < 4; ++m) _Pragma("unroll") for (int n = 0; n < 2; ++n) _Pragma("unroll") for (int k = 0; k < 2; ++k) \
        acc[ai][bj][m][n] = __builtin_amdgcn_mfma_f32_16x16x32_bf16(Bt[n][k], At[m][k], acc[ai][bj][m][n], 0, 0, 0); __builtin_amdgcn_s_setprio(0); } while (0)
#define PG8_WAIT_V(n) asm volatile("s_waitcnt vmcnt(" #n ")" ::: "memory")
#define PG8_WAIT_L(n) asm volatile("s_waitcnt lgkmcnt(" #n ")" ::: "memory")
#define PG8_BAR __builtin_amdgcn_s_barrier()
#define PG8_SCHED __builtin_amdgcn_sched_barrier(0)
    Unit cur, nxt; int ui = 0;
    if (!S.next(0, cur)) return;
    f32x4 acc[2][2][4][2];
#pragma unroll
    for (int a = 0; a < 2; ++a)
#pragma unroll
        for (int b = 0; b < 2; ++b)
#pragma unroll
            for (int m = 0; m < 4; ++m)
#pragma unroll
                for (int n = 0; n < 2; ++n) acc[a][b][m][n] = (f32x4){0.f, 0.f, 0.f, 0.f};
    bf16x8 At[4][2], B0[2][2], B1[2][2];
    const char* cA = (const char*)g.A + (size_t)cur.pm * tstep; const char* cB = (const char*)g.Bt + (size_t)cur.pn * tstep;
    S.a_ready(cur);
    if constexpr (SP2) {
        PG8_STAGE(PG8_SB(0, 0), cB, voffB); PG8_STAGE(PG8_SB(0, 1), cB + hstep, voffB); PG8_STAGE(PG8_SA(0, 0), cA, voffA); PG8_STAGE(PG8_SA(0, 1), cA + hstep, voffA);
        if (wr == 1) PG8_BAR;
        PG8_WAIT_V(2); PG8_BAR;
        PG8_STAGE(PG8_SB(1, 0), cB + kstep, voffB); PG8_STAGE(PG8_SA(1, 0), cA + kstep, voffA); PG8_STAGE(PG8_SB(1, 1), cB + hstep + kstep, voffB);
        PG8_WAIT_V(6); PG8_BAR;
    } else {
        PG8_STAGE(PG8_SB(0, 0), cB, voffB); PG8_STAGE(PG8_SA(0, 0), cA, voffA); PG8_STAGE(PG8_SB(0, 1), cB + hstep, voffB); PG8_STAGE(PG8_SA(0, 1), cA + hstep, voffA);
        if (wr == 1) PG8_BAR;
        PG8_WAIT_V(4); PG8_BAR;
        PG8_STAGE(PG8_SB(1, 0), cB + kstep, voffB); PG8_STAGE(PG8_SA(1, 0), cA + kstep, voffA); PG8_STAGE(PG8_SB(1, 1), cB + hstep + kstep, voffB);
        PG8_WAIT_V(6); PG8_BAR;
    }
    for (;;) {
        const bool has_next = S.next(ui + 1, nxt);
        const char* nA = has_next ? (const char*)g.A + (size_t)nxt.pm * tstep : cA; const char* nB = has_next ? (const char*)g.Bt + (size_t)nxt.pn * tstep : cB;
        for (int t = 0; t < nt; t += 2) {
            const bool last = (t == nt - 2);
            const char* a1 = cA + (size_t)(t + 1) * kstep;
            const char* a2 = last ? nA : cA + (size_t)(t + 2) * kstep; const char* b2 = last ? nB : cB + (size_t)(t + 2) * kstep;
            const char* a3 = a2 + kstep; const char* b3 = b2 + kstep;
            if (last && has_next) S.a_ready(nxt);
            if constexpr (SP2) {
            PG8_LDB(B0, 0, 0); PG8_LDB(B1, 0, 1); PG8_SCHED; PG8_LDA(At, 0, 0); PG8_STAGE(PG8_SA(1, 1), a1 + hstep, voffA);
            PG8_WAIT_V(8); PG8_WAIT_L(0); PG8_BAR; PG8_MMA(0, 0, At, B0); PG8_MMA(0, 1, At, B1); PG8_BAR; PG8_SCHED;
            PG8_LDA(At, 0, 1); PG8_STAGE(PG8_SB(0, 0), b2, voffB); PG8_STAGE(PG8_SB(0, 1), b2 + hstep, voffB); PG8_STAGE(PG8_SA(0, 0), a2, voffA);
            PG8_WAIT_V(8); PG8_WAIT_L(0); PG8_BAR; PG8_MMA(1, 0, At, B0); PG8_MMA(1, 1, At, B1); PG8_BAR; PG8_SCHED;
            PG8_LDB(B0, 1, 0); PG8_LDB(B1, 1, 1); PG8_SCHED; PG8_LDA(At, 1, 0); PG8_STAGE(PG8_SA(0, 1), a2 + hstep, voffA);
            PG8_WAIT_V(8); PG8_WAIT_L(0); PG8_BAR; PG8_MMA(0, 0, At, B0); PG8_MMA(0, 1, At, B1); PG8_BAR; PG8_SCHED;
            PG8_LDA(At, 1, 1); PG8_STAGE(PG8_SB(1, 0), b3, voffB); PG8_STAGE(PG8_SB(1, 1), b3 + hstep, voffB); PG8_STAGE(PG8_SA(1, 0), a3, voffA);
            PG8_WAIT_V(8); PG8_WAIT_L(0); PG8_BAR; PG8_MMA(1, 0, At, B0); PG8_MMA(1, 1, At, B1); PG8_BAR; PG8_SCHED;
            } else {
            PG8_LDB(B0, 0, 0); PG8_SCHED; PG8_LDA(At, 0, 0); PG8_STAGE(PG8_SA(1, 1), a1 + hstep, voffA);
            PG8_WAIT_L(8); PG8_BAR; PG8_WAIT_L(0); PG8_MMA(0, 0, At, B0); PG8_BAR; PG8_SCHED;
            PG8_LDB(B1, 0, 1); PG8_STAGE(PG8_SB(0, 0), b2, voffB);
            PG8_BAR; PG8_WAIT_L(0); PG8_MMA(0, 1, At, B1); PG8_BAR;
            PG8_LDA(At, 0, 1); PG8_STAGE(PG8_SA(0, 0), a2, voffA);
            PG8_BAR; PG8_WAIT_L(0); PG8_MMA(1, 0, At, B0); PG8_BAR; PG8_SCHED;
            PG8_STAGE(PG8_SB(0, 1), b2 + hstep, voffB);
            PG8_WAIT_V(6); PG8_BAR; PG8_MMA(1, 1, At, B1); PG8_BAR;
            PG8_LDB(B0, 1, 0); PG8_SCHED; PG8_LDA(At, 1, 0); PG8_STAGE(PG8_SA(0, 1), a2 + hstep, voffA);
            PG8_WAIT_L(8); PG8_BAR; PG8_WAIT_L(0); PG8_MMA(0, 0, At, B0); PG8_BAR; PG8_SCHED;
            PG8_LDB(B1, 1, 1); PG8_STAGE(PG8_SB(1, 0), b3, voffB);
            PG8_BAR; PG8_WAIT_L(0); PG8_MMA(0, 1, At, B1); PG8_BAR;
            PG8_LDA(At, 1, 1); PG8_STAGE(PG8_SA(1, 0), a3, voffA);
            PG8_BAR; PG8_WAIT_L(0); PG8_MMA(1, 0, At, B0); PG8_BAR; PG8_SCHED;
            PG8_STAGE(PG8_SB(1, 1), b3 + hstep, voffB);
            PG8_WAIT_V(6); PG8_BAR; PG8_MMA(1, 1, At, B1); PG8_BAR;
            }
        }
        if constexpr (ALIGN_EPI) { if (wr == 0) PG8_BAR; }
        if constexpr (!Epi::AFTER_DRAIN) { if constexpr (Epi::XCHG) E.xchg(acc, cur, wr, wc, fr, fq, lds + STAGE_BYTES, wid, lane); else E(acc, cur, wr, wc, fr, fq); S.done(cur); }
        if (!has_next) break;
#pragma unroll
        for (int a = 0; a < 2; ++a)
#pragma unroll
            for (int b = 0; b < 2; ++b)
#pragma unroll
                for (int m = 0; m < 4; ++m)
#pragma unroll
                    for (int n = 0; n < 2; ++n) acc[a][b][m][n] = (f32x4){0.f, 0.f, 0.f, 0.f};
        cur = nxt; cA = nA; cB = nB; ++ui;
        if constexpr (ALIGN_EPI) { if (wr == 1) PG8_BAR; }
    }
    PG8_WAIT_V(0);
    if constexpr (!ALIGN_EPI) { if (wr == 0) PG8_BAR; }
    PG8_BAR;
    if constexpr (Epi::AFTER_DRAIN) { E.fused(acc, cur, wr, wc, fr, fq, lds, wid, lane); S.done(cur); }
#undef PG8_SA
#undef PG8_SB
#undef PG8_STAGE
#undef PG8_LDA
#undef PG8_LDB
#undef PG8_MMA
#undef PG8_WAIT_V
#undef PG8_WAIT_L
#undef PG8_BAR
#undef PG8_SCHED
}
}
#define LAS __attribute__((address_space(3)))
typedef unsigned short bf16_t;
typedef short bf16x8 __attribute__((ext_vector_type(8)));
typedef float f32x4 __attribute__((ext_vector_type(4)));
typedef float f32x2 __attribute__((ext_vector_type(2)));
typedef float f32x16 __attribute__((ext_vector_type(16)));
typedef unsigned u32x4 __attribute__((ext_vector_type(4)));
typedef unsigned u32x2 __attribute__((ext_vector_type(2)));
constexpr int NB = 2, SEQ = 16384, MTOK = NB * SEQ, DM = 2048, NP = 4608, INW = 4480, AW = 1536, SW = 512;
constexpr int COL_Q = 0, COL_K = 1536, COL_V = 1728, COL_ZA = 2048, COL_U = 3584, COL_ZS = 4096;
constexpr int NCH = SEQ / 64;
constexpr float EPSN = 1e-5f, LOG2E = 1.4426950408889634f, QSCALE = 0.125f * LOG2E;
constexpr int KPARTS = 16;
constexpr size_t MiB = 1u << 20;
constexpr size_t WS_WIN = 0, WS_WOUT = 18 * MiB, WS_GLU = 26 * MiB, WS_MODP = 27 * MiB, WS_GATE = 28 * MiB, WS_BIASP = 28 * MiB + 65536,
                 WS_ABAR = 28 * MiB + 131072, WS_A64 = WS_ABAR + 16384, WS_BCAT = 28 * MiB + 196608, WS_CCAT = WS_BCAT + 131072,
                 WS_SSQA = 29 * MiB, WS_SSQO = 30 * MiB, WS_SC = 34 * MiB, WS_HC = 42 * MiB, WS_HB = 64 * MiB, WS_PROJ = 192 * MiB, WS_END = 480 * MiB;
constexpr int LDS_BYTES = 147456;
#ifndef MK_FUSE_FINAL
#define MK_FUSE_FINAL 1
#endif
constexpr int NPHASE = MK_FUSE_FINAL ? 7 : 8;
#ifndef MK_ONE_LAUNCH
#define MK_ONE_LAUNCH 1
#endif

typedef __bf16 bf16x2_t __attribute__((ext_vector_type(2)));
__device__ __forceinline__ unsigned pkbf(float lo, float hi) { const f32x2 v = {lo, hi}; const bf16x2_t b = __builtin_convertvector(v, bf16x2_t); return __builtin_bit_cast(unsigned, b); }
__device__ __forceinline__ float bflo(unsigned v) { return __uint_as_float(v << 16); }
__device__ __forceinline__ float bfhi(unsigned v) { return __uint_as_float(v & 0xffff0000u); }
__device__ __forceinline__ float wave_sum(float v) {
#pragma unroll
    for (int o = 1; o < 64; o <<= 1) v += __shfl_xor(v, o);
    return v;
}
#define LDS_WAIT() asm volatile("s_waitcnt lgkmcnt(0)" ::: "memory")

constexpr size_t WS_BAR = 51 * MiB, WS_PCNT = WS_BAR + 16384, WS_XSLOT = 52 * MiB; constexpr int LDS_ST_OFF = LDS_BYTES - 64;
#define XB_TMO      128
#define XB_XCNT(j)  (256  + 64 * (j))
#define XB_XSUB(j)  (1280 + 64 * (j))
#define XB_XGEN(j)  (2304 + 64 * (j))
#define XB_TOP      3328
#define XB_TOPGEN   3392
#define XCD_BAR_WORDS 3456
#define XB_SPIN_CAP (1u << 18)

__device__ __forceinline__ unsigned xb_ld(unsigned* p)              { return __hip_atomic_load(p, __ATOMIC_RELAXED, __HIP_MEMORY_SCOPE_AGENT); }
__device__ __forceinline__ unsigned xb_add(unsigned* p, unsigned v) { return __hip_atomic_fetch_add(p, v, __ATOMIC_RELAXED, __HIP_MEMORY_SCOPE_AGENT); }
__device__ __forceinline__ unsigned xb_xcc_id() { return (unsigned)__builtin_amdgcn_s_getreg((3 << 11) | 20) & 0xFu; }
#define XB_SPIN(cond, bar) do { unsigned _sp = 0; while (cond) { __builtin_amdgcn_s_sleep(1); \
    if ((++_sp & 255u) == 0u) { if (xb_ld(&(bar)[XB_TMO])) break; if (_sp > XB_SPIN_CAP) { atomicAdd(&(bar)[XB_TMO], 1u); break; } } } } while (0)

struct XcdBarrier {
    unsigned* bar; unsigned x;
    volatile LAS unsigned* st;
};

__device__ __forceinline__ XcdBarrier xcd_barrier_post(unsigned* bar, volatile LAS unsigned* st) {
    XcdBarrier b; b.bar = bar; b.x = xb_xcc_id(); b.st = st;
    if (threadIdx.x == 0) (void)xb_add(&bar[XB_XCNT(b.x)], 1u);
    return b;
}
__device__ __forceinline__ void xcd_barrier_complete(unsigned* bar, unsigned x, unsigned& nloc, unsigned& nx) {
    const unsigned G = gridDim.x * gridDim.y * gridDim.z;
    unsigned sum, cnt, mine, sp = 0u;
    for (;;) {
        sum = 0u; cnt = 0u; mine = 0u;
#pragma unroll
        for (unsigned j = 0; j < 16; ++j) { const unsigned c = xb_ld(&bar[XB_XCNT(j)]); sum += c; cnt += (c > 0u) ? 1u : 0u; mine = (j == x) ? c : mine; }
        if (sum == G) break;
        __builtin_amdgcn_s_sleep(1);
        if ((++sp & 255u) == 0u) { if (xb_ld(&bar[XB_TMO])) break; if (sp > XB_SPIN_CAP) { atomicAdd(&bar[XB_TMO], 1u); break; } }
    }
    nloc = mine > 0u ? mine : 1u; nx = cnt > 0u ? cnt : 1u;
}

__device__ __forceinline__ void xcd_barrier(const XcdBarrier& b) {
    asm volatile("s_waitcnt vmcnt(0)" ::: "memory");
    __syncthreads();
    if (threadIdx.x == 0) {
        unsigned* bar = b.bar;
        __builtin_amdgcn_s_waitcnt(0);
        unsigned nloc = b.st[0], nx = b.st[1];
        if (nloc == 0u) { xcd_barrier_complete(bar, b.x, nloc, nx); b.st[0] = nloc; b.st[1] = nx; }
        const unsigned old = xb_add(&bar[XB_XSUB(b.x)], 1u);
        const unsigned gen = old / nloc;
        if (old + 1u == (gen + 1u) * nloc) {
            __builtin_amdgcn_fence(__ATOMIC_RELEASE, "agent");
            asm volatile("s_waitcnt vmcnt(0)" ::: "memory");
            const unsigned og = xb_add(&bar[XB_TOP], 1u);
            const unsigned tg = og / nx;
            if (og + 1u == (tg + 1u) * nx) xb_add(&bar[XB_TOPGEN], 1u);
            else XB_SPIN(xb_ld(&bar[XB_TOPGEN]) == tg, bar);
            __builtin_amdgcn_fence(__ATOMIC_ACQUIRE, "agent");
            xb_add(&bar[XB_XGEN(b.x)], 1u);
            asm volatile("s_waitcnt vmcnt(0)" ::: "memory");
        } else {
            XB_SPIN(xb_ld(&bar[XB_XGEN(b.x)]) == gen, bar);
            __builtin_amdgcn_fence(__ATOMIC_ACQUIRE, "agent");
            asm volatile("s_waitcnt vmcnt(0)" ::: "memory");
        }
    }
    __syncthreads();
}


struct Args { const float* in[22]; float* out; unsigned char* ws; int ph_lo, ph_hi; };

__device__ __forceinline__ void transpose_item(const float* W, int ldw, int src_n0, int k0, bf16_t* WT, int K, int dst_n0, LAS float* scr, int lane) {
    if (src_n0 >= 0) {
#pragma unroll
        for (int i = 0; i < 32; ++i) { const int kk = 2 * i + (lane >> 5); scr[kk * 33 + (lane & 31)] = W[(size_t)(k0 + kk) * ldw + src_n0 + (lane & 31)]; }
    }
    LDS_WAIT();
    const int c = lane & 7;
#pragma unroll
    for (int j = 0; j < 4; ++j) { const int n = (lane >> 3) + 8 * j; const LAS float* s = scr + (8 * c) * 33 + n;
        u32x4 o = (u32x4){0u, 0u, 0u, 0u};
        if (src_n0 >= 0) { o.x = pkbf(s[0 * 33], s[1 * 33]); o.y = pkbf(s[2 * 33], s[3 * 33]); o.z = pkbf(s[4 * 33], s[5 * 33]); o.w = pkbf(s[6 * 33], s[7 * 33]); }
        *(u32x4*)(WT + (size_t)(dst_n0 + n) * K + k0 + 8 * c) = o; }
    LDS_WAIT();
}

__device__ __forceinline__ void phase0(const Args& a, LAS unsigned char* lds, int G, int blk, int tid, int wid, int lane) {
    unsigned char* ws = a.ws;
    LAS float* scr = (LAS float*)(lds + wid * 8448);
    LAS float* sil = (LAS float*)(lds + 69632);
    const int gw = blk * 8 + wid, NGW = G * 8;
    for (int k = tid; k < 2 * DM; k += 512) { const float cv = a.in[1][k]; sil[k] = cv / (1.0f + __expf(-cv)); }
    __syncthreads();
    {
        const float* wa = a.in[2]; const float* ba = a.in[3]; float* modp = (float*)(ws + WS_MODP);
        constexpr int NJ = 3 * DM / 64, KL = DM / KPARTS;
        for (int it = gw; it < NJ * KPARTS; it += NGW) {
            const int jg = it % NJ, kp = it / NJ, j = 64 * jg + lane; float a0 = 0.f, a1 = 0.f;
            const float* wp = wa + (size_t)(kp * KL) * (3 * DM) + j;
#pragma unroll 32
            for (int k = 0; k < KL; ++k) { const float w = wp[(size_t)k * (3 * DM)]; a0 += sil[kp * KL + k] * w; a1 += sil[DM + kp * KL + k] * w; }
            if (kp == 0) { const float bb = ba[j]; a0 += bb; a1 += bb; }
            modp[(size_t)(kp * 2 + 0) * (3 * DM) + j] = a0; modp[(size_t)(kp * 2 + 1) * (3 * DM) + j] = a1;
        }
    }
    { float* bp = (float*)(ws + WS_BIASP); const float* bi = a.in[6];
      for (int n = blk * 512 + tid; n < NP; n += G * 512) bp[n] = n < 1920 ? bi[n] : (n < 2048 ? 0.f : bi[n - 128]); }
    {
        const float *lre = a.in[9], *lim = a.in[10], *lst = a.in[11], *bre = a.in[12], *bim = a.in[13], *cre = a.in[14], *cim = a.in[15];
        float* abar = (float*)(ws + WS_ABAR); float* a64 = (float*)(ws + WS_A64); bf16_t* Bcat = (bf16_t*)(ws + WS_BCAT); bf16_t* Ccat = (bf16_t*)(ws + WS_CCAT);
        for (int e = (G - 1 - blk) * 512 + tid; e < 32 * 64 * 16; e += G * 512) {
            const int gp = e >> 4, cch = e & 15, g = gp >> 6, p = gp & 63;
            const float step = expf(lst[g]), lr = lre[gp], li = lim[gp];
            const float decay = expf(lr * step); const float ar = decay * cosf(li * step), ai = decay * sinf(li * step);
            const float den = lr * lr + li * li, nr = ar - 1.0f, ni = ai;
            const float cr_ = (nr * lr + ni * li) / den, ci_ = (ni * lr - nr * li) / den;
            if (cch == 0) { abar[2 * gp] = ar; abar[2 * gp + 1] = ai; float pr = ar, pi = ai;
#pragma unroll
                for (int s = 0; s < 6; ++s) { const float tr = pr * pr - pi * pi, ti = 2.0f * pr * pi; pr = tr; pi = ti; }
                a64[2 * gp] = pr; a64[2 * gp + 1] = pi; }
            const float br = bre[e], bi = bim[e];
            const float xr = cr_ * br - ci_ * bi, xi = cr_ * bi + ci_ * br;
            Bcat[((size_t)g * 128 + 2 * p) * 16 + cch] = (bf16_t)(pkbf(xr, 0.f) & 0xffffu);
            Bcat[((size_t)g * 128 + 2 * p + 1) * 16 + cch] = (bf16_t)(pkbf(xi, 0.f) & 0xffffu);
            const float c_r = cre[((size_t)g * 16 + cch) * 64 + p], c_i = cim[((size_t)g * 16 + cch) * 64 + p];
            *(unsigned*)(Ccat + ((size_t)g * 16 + cch) * 128 + 2 * p) = pkbf(c_r, -c_i);
        }
    }
}

__device__ __forceinline__ void phase1(const Args& a, LAS unsigned char* lds, int G, int blk, int tid, int wid, int lane) {
    unsigned char* ws = a.ws;
    const int rpb = MTOK / G, row_lo = blk * rpb, batch = row_lo / SEQ;
    LAS float* gs = (LAS float*)lds; LAS float* sh = gs + DM;
    const float* modp = (const float*)(ws + WS_MODP); const float* ng = a.in[4];
    for (int j = tid; j < DM; j += 512) { float s0 = 0.f, s1 = 0.f, s2 = 0.f;
#pragma unroll
        for (int kp = 0; kp < KPARTS; ++kp) { const float* mp = modp + (size_t)(kp * 2 + batch) * (3 * DM); s0 += mp[j]; s1 += mp[DM + j]; s2 += mp[2 * DM + j]; }
        gs[j] = ng[j] * (1.0f + s1); sh[j] = s0;
        if (row_lo % SEQ == 0) ((float*)(ws + WS_GATE))[batch * DM + j] = s2; }
    __syncthreads();
    if (wid >= 4) {
        LAS float* scr = (LAS float*)(lds + 16384 + (wid - 4) * 8448);
        const int gw = blk * 4 + (wid - 4), NGW = G * 4;
    constexpr int I_IN = (DM / 64) * (NP / 32), I_OUT = (DM / 64) * (DM / 32), I_GLU = (SW / 64) * (SW / 32);
    for (int it = gw; it < I_IN + I_OUT + I_GLU; it += NGW) {
        int r = it;
        if (r < I_IN) { const int nblk = NP / 32, kb = r / nblk, nb = r % nblk, n0 = 32 * nb; const int src = n0 < 1920 ? n0 : (n0 < 2048 ? -1 : n0 - 128);
            transpose_item(a.in[5], INW, src, 64 * kb, (bf16_t*)(ws + WS_WIN), DM, n0, scr, lane); continue; }
        r -= I_IN;
        if (r < I_OUT) { const int nblk = DM / 32, kb = r / nblk, nb = r % nblk; transpose_item(a.in[20], DM, 32 * nb, 64 * kb, (bf16_t*)(ws + WS_WOUT), DM, 32 * nb, scr, lane); continue; }
        r -= I_OUT;
        { const int nblk = SW / 32, kb = r / nblk, nb = r % nblk; transpose_item(a.in[17], SW, 32 * nb, 64 * kb, (bf16_t*)(ws + WS_GLU), SW, 32 * nb, scr, lane); }
    }
        return;
    }
    const float* x = a.in[0]; bf16_t* hb = (bf16_t*)(ws + WS_HB);
    for (int r = row_lo + 2 * wid; r < row_lo + rpb; r += 8) {
        const f32x4* xr = (const f32x4*)(x + (size_t)r * DM) + lane; f32x4 v[2][8]; float ss[2] = {0.f, 0.f};
#pragma unroll
        for (int q = 0; q < 2; ++q)
#pragma unroll
            for (int i = 0; i < 8; ++i) v[q][i] = xr[q * (DM / 4) + 64 * i];
#pragma unroll
        for (int q = 0; q < 2; ++q)
#pragma unroll
            for (int i = 0; i < 8; ++i) ss[q] += (v[q][i][0] * v[q][i][0] + v[q][i][1] * v[q][i][1]) + (v[q][i][2] * v[q][i][2] + v[q][i][3] * v[q][i][3]);
#pragma unroll
        for (int q = 0; q < 2; ++q) {
            const float rstd = 1.0f / sqrtf(wave_sum(ss[q]) * (1.0f / DM) + EPSN);
            u32x2* o = (u32x2*)(hb + (size_t)(r + q) * DM) + lane;
#pragma unroll
            for (int i = 0; i < 8; ++i) { const f32x4 g4 = *(const LAS f32x4*)(gs + 4 * (lane + 64 * i)), s4 = *(const LAS f32x4*)(sh + 4 * (lane + 64 * i));
                const f32x4 h = v[q][i] * rstd * g4 + s4; u32x2 w; w.x = pkbf(h[0], h[1]); w.y = pkbf(h[2], h[3]); o[64 * i] = w; }
        }
    }
}

#define MFMA32(A, B, C) __builtin_amdgcn_mfma_f32_32x32x16_bf16(A, B, C, 0, 0, 0)
#define MFMA16(A, B, C) __builtin_amdgcn_mfma_f32_16x16x32_bf16(A, B, C, 0, 0, 0)
__device__ __forceinline__ void attn_unit(const Args& a, LAS unsigned char* lds, int b, int kvh, int qb, int tid, int wid, int lane) {
    const bf16_t* proj = (const bf16_t*)(a.ws + WS_PROJ); bf16_t* mixed = (bf16_t*)(a.ws + WS_HB); float* ssqa = (float*)(a.ws + WS_SSQA);
    const int r32 = lane & 31, hi = lane >> 5;
    LAS bf16_t* KS = (LAS bf16_t*)lds;
    LAS bf16_t* VT = (LAS bf16_t*)(lds + 36864);
    LAS bf16_t* OST = (LAS bf16_t*)(lds + 70656 + wid * 4608);
    LAS float* SSQ = (LAS float*)(lds + 107520);
    const long tok0 = (long)b * SEQ + qb * 128;
#pragma unroll
    for (int i = 0; i < 4; ++i) { const int id = tid + 512 * i, row = id >> 3, ch = id & 7;
        u32x4 v = (u32x4){0u, 0u, 0u, 0u};
        if (qb > 0 || row >= 128) v = *(const u32x4*)(proj + (size_t)(tok0 - 128 + row) * NP + COL_K + kvh * 64 + ch * 8);
        *(LAS u32x4*)(KS + row * 72 + ch * 8) = v; }
#pragma unroll
    for (int i = 0; i < 4; ++i) { const int id = tid + 512 * i, row = id & 255, ch = id >> 8;
        u32x4 v = (u32x4){0u, 0u, 0u, 0u};
        if (qb > 0 || row >= 128) v = *(const u32x4*)(proj + (size_t)(tok0 - 128 + row) * NP + COL_V + kvh * 64 + ch * 8);
#pragma unroll
        for (int e = 0; e < 8; ++e) VT[(ch * 8 + e) * 264 + row] = (bf16_t)((v[e >> 1] >> (16 * (e & 1))) & 0xffffu); }
    const int head = kvh * 8 + wid;
    bf16x8 qn[4];
#pragma unroll
    for (int ds = 0; ds < 4; ++ds) qn[ds] = *(const bf16x8*)(proj + (size_t)(tok0 + r32) * NP + COL_Q + head * 64 + 16 * ds + 8 * hi);
    __syncthreads();
    const float sink2 = a.in[7][head] * LOG2E;
    const int oc = (lane & 7) * 8;
    const f32x4 g0 = *(const f32x4*)(a.in[8] + head * 64 + oc), g1 = *(const f32x4*)(a.in[8] + head * 64 + oc + 4);
    const float NEG = -1.0e30f;
    for (int s = 0; s < 4; ++s) {
        bf16x8 qf[4];
#pragma unroll
        for (int ds = 0; ds < 4; ++ds) qf[ds] = qn[ds];
        if (s < 3) { const size_t qtok = (size_t)(tok0 + 32 * (s + 1) + r32);
#pragma unroll
            for (int ds = 0; ds < 4; ++ds) qn[ds] = *(const bf16x8*)(proj + qtok * NP + COL_Q + head * 64 + 16 * ds + 8 * hi); }
        u32x4 zp[4];
#pragma unroll
        for (int i = 0; i < 4; ++i) zp[i] = *(const u32x4*)(proj + (size_t)(tok0 + 32 * s + 8 * i + (lane >> 3)) * NP + COL_ZA + head * 64 + oc);
        f32x16 S[5];
#pragma unroll
        for (int j = 0; j < 5; ++j) { const int kb0 = 32 * (s + j); f32x16 acc = {};
#pragma unroll
            for (int ds = 0; ds < 4; ++ds) { const bf16x8 kf = *(const LAS bf16x8*)(KS + (kb0 + r32) * 72 + 16 * ds + 8 * hi); acc = MFMA32(kf, qf[ds], acc); }
            S[j] = acc; }
#pragma unroll
        for (int r = 0; r < 16; ++r) { const int kk = (r & 3) + 8 * (r >> 2) + 4 * hi; if (kk <= r32) S[0][r] = NEG; if (kk > r32) S[4][r] = NEG; }
        if (qb == 0) {
#pragma unroll
            for (int j = 0; j < 4; ++j) if (s + j < 4) {
#pragma unroll
                for (int r = 0; r < 16; ++r) S[j][r] = NEG; } }
        float m = NEG;
#pragma unroll
        for (int j = 0; j < 5; ++j)
#pragma unroll
            for (int r = 0; r < 16; ++r) m = fmaxf(m, S[j][r]);
        m = fmaxf(m, __shfl_xor(m, 32));
        float l = 0.f;
#pragma unroll
        for (int j = 0; j < 5; ++j)
#pragma unroll
            for (int r = 0; r < 16; ++r) { const float p = __builtin_amdgcn_exp2f(S[j][r] - m); S[j][r] = p; l += p; }
        l += __shfl_xor(l, 32); l += __builtin_amdgcn_exp2f(sink2 - m);
        f32x16 O[2]; O[0] = (f32x16){}; O[1] = (f32x16){};
#pragma unroll
        for (int j = 0; j < 5; ++j)
#pragma unroll
            for (int s2 = 0; s2 < 2; ++s2) {
                u32x4 pw; pw.x = pkbf(S[j][8 * s2 + 0], S[j][8 * s2 + 1]); pw.y = pkbf(S[j][8 * s2 + 2], S[j][8 * s2 + 3]); pw.z = pkbf(S[j][8 * s2 + 4], S[j][8 * s2 + 5]); pw.w = pkbf(S[j][8 * s2 + 6], S[j][8 * s2 + 7]);
                const bf16x8 pf = __builtin_bit_cast(bf16x8, pw);
                const int kv0 = 32 * (s + j) + 16 * s2 + 4 * hi;
#pragma unroll
                for (int dt = 0; dt < 2; ++dt) { const int d = 32 * dt + r32;
                    const u32x2 lo = *(const LAS u32x2*)(VT + d * 264 + kv0), hh = *(const LAS u32x2*)(VT + d * 264 + kv0 + 8);
                    const u32x4 vw = (u32x4){lo.x, lo.y, hh.x, hh.y};
                    O[dt] = MFMA32(__builtin_bit_cast(bf16x8, vw), pf, O[dt]); }
            }
        const float inv = 1.0f / l; float ss = 0.f;
#pragma unroll
        for (int dt = 0; dt < 2; ++dt)
#pragma unroll
            for (int r = 0; r < 16; ++r) { const float o = O[dt][r] * inv; O[dt][r] = o; ss += o * o; }
        ss += __shfl_xor(ss, 32);
        if (hi == 0) SSQ[wid * 128 + 32 * s + r32] = ss;
#pragma unroll
        for (int dt = 0; dt < 2; ++dt)
#pragma unroll
            for (int rg = 0; rg < 4; ++rg) { u32x2 w; w.x = pkbf(O[dt][4 * rg], O[dt][4 * rg + 1]); w.y = pkbf(O[dt][4 * rg + 2], O[dt][4 * rg + 3]);
                *(LAS u32x2*)(OST + r32 * 72 + 32 * dt + 8 * rg + 4 * hi) = w; }
        LDS_WAIT();
#pragma unroll
        for (int i = 0; i < 4; ++i) { const int row = 8 * i + (lane >> 3); const size_t tok = (size_t)(tok0 + 32 * s + row);
            const u32x4 o8 = *(const LAS u32x4*)(OST + row * 72 + oc);
            const u32x4 z8 = zp[i];
            u32x4 w;
            w.x = pkbf(bflo(o8.x) * g0[0] * bflo(z8.x), bfhi(o8.x) * g0[1] * bfhi(z8.x));
            w.y = pkbf(bflo(o8.y) * g0[2] * bflo(z8.y), bfhi(o8.y) * g0[3] * bfhi(z8.y));
            w.z = pkbf(bflo(o8.z) * g1[0] * bflo(z8.z), bfhi(o8.z) * g1[1] * bfhi(z8.z));
            w.w = pkbf(bflo(o8.w) * g1[2] * bflo(z8.w), bfhi(o8.w) * g1[3] * bfhi(z8.w));
#ifdef DBG_NO_ATTN
            w = (u32x4){0u, 0u, 0u, 0u};
#endif
            *(u32x4*)(mixed + tok * DM + head * 64 + oc) = w; }
        LDS_WAIT();
    }
    __syncthreads();
    if (tid < 128) { float t = 0.f;
#pragma unroll
        for (int w = 0; w < 8; ++w) t += SSQ[w * 128 + tid];
        ssqa[(size_t)kvh * MTOK + tok0 + tid] = t; }
    __syncthreads();
}

__device__ __forceinline__ f32x2 gelu_pk(f32x2 v) {
    const f32x2 av = __builtin_elementwise_abs(v), d = av * 0.2316418882f + 1.0f;
    f32x2 t; t.x = __builtin_amdgcn_rcpf(d.x); t.y = __builtin_amdgcn_rcpf(d.y);
    f32x2 q = t * 0.5307027145f + (-0.7265760135f); q = q * t + 0.7107068705f; q = q * t + (-0.142248368f); q = q * t + 0.127414796f; q = q * t;
    const f32x2 s = (v * v) * (-0.72134752044f);
    f32x2 e; e.x = __builtin_amdgcn_exp2f(s.x); e.y = __builtin_amdgcn_exp2f(s.y);
    const f32x2 mm = v * (q * e), r = v - mm;
    f32x2 o; o.x = v.x < 0.f ? mm.x : r.x; o.y = v.y < 0.f ? mm.y : r.y; return o;
}
template <bool FINAL>
__device__ __forceinline__ void ssm_unit(const Args& a, LAS unsigned char* lds, int b, int c64, int tid, int wid, int lane, int next_u = -1) {
    const bf16_t* proj = (const bf16_t*)(a.ws + WS_PROJ); bf16_t* mixed = (bf16_t*)(a.ws + WS_HB);
    const float* abar = (const float*)(a.ws + WS_ABAR); const bf16_t* Bcat = (const bf16_t*)(a.ws + WS_BCAT); const bf16_t* Ccat = (const bf16_t*)(a.ws + WS_CCAT);
    f32x2* Sc = (f32x2*)(a.ws + WS_SC); const f32x2* Hc = (const f32x2*)(a.ws + WS_HC);
    LAS bf16_t* BUF = (LAS bf16_t*)(lds + wid * 8704);
    LAS bf16_t* TILE = (LAS bf16_t*)(lds + 69632);
    LAS float* SSQ2 = (LAS float*)(lds + 136192);
    const size_t tok0 = (size_t)b * SEQ + 64 * c64;
    const int r32 = lane & 31, hi = lane >> 5, r16 = lane & 15, q4 = lane >> 4;
#if defined(PROBE_P5) && PROBE_P5 == 2
    for (int rp_ = 0; rp_ < (FINAL ? 2 : 1); ++rp_) {
    if (rp_) __syncthreads();
#else
    {
#endif
    if (!FINAL) {
#pragma unroll
    for (int i = 0; i < 8; ++i) { const int id = tid + 512 * i, row = id >> 6, ch = id & 63;
        *(LAS u32x4*)(TILE + row * 520 + ch * 8) = *(const u32x4*)(proj + (tok0 + row) * NP + COL_U + ch * 8); }
    }
    bf16x8 bcN[4], ccN[4]; f32x2 abN, h0N = {0.f, 0.f}; f32x4 d4N = {0.f, 0.f, 0.f, 0.f};
#define SSM_LOADC(G_) do { const int g_ = (G_); \
        _Pragma("unroll") for (int jt = 0; jt < 4; ++jt) bcN[jt] = *(const bf16x8*)(Bcat + ((size_t)(g_ * 128 + 32 * jt + r32) * 16 + 8 * hi)); \
        abN = *(const f32x2*)(abar + (size_t)(g_ * 64 + lane) * 2); \
        if (FINAL) { h0N = Hc[((size_t)(b * NCH + c64) * 32 + g_) * 64 + lane]; d4N = *(const f32x4*)(a.in[16] + g_ * 16 + 4 * q4); \
            _Pragma("unroll") for (int ks = 0; ks < 4; ++ks) ccN[ks] = *(const bf16x8*)(Ccat + ((size_t)(g_ * 16 + r16) * 128 + 32 * ks + 8 * q4)); } } while (0)
    SSM_LOADC(wid);
    __syncthreads();
    for (int gi = 0; gi < 4; ++gi) {
        const int g = wid + 8 * gi;
        bf16x8 bc[4], cc[4];
#pragma unroll
        for (int i = 0; i < 4; ++i) { bc[i] = bcN[i]; cc[i] = ccN[i]; }
        const float ar = abN[0], ai = abN[1]; float hr = h0N[0], hq = h0N[1]; const f32x4 d4 = d4N;
        const size_t sidx = ((size_t)(b * NCH + c64) * 32 + g) * 64 + lane;
        if (gi < 3) SSM_LOADC(g + 8);
        for (int hh = 0; hh < 2; ++hh) {
            const bf16x8 uf = *(const LAS bf16x8*)(TILE + (32 * hh + r32) * 520 + g * 16 + 8 * hi);
#pragma unroll
            for (int jt = 0; jt < 4; ++jt) { f32x16 d = {}; d = MFMA32(bc[jt], uf, d);
#pragma unroll
                for (int rg = 0; rg < 4; ++rg) { u32x2 w; w.x = pkbf(d[4 * rg], d[4 * rg + 1]); w.y = pkbf(d[4 * rg + 2], d[4 * rg + 3]);
                    *(LAS u32x2*)(BUF + r32 * 136 + 32 * jt + 8 * rg + 4 * hi) = w; } }
            LDS_WAIT();
#pragma unroll
            for (int t0 = 0; t0 < 32; t0 += 8) { unsigned v[8];
#pragma unroll
                for (int i = 0; i < 8; ++i) v[i] = *(const LAS unsigned*)(BUF + (t0 + i) * 136 + 2 * lane);
#pragma unroll
                for (int i = 0; i < 8; ++i) { const float bur = bflo(v[i]), bui = bfhi(v[i]);
                    const float nr = fmaf(ar, hr, fmaf(-ai, hq, bur)), ni = fmaf(ar, hq, fmaf(ai, hr, bui)); hr = nr; hq = ni;
                    if (FINAL) *(LAS unsigned*)(BUF + (t0 + i) * 136 + 2 * lane) = pkbf(hr, hq); } }
            if (FINAL) {
                LDS_WAIT();
#pragma unroll
                for (int tt = 0; tt < 2; ++tt) { f32x4 y = {};
#pragma unroll
                    for (int ks = 0; ks < 4; ++ks) { const bf16x8 hf = *(const LAS bf16x8*)(BUF + (16 * tt + r16) * 136 + 32 * ks + 8 * q4); y = MFMA16(cc[ks], hf, y); }
                    const int tl = 32 * hh + 16 * tt + r16;
                    const u32x2 u4 = *(const LAS u32x2*)(TILE + tl * 520 + g * 16 + 4 * q4);
                    const f32x2 ga = gelu_pk((f32x2){y[0] + d4[0] * bflo(u4.x), y[1] + d4[1] * bfhi(u4.x)}), gb = gelu_pk((f32x2){y[2] + d4[2] * bflo(u4.y), y[3] + d4[3] * bfhi(u4.y)});
                    u32x2 w; w.x = pkbf(ga.x, ga.y); w.y = pkbf(gb.x, gb.y);
                    *(LAS u32x2*)(TILE + tl * 520 + g * 16 + 4 * q4) = w; }
                LDS_WAIT();
            }
        }
        if (!FINAL) Sc[sidx] = (f32x2){hr, hq};
    }
    }
#undef SSM_LOADC
    if (!FINAL) __syncthreads();
    if (FINAL) {
        const bf16_t* glu = (const bf16_t*)(a.ws + WS_GLU);
        __syncthreads();
#if defined(PROBE_P5) && PROBE_P5 == 3
        for (int i = tid; i < 64 * 65; i += 512) ((LAS u32x4*)lds)[i] = ((const LAS u32x4*)(lds + 69632))[i];
        __syncthreads();
        _Pragma("nounroll") for (int rp3_ = 0; rp3_ < a.ph_hi - 5; ++rp3_) {
        if (rp3_) { for (int i = tid; i < 64 * 65; i += 512) ((LAS u32x4*)(lds + 69632))[i] = ((const LAS u32x4*)lds)[i]; __syncthreads(); }
#else
        {
#endif
        f32x16 acc[2][2];
#pragma unroll
        for (int i = 0; i < 2; ++i)
#pragma unroll
            for (int j = 0; j < 2; ++j) acc[i][j] = (f32x16){};
        const int nb = 64 * wid;
        bf16x8 gA0[4][2], gA1[4][2];
        const bf16_t* gl0 = glu + (size_t)(nb + r32) * SW + 8 * hi;
#define GLU_LOAD(BUFV, c) do { _Pragma("unroll") for (int k4 = 0; k4 < 4; ++k4) { BUFV[k4][0] = *(const bf16x8*)(gl0 + 16 * (4 * (c) + k4)); BUFV[k4][1] = *(const bf16x8*)(gl0 + 32 * SW + 16 * (4 * (c) + k4)); } } while (0)
#define GLU_MMA(BUFV, c) do { _Pragma("unroll") for (int k4 = 0; k4 < 4; ++k4) { const int ks = 4 * (c) + k4; bf16x8 bf[2]; \
            _Pragma("unroll") for (int tt = 0; tt < 2; ++tt) bf[tt] = *(const LAS bf16x8*)(TILE + (32 * tt + r32) * 520 + 16 * ks + 8 * hi); \
            _Pragma("unroll") for (int nt = 0; nt < 2; ++nt) _Pragma("unroll") for (int tt = 0; tt < 2; ++tt) acc[nt][tt] = MFMA32(BUFV[k4][nt], bf[tt], acc[nt][tt]); } } while (0)
#if defined(PROBE_P5) && PROBE_P5 == 1
        for (int rp_ = 0; rp_ < 2; ++rp_) {
        for (int i = 0; i < 2; ++i) for (int j = 0; j < 2; ++j) acc[i][j] = (f32x16){};
#else
        {
#endif
        GLU_LOAD(gA0, 0);
#pragma unroll 1
        for (int c = 0; c < 8; c += 2) {
            GLU_LOAD(gA1, c + 1);
            asm volatile("" ::: "memory");
            GLU_MMA(gA0, c);
            if (c + 2 < 8) GLU_LOAD(gA0, c + 2);
            asm volatile("" ::: "memory");
            GLU_MMA(gA1, c + 1);
        }
        }
#undef GLU_LOAD
#undef GLU_MMA
#pragma unroll
        for (int tt = 0; tt < 2; ++tt) { const int t = 32 * tt + r32; float ss = 0.f;
#pragma unroll
            for (int nt = 0; nt < 2; ++nt)
#pragma unroll
                for (int rg = 0; rg < 4; ++rg) { const int n0 = nb + 32 * nt + 8 * rg + 4 * hi;
                    const u32x2 s4 = *(const LAS u32x2*)(TILE + t * 520 + n0); const f32x4 b4 = *(const f32x4*)(a.in[18] + n0);
                    const float sv[4] = {bflo(s4.x), bfhi(s4.x), bflo(s4.y), bfhi(s4.y)};
#pragma unroll
                    for (int e = 0; e < 4; ++e) { const float gl = acc[nt][tt][4 * rg + e] + b4[e]; const float gv = sv[e] * __builtin_amdgcn_rcpf(1.0f + __builtin_amdgcn_exp2f(-LOG2E * gl));
                        acc[nt][tt][4 * rg + e] = gv; ss += gv * gv; } }
            ss += __shfl_xor(ss, 32);
            if (hi == 0) SSQ2[wid * 64 + t] = ss; }
        u32x4 zpre[8];
#pragma unroll
        for (int i = 0; i < 8; ++i) { const int id = tid + 512 * i, row = id >> 6, ch = id & 63; zpre[i] = *(const u32x4*)(proj + (tok0 + row) * NP + COL_ZS + ch * 8); }
        __syncthreads();
#pragma unroll
        for (int tt = 0; tt < 2; ++tt) { const int t = 32 * tt + r32; float tot = 0.f;
#pragma unroll
            for (int w = 0; w < 8; ++w) tot += SSQ2[w * 64 + t];
            const float* sq = (const float*)(a.ws + WS_SSQA) + tok0 + t;
            const float rstd = sqrtf((((sq[0] + sq[MTOK]) + sq[2 * MTOK]) * (1.0f / AW) + EPSN) / (tot * (1.0f / SW) + EPSN));
#pragma unroll
            for (int nt = 0; nt < 2; ++nt)
#pragma unroll
                for (int rg = 0; rg < 4; ++rg) { const int n0 = nb + 32 * nt + 8 * rg + 4 * hi; const f32x4 g4 = *(const f32x4*)(a.in[19] + n0);
                    u32x2 w; w.x = pkbf(acc[nt][tt][4 * rg] * rstd * g4[0], acc[nt][tt][4 * rg + 1] * rstd * g4[1]); w.y = pkbf(acc[nt][tt][4 * rg + 2] * rstd * g4[2], acc[nt][tt][4 * rg + 3] * rstd * g4[3]);
                    *(LAS u32x2*)(TILE + t * 520 + n0) = w; } }
        __syncthreads();
#pragma unroll
        for (int i = 0; i < 8; ++i) { const int id = tid + 512 * i, row = id >> 6, ch = id & 63;
            const u32x4 o8 = *(const LAS u32x4*)(TILE + row * 520 + ch * 8);
            const u32x4 z8 = zpre[i];
            u32x4 w;
            w.x = pkbf(bflo(o8.x) * bflo(z8.x), bfhi(o8.x) * bfhi(z8.x)); w.y = pkbf(bflo(o8.y) * bflo(z8.y), bfhi(o8.y) * bfhi(z8.y));
            w.z = pkbf(bflo(o8.z) * bflo(z8.z), bfhi(o8.z) * bfhi(z8.z)); w.w = pkbf(bflo(o8.w) * bflo(z8.w), bfhi(o8.w) * bfhi(z8.w));
#ifdef DBG_NO_SSM
            w = (u32x4){0u, 0u, 0u, 0u};
#endif
#ifdef DBG_SAN_SSM
            { unsigned* wp = (unsigned*)&w; for (int e = 0; e < 4; ++e) { unsigned x = wp[e]; if ((x & 0x7f80u) == 0x7f80u) x &= 0xffff0000u; if ((x & 0x7f800000u) == 0x7f800000u) x &= 0xffffu; wp[e] = x; } }
#endif
            *(u32x4*)(mixed + (tok0 + row) * DM + AW + ch * 8) = w; }
        __syncthreads();
        if (next_u >= 0) { const size_t tokn = (size_t)(next_u / NCH) * SEQ + 64 * (next_u % NCH);
#pragma unroll
            for (int i = 0; i < 8; ++i) { const int id = tid + 512 * i, row = id >> 6, ch = id & 63;
                *(LAS u32x4*)(TILE + row * 520 + ch * 8) = *(const u32x4*)(proj + (tokn + row) * NP + COL_U + ch * 8); } }
        }
    }
}

__device__ __forceinline__ void phase_carry(const Args& a, LAS unsigned char* lds, int blk, int wid, int lane) {
    if (blk >= NB * 32) return;
    const int b = blk >> 5, g = blk & 31;
    const f32x2 aa = *(const f32x2*)((const float*)(a.ws + WS_A64) + (size_t)(g * 64 + lane) * 2);
    const f32x2* Sc = (const f32x2*)(a.ws + WS_SC); f32x2* Hc = (f32x2*)(a.ws + WS_HC);
    LAS f32x2* E = (LAS f32x2*)lds;
    const size_t base = ((size_t)(b * NCH + 32 * wid) * 32 + g) * 64 + lane;
    f32x2 s[32];
#pragma unroll
    for (int i = 0; i < 32; ++i) s[i] = Sc[base + (size_t)i * 2048];
    float hr = 0.f, hq = 0.f;
#pragma unroll
    for (int i = 0; i < 32; ++i) { const float sr = s[i][0], si = s[i][1]; s[i] = (f32x2){hr, hq};
        const float nr = fmaf(aa[0], hr, fmaf(-aa[1], hq, sr)), ni = fmaf(aa[0], hq, fmaf(aa[1], hr, si)); hr = nr; hq = ni; }
    E[wid * 64 + lane] = (f32x2){hr, hq};
    float pr = aa[0], pi = aa[1];
#pragma unroll
    for (int q = 0; q < 5; ++q) { const float tr = pr * pr - pi * pi, ti = 2.0f * pr * pi; pr = tr; pi = ti; }
    __syncthreads();
    float cr = 0.f, ci = 0.f;
    for (int v = 0; v < wid; ++v) { const f32x2 e = E[v * 64 + lane]; const float nr = fmaf(pr, cr, fmaf(-pi, ci, e[0])), ni = fmaf(pr, ci, fmaf(pi, cr, e[1])); cr = nr; ci = ni; }
#pragma unroll
    for (int i = 0; i < 32; ++i) { Hc[base + (size_t)i * 2048] = (f32x2){s[i][0] + cr, s[i][1] + ci};
        const float nr = aa[0] * cr - aa[1] * ci, ni = aa[0] * ci + aa[1] * cr; cr = nr; ci = ni; }
    __syncthreads();
}

__device__ __forceinline__ void phase_final(const Args& a, int G, int blk, int wid, int lane) {
    const float* ssqo = (const float*)(a.ws + WS_SSQO); const float* fg = a.in[21]; float* out = a.out;
    f32x4 g4[8];
#pragma unroll
    for (int i = 0; i < 8; ++i) g4[i] = *((const f32x4*)fg + lane + 64 * i);
    for (int r = blk * 8 + wid; r < MTOK; r += G * 8) {
        float s = lane < 32 ? ssqo[(size_t)lane * MTOK + r] : 0.f;
        const float rstd = 1.0f / sqrtf(wave_sum(s) * (1.0f / DM) + EPSN);
        f32x4* o = (f32x4*)(out + (size_t)r * DM) + lane;
#pragma unroll
        for (int i = 0; i < 8; ++i) { const f32x4 v = o[64 * i]; o[64 * i] = v * rstd * g4[i]; }
    }
}

__global__ void __launch_bounds__(512, 2) mk_fwd(Args a) {
    extern __shared__ __attribute__((aligned(16))) unsigned char lds_raw[];
    LAS unsigned char* lds = (LAS unsigned char*)lds_raw;
    cg::grid_group grid = cg::this_grid();
    const int tid = threadIdx.x, lane = tid & 63, wid = __builtin_amdgcn_readfirstlane(tid >> 6);
    const int G = gridDim.x, blk = blockIdx.x;
    const int lo = a.ph_lo, hi_ph = a.ph_hi;
    if (tid < 16) ((LAS unsigned*)(lds + LDS_ST_OFF))[tid] = 0u;
    __syncthreads();
    XcdBarrier bar = xcd_barrier_post((unsigned*)(a.ws + WS_BAR), (volatile LAS unsigned*)(lds + LDS_ST_OFF));
    if (hi_ph > 1000) grid.sync();
#define IN(k) (lo <= (k) && (k) < hi_ph)
#define SEAM(k) do { if ((k) + 1 < hi_ph) xcd_barrier(bar); } while (0)
#ifndef REPMASK
#define REPMASK 0
#endif
#define NREP(k) (((REPMASK >> (k)) & 1) ? 2 : 1)
    if (IN(0)) for (int rep_ = 0; rep_ < NREP(0); ++rep_) { if (rep_) xcd_barrier(bar);
#ifndef OFF_P0
        phase0(a, lds, G, blk, tid, wid, lane);
#endif
        SEAM(0); }
#ifdef EXTRA_SYNCS
    for (int es_ = 0; es_ < EXTRA_SYNCS; ++es_) xcd_barrier(bar);
#endif
    if (IN(1)) for (int rep_ = 0; rep_ < NREP(1); ++rep_) { if (rep_) xcd_barrier(bar);
#ifndef OFF_P1
        phase1(a, lds, G, blk, tid, wid, lane);
#endif
        SEAM(1); }
    if (IN(2)) for (int rep_ = 0; rep_ < NREP(2); ++rep_) { if (rep_) xcd_barrier(bar);
#ifndef OFF_P2
        pg8::Gemm g{(const bf16_t*)(a.ws + WS_HB), (const bf16_t*)(a.ws + WS_WIN), MTOK, NP, DM}; pg8::StaticOrder S; S.init(MTOK, NP, G, blk);
        pg8::EpiProj E{(bf16_t*)(a.ws + WS_PROJ), NP, (const float*)(a.ws + WS_BIASP), QSCALE};
        pg8::gemm_phase<pg8::EpiProj, pg8::StaticOrder, true, true>(lds, g, S, E);
#endif
        SEAM(2); }
    if (IN(3)) for (int rep_ = 0; rep_ < NREP(3); ++rep_) { if (rep_) xcd_barrier(bar);
        constexpr int NATT = NB * 3 * (SEQ / 128), NSSM = NB * NCH;
#ifndef OFF_P3A
        for (int L = blk; L < NATT; L += G) { const int qb = L % (SEQ / 128), r = L / (SEQ / 128), kvh = r % 3, b = r / 3; attn_unit(a, lds, b, kvh, qb, tid, wid, lane); }
#endif
#ifndef OFF_P3B
        for (int u = blk; u < NSSM; u += G) ssm_unit<false>(a, lds, u / NCH, u % NCH, tid, wid, lane);
#endif
        SEAM(3); }
    if (IN(4)) for (int rep_ = 0; rep_ < NREP(4); ++rep_) { if (rep_) xcd_barrier(bar);
#ifndef OFF_P4
        phase_carry(a, lds, blk, wid, lane);
#endif
        if (blk < NB * NCH) {
            const bf16_t* proj = (const bf16_t*)(a.ws + WS_PROJ); const size_t tok0 = (size_t)(blk / NCH) * SEQ + 64 * (blk % NCH);
#pragma unroll
            for (int i = 0; i < 8; ++i) { const int id = tid + 512 * i, row = id >> 6, ch = id & 63;
                *(LAS u32x4*)((LAS bf16_t*)(lds + 69632) + row * 520 + ch * 8) = *(const u32x4*)(proj + (tok0 + row) * NP + COL_U + ch * 8); }
        }
        SEAM(4); }
    if (IN(5)) for (int rep_ = 0; rep_ < NREP(5); ++rep_) { if (rep_) xcd_barrier(bar);
#ifndef OFF_P5
        for (int u = blk; u < NB * NCH; u += G) ssm_unit<true>(a, lds, u / NCH, u % NCH, tid, wid, lane, (u + G < NB * NCH) ? u + G : -1);
#endif
        SEAM(5); }
    if (IN(6)) for (int rep_ = 0; rep_ < NREP(6); ++rep_) { if (rep_) xcd_barrier(bar);
#ifndef OFF_P6
        pg8::Gemm g{(const bf16_t*)(a.ws + WS_HB), (const bf16_t*)(a.ws + WS_WOUT), MTOK, DM, DM};
#if MK_FUSE_FINAL
        pg8::OutOrder S{blk};
        pg8::EpiOutFused E{a.in[0], a.out, (const float*)(a.ws + WS_GATE), (const float*)(a.ws + WS_SSQA), a.in[21], (float*)(a.ws + WS_XSLOT), (unsigned*)(a.ws + WS_PCNT), MTOK, DM, SEQ};
        pg8::gemm_phase<pg8::EpiOutFused, pg8::OutOrder, true, true>(lds, g, S, E);
#else
        pg8::StaticOrder S; S.init(MTOK, DM, G, blk);
        pg8::EpiOut E{a.in[0], a.out, (const float*)(a.ws + WS_GATE), (const float*)(a.ws + WS_SSQA), (float*)(a.ws + WS_SSQO), MTOK, DM, SEQ};
        pg8::gemm_phase<pg8::EpiOut, pg8::StaticOrder, true, true>(lds, g, S, E);
#endif
#endif
        SEAM(6); }
    if (IN(7)) {
#if !defined(OFF_P7) && !MK_FUSE_FINAL
        phase_final(a, G, blk, wid, lane);
#endif
    }
#undef IN
#undef SEAM
}

extern "C" void kernel_launch(void* const* d_in, const int* in_sizes, int n_in, void* d_out, int out_size, void* d_ws, size_t ws_size, hipStream_t stream) {
    static int grid = 0;
    if (grid == 0) {
        int dev = 0, cus = 0, per_cu = 0;
        if (n_in != 22 || ws_size < WS_END) { fprintf(stderr, "kernel_launch: unexpected n_in %d / ws_size %zu\n", n_in, ws_size); grid = -1; return; }
        (void)hipGetDevice(&dev); (void)hipDeviceGetAttribute(&cus, hipDeviceAttributeMultiprocessorCount, dev);
        if (hipFuncSetAttribute((const void*)mk_fwd, hipFuncAttributeMaxDynamicSharedMemorySize, LDS_BYTES) != hipSuccess) { fprintf(stderr, "kernel_launch: hipFuncSetAttribute failed\n"); grid = -1; return; }
        if (hipOccupancyMaxActiveBlocksPerMultiprocessor(&per_cu, (const void*)mk_fwd, 512, LDS_BYTES) != hipSuccess || per_cu < 1) { fprintf(stderr, "kernel_launch: occupancy query gave %d\n", per_cu); per_cu = 1; (void)hipGetLastError(); }
        grid = cus * per_cu;
        while (grid > 0 && (MTOK % grid != 0 || SEQ % (MTOK / grid) != 0)) --grid;
    }
    if (grid <= 0) return;
#if MK_FUSE_FINAL
    if (grid != 256) { fprintf(stderr, "kernel_launch: the fused final-norm epilogue needs a 256-workgroup grid, got %d\n", grid); return; }
#endif
    (void)hipMemsetAsync((unsigned char*)d_ws + WS_BAR, 0, 16384 + 32768, stream);
    Args a{};
    for (int i = 0; i < 22; ++i) a.in[i] = (const float*)d_in[i];
    a.out = (float*)d_out; a.ws = (unsigned char*)d_ws;
#if MK_ONE_LAUNCH
    a.ph_lo = 0; a.ph_hi = NPHASE;
    void* args[] = {&a};
    hipError_t e = hipLaunchCooperativeKernel((const void*)mk_fwd, dim3(grid), dim3(512), args, LDS_BYTES, stream);
    if (e != hipSuccess) fprintf(stderr, "cooperative launch failed: %s (grid %d)\n", hipGetErrorString(e), grid);
#else
    for (int p = 0; p < NPHASE; ++p) { a.ph_lo = p; a.ph_hi = p + 1; hipLaunchKernelGGL(mk_fwd, dim3(grid), dim3(512), LDS_BYTES, stream, a); }
#endif
}
```

```cpp
#include <hip/hip_runtime.h>
#include <hip/hip_cooperative_groups.h>
#include <cstdio>
#include <cstdint>
namespace cg = cooperative_groups;
#define MK_ONE_LAUNCH 1
namespace pg8 {
#define PG8_LAS __attribute__((address_space(3)))
typedef unsigned short bf16_t;
typedef short bf16x8 __attribute__((ext_vector_type(8)));
typedef float f32x4 __attribute__((ext_vector_type(4)));
typedef unsigned u32x4 __attribute__((ext_vector_type(4)));
constexpr int BM = 256, BK = 64, HALF = 128, HTB = HALF * BK * 2  , STAGE_BYTES = 8 * HTB, NXCD = 8, WGM = 8;

__host__ __device__ __forceinline__ int lds_byte(int r, int c) { const int st = (r >> 4) * 2 + (c >> 5), rr = r & 15, cc = c & 31, ob = rr * 64 + cc * 2; return st * 1024 + (ob ^ (((ob >> 9) & 1) << 5)); }
__host__ __device__ __forceinline__ void stage_rc(int b, int& R, int& C) { const int st = b / 1024, sb = b % 1024, swz = sb ^ (((sb >> 9) & 1) << 5); R = (st >> 1) * 16 + swz / 64; C = (st & 1) * 32 + (swz % 64) / 2; }
__host__ __device__ __forceinline__ int perm32(int rho) { const int n = rho >> 4, i = rho & 15; return 8 * (i >> 2) + 4 * n + (i & 3); }

struct Unit { int pm, pn; };
struct Gemm { const bf16_t* A; const bf16_t* Bt; int M, N, K; };

struct StaticOrder {
    int nM, nN, nwg, G, c;
    __host__ __device__ void init(int M, int N, int G_, int c_) { nM = M / BM; nN = N / BM; nwg = nM * nN; G = G_; c = c_; }
    __host__ __device__ bool next(int i, Unit& u) const {
        const long L = (long)i * G + c; if (L >= nwg) return false;
        int wgid = (int)L; { const int q = nwg / NXCD, r = nwg % NXCD, xcd = wgid % NXCD, off = wgid / NXCD; wgid = (xcd < r ? xcd * (q + 1) : r * (q + 1) + (xcd - r) * q) + off; }
        const int nig = WGM * nN, gid = wgid / nig, fm = gid * WGM, gsz = (nM - fm) < WGM ? (nM - fm) : WGM;
        u.pm = fm + ((wgid % nig) % gsz); u.pn = (wgid % nig) / gsz; return true;
    }
    __device__ __forceinline__ void a_ready(const Unit&) const {}
    __device__ __forceinline__ void done(const Unit&) const {}
};

__device__ __forceinline__ unsigned cvt_pk_bf16(float lo, float hi) { unsigned r; asm volatile("v_cvt_pk_bf16_f32 %0, %1, %2" : "=v"(r) : "v"(lo), "v"(hi)); return r; }
#ifdef DBG_STAGE
#define DBG_MIX(x) ((f32x4){0.f, 0.f, 0.f, 0.f})
#else
#define DBG_MIX(x) (x)
#endif
typedef unsigned u32x4 __attribute__((ext_vector_type(4)));
__device__ __forceinline__ float silu_f(float v) { return v * __builtin_amdgcn_rcpf(1.0f + __builtin_amdgcn_exp2f(-1.4426950408889634f * v)); }
struct EpiProj {
    static constexpr bool PERM = true, AFTER_DRAIN = false, XCHG = false;
    bf16_t* O; int ldc; const float* bias; float qscale;
    __device__ __forceinline__ void operator()(const f32x4 (&acc)[2][2][4][2], const Unit& u, int wr, int wc, int fr, int fq) const {
        asm volatile("" : "+v"(fr), "+v"(fq));
        const int row0 = u.pm * BM + wr * 64 + fr; const int pn = u.pn;
        const int mode = (pn < 6) ? 1 : (((pn >= 8 && pn < 14) || pn >= 16) ? 2 : 0);
        const float sc = mode == 1 ? qscale : 1.f;
        const int col0 = pn * BM + wc * 32 + 8 * fq;
        f32x4 bv[2][2];
#pragma unroll
        for (int bj = 0; bj < 2; ++bj)
#pragma unroll
            for (int n = 0; n < 2; ++n) bv[bj][n] = *(const f32x4*)(bias + col0 + bj * HALF + 4 * n);
#pragma unroll
        for (int ai = 0; ai < 2; ++ai)
#pragma unroll
            for (int m = 0; m < 4; ++m) { bf16_t* rowp = O + (size_t)(row0 + ai * HALF + m * 16) * ldc + col0;
#pragma unroll
                for (int bj = 0; bj < 2; ++bj) { f32x4 v0 = acc[ai][bj][m][0] + bv[bj][0], v1 = acc[ai][bj][m][1] + bv[bj][1];
                    if (mode == 2) {
#pragma unroll
                        for (int e = 0; e < 4; ++e) { v0[e] = silu_f(v0[e]); v1[e] = silu_f(v1[e]); } }
                    v0 = v0 * sc; v1 = v1 * sc; u32x4 w; w.x = cvt_pk_bf16(v0[0], v0[1]); w.y = cvt_pk_bf16(v0[2], v0[3]); w.z = cvt_pk_bf16(v1[0], v1[1]); w.w = cvt_pk_bf16(v1[2], v1[3]);
                    *(u32x4*)(rowp + bj * HALF) = w; } }
    }
};
struct EpiOut {
    static constexpr bool PERM = true, AFTER_DRAIN = false, XCHG = false;
    const float* x; float* out; const float* gate; const float* ssqa; float* ssqo; int M_, ldc, seq;
    __device__ __forceinline__ void operator()(const f32x4 (&acc)[2][2][4][2], const Unit& u, int wr, int wc, int fr, int fq) const {
        const int col0 = u.pn * BM + wc * 32 + 8 * fq; const int batch = (u.pm * BM) / seq;
        f32x4 gv[2][2];
#pragma unroll
        for (int bj = 0; bj < 2; ++bj)
#pragma unroll
            for (int n = 0; n < 2; ++n) gv[bj][n] = *(const f32x4*)(gate + batch * ldc + col0 + bj * HALF + n * 4);
#pragma unroll
        for (int ai = 0; ai < 2; ++ai)
#pragma unroll
            for (int m = 0; m < 4; ++m) { const int row = u.pm * BM + ai * HALF + wr * 64 + m * 16 + fr; const size_t off = (size_t)row * ldc + col0; float ss = 0.f;
                const float ra = __builtin_amdgcn_rsqf(((ssqa[row] + ssqa[M_ + row]) + ssqa[2 * M_ + row]) * (1.0f / 1536.0f) + 1e-5f);
#pragma unroll
                for (int bj = 0; bj < 2; ++bj)
#pragma unroll
                    for (int n = 0; n < 2; ++n) { const f32x4 xv = *(const f32x4*)(x + off + bj * HALF + n * 4); const f32x4 y = xv + DBG_MIX(gv[bj][n] * (acc[ai][bj][m][n] * ra));
                        *(f32x4*)(out + off + bj * HALF + n * 4) = y; ss += (y[0] * y[0] + y[1] * y[1]) + (y[2] * y[2] + y[3] * y[3]); }
                ss += __shfl_xor(ss, 16); ss += __shfl_xor(ss, 32);
                if (fq == 0) ssqo[(size_t)(u.pn * 4 + wc) * M_ + row] = ss;
                asm volatile("" ::: "memory"); }
    }
};

struct OutOrder {
    int c;
    __device__ __forceinline__ bool next(int i, Unit& u) const { if (i >= 4) return false; const int x = c & 7, j = c >> 3; u.pm = (i * 8 + x) * 4 + (j >> 3); u.pn = j & 7; return true; }
    __device__ __forceinline__ void a_ready(const Unit&) const {}
    __device__ __forceinline__ void done(const Unit&) const {}
};
struct EpiOutFused {
    static constexpr bool PERM = true, AFTER_DRAIN = false, XCHG = true;
    __device__ __forceinline__ void touch(int pm, int pn, int tid) const {
        asm volatile("" : "+v"(tid));
        const unsigned o = (unsigned)((pm * BM + (tid >> 3)) * ldc + pn * BM + (tid & 7) * 32), st = 64u * (unsigned)ldc;
        const float t = (x[o] + x[o + st]) + (x[o + 2u * st] + x[o + 3u * st]);
        if (t == 1.2345678e-33f) out[0] = t;
    }
    const float* x; float* out; const float* gate; const float* ssqa; const float* fgain; float* slots; unsigned* cnt; int M_, ldc, seq;
    __device__ __forceinline__ void xchg(f32x4 (&acc)[2][2][4][2], const Unit& u, int wr, int wc, int fr, int fq, PG8_LAS unsigned char* xl, int wid, int lane) const {
        asm volatile("" : "+v"(fr), "+v"(fq), "+v"(lane));
        PG8_LAS float* P = (PG8_LAS float*)xl;
        PG8_LAS float* S = (PG8_LAS float*)(xl + 4096);
        asm volatile("" ::: "memory");
        const int col0 = u.pn * BM + wc * 32 + 8 * fq; const int batch = (u.pm * BM) / seq;
        {
            f32x4 gv[2][2];
#pragma unroll
            for (int bj = 0; bj < 2; ++bj)
#pragma unroll
                for (int n = 0; n < 2; ++n) gv[bj][n] = *(const f32x4*)(gate + batch * ldc + col0 + bj * HALF + n * 4);
#pragma unroll
            for (int ai = 0; ai < 2; ++ai)
#pragma unroll
                for (int m = 0; m < 4; ++m) { const int lrow = ai * HALF + wr * 64 + m * 16 + fr, row = u.pm * BM + lrow; const size_t off = (size_t)row * ldc + col0; float ss = 0.f;
                    const float ra = __builtin_amdgcn_rsqf(((ssqa[row] + ssqa[M_ + row]) + ssqa[2 * M_ + row]) * (1.0f / 1536.0f) + 1e-5f);
#pragma unroll
                    for (int bj = 0; bj < 2; ++bj)
#pragma unroll
                        for (int n = 0; n < 2; ++n) { const f32x4 xv = *(const f32x4*)(x + off + bj * HALF + n * 4); const f32x4 y = xv + gv[bj][n] * (acc[ai][bj][m][n] * ra);
                            acc[ai][bj][m][n] = y; ss += (y[0] * y[0] + y[1] * y[1]) + (y[2] * y[2] + y[3] * y[3]); }
                    ss += __shfl_xor(ss, 16); ss += __shfl_xor(ss, 32);
                    if (fq == 0) P[lrow * 4 + wc] = ss;
                    asm volatile("" ::: "memory"); }
        }
        asm volatile("s_waitcnt lgkmcnt(0)" ::: "memory"); __builtin_amdgcn_s_barrier(); asm volatile("" ::: "memory");
        const int tid = wid * 64 + lane;
        if (wid < 4) {
            const float s = (P[tid * 4 + 0] + P[tid * 4 + 1]) + (P[tid * 4 + 2] + P[tid * 4 + 3]);
            __hip_atomic_store(slots + ((size_t)(u.pm * BM + tid) * 8 + u.pn), s, __ATOMIC_RELAXED, __HIP_MEMORY_SCOPE_AGENT);
            asm volatile("s_waitcnt vmcnt(0)" ::: "memory");
            if (lane == 0) __hip_atomic_fetch_add(cnt + 64 * u.pm, 1u, __ATOMIC_RELAXED, __HIP_MEMORY_SCOPE_AGENT);
        }
        if (wid == 0) {
            unsigned sp = 0;
            while ((unsigned)__builtin_amdgcn_readfirstlane(__hip_atomic_load(cnt + 64 * u.pm, __ATOMIC_RELAXED, __HIP_MEMORY_SCOPE_AGENT)) < 32u) { __builtin_amdgcn_s_sleep(2); if (++sp > (1u << 22)) break; }
            __builtin_amdgcn_fence(__ATOMIC_ACQUIRE, "agent");
        }
        asm volatile("s_waitcnt vmcnt(0) lgkmcnt(0)" ::: "memory"); __builtin_amdgcn_s_barrier(); asm volatile("" ::: "memory");
        if (wid < 4) {
            const float* sl = slots + (size_t)(u.pm * BM + tid) * 8; float t = 0.f;
#pragma unroll
            for (int k = 0; k < 8; ++k) t += __hip_atomic_load(sl + k, __ATOMIC_RELAXED, __HIP_MEMORY_SCOPE_AGENT);
            S[tid] = __builtin_amdgcn_rsqf(t * (1.0f / 2048.0f) + 1e-5f);
        }
        asm volatile("s_waitcnt lgkmcnt(0)" ::: "memory"); __builtin_amdgcn_s_barrier(); asm volatile("" ::: "memory");
#pragma unroll
        for (int ai = 0; ai < 2; ++ai)
#pragma unroll
            for (int m = 0; m < 4; ++m) { const int lrow = ai * HALF + wr * 64 + m * 16 + fr; const float r = S[lrow]; const size_t off = (size_t)(u.pm * BM + lrow) * ldc + col0;
#pragma unroll
                for (int bj = 0; bj < 2; ++bj)
#pragma unroll
                    for (int n = 0; n < 2; ++n) *(f32x4*)(out + off + bj * HALF + n * 4) = acc[ai][bj][m][n] * r * *(const f32x4*)(fgain + col0 + bj * HALF + n * 4); }
    }
};
template <class Epi, class Sched, bool ALIGN_EPI = false, bool SP2 = false>
__device__ __forceinline__ void gemm_phase(PG8_LAS unsigned char* lds, const Gemm g, const Sched& S, const Epi& E) {
    const int tid = threadIdx.x, wid = __builtin_amdgcn_readfirstlane(tid >> 6), lane = tid & 63, wr = wid >> 2, wc = wid & 3, fr = lane & 15, fq = lane >> 4;
    const int K = g.K, nt = K / BK;
    unsigned voffA[2], voffB[2];
#pragma unroll
    for (int i = 0; i < 2; ++i) { int R, C; stage_rc(tid * 16 + i * 8192, R, C); const int Rb = Epi::PERM ? ((R & ~31) + perm32(R & 31)) : R;
        voffA[i] = (unsigned)(R * K + C) * 2u; voffB[i] = (unsigned)(Rb * K + C) * 2u; }
    const size_t kstep = (size_t)(BK * 2);
    const size_t hstep = (size_t)HALF * K * 2;
    const size_t tstep = 2 * hstep;
    const unsigned ldsw = (unsigned)wid * 1024u;
    const int aoff = lds_byte(wr * 64 + fr, fq * 8), boff = lds_byte(wc * 32 + fr, fq * 8);
#define PG8_SA(b, h) (((b) * 2 + (h)) * HTB)
#define PG8_SB(b, h) ((4 + (b) * 2 + (h)) * HTB)
#define PG8_STAGE(bufoff, gbase, voff) do { _Pragma("unroll") for (int _i = 0; _i < 2; ++_i) \
        __builtin_amdgcn_global_load_lds((const unsigned*)((const char*)(gbase) + (voff)[_i]), (PG8_LAS unsigned*)(lds + (bufoff) + ldsw + _i * 8192), 16, 0, 0); } while (0)
#define PG8_LDA(dst, b, h) do { _Pragma("unroll") for (int m = 0; m < 4; ++m) _Pragma("unroll") for (int k = 0; k < 2; ++k) dst[m][k] = *(const PG8_LAS bf16x8*)(lds + PG8_SA(b, h) + aoff + m * 2048 + k * 1024); } while (0)
#define PG8_LDB(dst, b, h) do { _Pragma("unroll") for (int n = 0; n < 2; ++n) _Pragma("unroll") for (int k = 0; k < 2; ++k) dst[n][k] = *(const PG8_LAS bf16x8*)(lds + PG8_SB(b, h) + boff + n * 2048 + k * 1024); } while (0)
#define PG8_MMA(ai, bj, At, Bt) do { __builtin_amdgcn_s_setprio(1); _Pragma("unroll") for (int m = 0; m < 4; ++m) _Pragma("unroll") for (int n = 0; n < 2; ++n) _Pragma("unroll") for (int k = 0; k < 2; ++k) \
        acc[ai][bj][m][n] = __builtin_amdgcn_mfma_f32_16x16x32_bf16(Bt[n][k], At[m][k], acc[ai][bj][m][n], 0, 0, 0); __builtin_amdgcn_s_setprio(0); } while (0)
#define PG8_WAIT_V(n) asm volatile("s_waitcnt vmcnt(" #n ")" ::: "memory")
#define PG8_WAIT_L(n) asm volatile("s_waitcnt lgkmcnt(" #n ")" ::: "memory")
#define PG8_BAR __builtin_amdgcn_s_barrier()
#define PG8_SCHED __builtin_amdgcn_sched_barrier(0)
    Unit cur, nxt; int ui = 0;
    if (!S.next(0, cur)) return;
    f32x4 acc[2][2][4][2];
#pragma unroll
    for (int a = 0; a < 2; ++a)
#pragma unroll
        for (int b = 0; b < 2; ++b)
#pragma unroll
            for (int m = 0; m < 4; ++m)
#pragma unroll
                for (int n = 0; n < 2; ++n) acc[a][b][m][n] = (f32x4){0.f, 0.f, 0.f, 0.f};
    bf16x8 At[4][2], B0[2][2], B1[2][2];
    const char* cA = (const char*)g.A + (size_t)cur.pm * tstep; const char* cB = (const char*)g.Bt + (size_t)cur.pn * tstep;
    S.a_ready(cur);
    if constexpr (SP2) {
        PG8_STAGE(PG8_SB(0, 0), cB, voffB); PG8_STAGE(PG8_SB(0, 1), cB + hstep, voffB); PG8_STAGE(PG8_SA(0, 0), cA, voffA); PG8_STAGE(PG8_SA(0, 1), cA + hstep, voffA);
        if (wr == 1) PG8_BAR;
        PG8_WAIT_V(2); PG8_BAR;
        PG8_STAGE(PG8_SB(1, 0), cB + kstep, voffB); PG8_STAGE(PG8_SA(1, 0), cA + kstep, voffA); PG8_STAGE(PG8_SB(1, 1), cB + hstep + kstep, voffB);
        PG8_WAIT_V(6); PG8_BAR;
    } else {
        PG8_STAGE(PG8_SB(0, 0), cB, voffB); PG8_STAGE(PG8_SA(0, 0), cA, voffA); PG8_STAGE(PG8_SB(0, 1), cB + hstep, voffB); PG8_STAGE(PG8_SA(0, 1), cA + hstep, voffA);
        if (wr == 1) PG8_BAR;
        PG8_WAIT_V(4); PG8_BAR;
        PG8_STAGE(PG8_SB(1, 0), cB + kstep, voffB); PG8_STAGE(PG8_SA(1, 0), cA + kstep, voffA); PG8_STAGE(PG8_SB(1, 1), cB + hstep + kstep, voffB);
        PG8_WAIT_V(6); PG8_BAR;
    }
    for (;;) {
        const bool has_next = S.next(ui + 1, nxt);
        const char* nA = has_next ? (const char*)g.A + (size_t)nxt.pm * tstep : cA; const char* nB = has_next ? (const char*)g.Bt + (size_t)nxt.pn * tstep : cB;
        for (int t = 0; t < nt; t += 2) {
            const bool last = (t == nt - 2);
            const char* a1 = cA + (size_t)(t + 1) * kstep;
            const char* a2 = last ? nA : cA + (size_t)(t + 2) * kstep; const char* b2 = last ? nB : cB + (size_t)(t + 2) * kstep;
            const char* a3 = a2 + kstep; const char* b3 = b2 + kstep;
            if (last && has_next) S.a_ready(nxt);
            if constexpr (SP2) {
            PG8_LDB(B0, 0, 0); PG8_LDB(B1, 0, 1); PG8_SCHED; PG8_LDA(At, 0, 0); PG8_STAGE(PG8_SA(1, 1), a1 + hstep, voffA);
            PG8_WAIT_V(8); PG8_WAIT_L(0); PG8_BAR; PG8_MMA(0, 0, At, B0); PG8_MMA(0, 1, At, B1); PG8_BAR; PG8_SCHED;
            PG8_LDA(At, 0, 1); PG8_STAGE(PG8_SB(0, 0), b2, voffB); PG8_STAGE(PG8_SB(0, 1), b2 + hstep, voffB); PG8_STAGE(PG8_SA(0, 0), a2, voffA);
            PG8_WAIT_V(8); PG8_WAIT_L(0); PG8_BAR; PG8_MMA(1, 0, At, B0); PG8_MMA(1, 1, At, B1); PG8_BAR; PG8_SCHED;
            PG8_LDB(B0, 1, 0); PG8_LDB(B1, 1, 1); PG8_SCHED; PG8_LDA(At, 1, 0); PG8_STAGE(PG8_SA(0, 1), a2 + hstep, voffA);
            PG8_WAIT_V(8); PG8_WAIT_L(0); PG8_BAR; PG8_MMA(0, 0, At, B0); PG8_MMA(0, 1, At, B1); PG8_BAR; PG8_SCHED;
            PG8_LDA(At, 1, 1); PG8_STAGE(PG8_SB(1, 0), b3, voffB); PG8_STAGE(PG8_SB(1, 1), b3 + hstep, voffB); PG8_STAGE(PG8_SA(1, 0), a3, voffA);
            PG8_WAIT_V(8); PG8_WAIT_L(0); PG8_BAR; PG8_MMA(1, 0, At, B0); PG8_MMA(1, 1, At, B1); PG8_BAR; PG8_SCHED;
            } else {
            PG8_LDB(B0, 0, 0); PG8_SCHED; PG8_LDA(At, 0, 0); PG8_STAGE(PG8_SA(1, 1), a1 + hstep, voffA);
            PG8_WAIT_L(8); PG8_BAR; PG8_WAIT_L(0); PG8_MMA(0, 0, At, B0); PG8_BAR; PG8_SCHED;
            PG8_LDB(B1, 0, 1); PG8_STAGE(PG8_SB(0, 0), b2, voffB);
            PG8_BAR; PG8_WAIT_L(0); PG8_MMA(0, 1, At, B1); PG8_BAR;
            PG8_LDA(At, 0, 1); PG8_STAGE(PG8_SA(0, 0), a2, voffA);
            PG8_BAR; PG8_WAIT_L(0); PG8_MMA(1, 0, At, B0); PG8_BAR; PG8_SCHED;
            PG8_STAGE(PG8_SB(0, 1), b2 + hstep, voffB);
            PG8_WAIT_V(6); PG8_BAR; PG8_MMA(1, 1, At, B1); PG8_BAR;
            PG8_LDB(B0, 1, 0); PG8_SCHED; PG8_LDA(At, 1, 0); PG8_STAGE(PG8_SA(0, 1), a2 + hstep, voffA);
            PG8_WAIT_L(8); PG8_BAR; PG8_WAIT_L(0); PG8_MMA(0, 0, At, B0); PG8_BAR; PG8_SCHED;
            PG8_LDB(B1, 1, 1); PG8_STAGE(PG8_SB(1, 0), b3, voffB);
            PG8_BAR; PG8_WAIT_L(0); PG8_MMA(0, 1, At, B1); PG8_BAR;
            PG8_LDA(At, 1, 1); PG8_STAGE(PG8_SA(1, 0), a3, voffA);
            PG8_BAR; PG8_WAIT_L(0); PG8_MMA(1, 0, At, B0); PG8_BAR; PG8_SCHED;
            PG8_STAGE(PG8_SB(1, 1), b3 + hstep, voffB);
            PG8_WAIT_V(6); PG8_BAR; PG8_MMA(1, 1, At, B1); PG8_BAR;
            }
        }
        if constexpr (ALIGN_EPI) { if (wr == 0) PG8_BAR; }
        if constexpr (!Epi::AFTER_DRAIN) { if constexpr (Epi::XCHG) E.xchg(acc, cur, wr, wc, fr, fq, lds + STAGE_BYTES, wid, lane); else E(acc, cur, wr, wc, fr, fq); S.done(cur); }
        if (!has_next) break;
#pragma unroll
        for (int a = 0; a < 2; ++a)
#pragma unroll
            for (int b = 0; b < 2; ++b)
#pragma unroll
                for (int m = 0; m < 4; ++m)
#pragma unroll
                    for (int n = 0; n < 2; ++n) acc[a][b][m][n] = (f32x4){0.f, 0.f, 0.f, 0.f};
        cur = nxt; cA = nA; cB = nB; ++ui;
        if constexpr (ALIGN_EPI) { if (wr == 1) PG8_BAR; }
    }
    PG8_WAIT_V(0);
    if constexpr (!ALIGN_EPI) { if (wr == 0) PG8_BAR; }
    PG8_BAR;
    if constexpr (Epi::AFTER_DRAIN) { E.fused(acc, cur, wr, wc, fr, fq, lds, wid, lane); S.done(cur); }
#undef PG8_SA
#undef PG8_SB
#undef PG8_STAGE
#undef PG8_LDA
#undef PG8_LDB
#undef PG8_MMA
#undef PG8_WAIT_V
#undef PG8_WAIT_L
#undef PG8_BAR
#undef PG8_SCHED
}
}
#define LAS __attribute__((address_space(3)))
typedef unsigned short bf16_t;
typedef short bf16x8 __attribute__((ext_vector_type(8)));
typedef float f32x4 __attribute__((ext_vector_type(4)));
typedef float f32x2 __attribute__((ext_vector_type(2)));
typedef float f32x16 __attribute__((ext_vector_type(16)));
typedef unsigned u32x4 __attribute__((ext_vector_type(4)));
typedef unsigned u32x2 __attribute__((ext_vector_type(2)));
constexpr int NB = 2, SEQ = 16384, MTOK = NB * SEQ, DM = 2048, NP = 4608, INW = 4480, AW = 1536, SW = 512;
constexpr int COL_Q = 0, COL_K = 1536, COL_V = 1728, COL_ZA = 2048, COL_U = 3584, COL_ZS = 4096;
constexpr int NCH = SEQ / 64;
constexpr float EPSN = 1e-5f, LOG2E = 1.4426950408889634f, QSCALE = 0.125f * LOG2E;
constexpr int KPARTS = 16;
constexpr size_t MiB = 1u << 20;
constexpr size_t WS_WIN = 0, WS_WOUT = 18 * MiB, WS_GLU = 26 * MiB, WS_MODP = 27 * MiB, WS_GATE = 28 * MiB, WS_BIASP = 28 * MiB + 65536,
                 WS_ABAR = 28 * MiB + 131072, WS_A64 = WS_ABAR + 16384, WS_BCAT = 28 * MiB + 196608, WS_CCAT = WS_BCAT + 131072,
                 WS_SSQA = 29 * MiB, WS_SSQO = 30 * MiB, WS_SC = 34 * MiB, WS_HC = 42 * MiB, WS_HB = 64 * MiB, WS_PROJ = 192 * MiB, WS_END = 480 * MiB;
constexpr int LDS_BYTES = 147456;
#ifndef MK_FUSE_FINAL
#define MK_FUSE_FINAL 1
#endif
constexpr int NPHASE = MK_FUSE_FINAL ? 7 : 8;
#ifndef MK_ONE_LAUNCH
#define MK_ONE_LAUNCH 1
#endif

typedef __bf16 bf16x2_t __attribute__((ext_vector_type(2)));
__device__ __forceinline__ unsigned pkbf(float lo, float hi) { const f32x2 v = {lo, hi}; const bf16x2_t b = __builtin_convertvector(v, bf16x2_t); return __builtin_bit_cast(unsigned, b); }
__device__ __forceinline__ float bflo(unsigned v) { return __uint_as_float(v << 16); }
__device__ __forceinline__ float bfhi(unsigned v) { return __uint_as_float(v & 0xffff0000u); }
__device__ __forceinline__ float wave_sum(float v) {
#pragma unroll
    for (int o = 1; o < 64; o <<= 1) v += __shfl_xor(v, o);
    return v;
}
#define LDS_WAIT() asm volatile("s_waitcnt lgkmcnt(0)" ::: "memory")

constexpr size_t WS_BAR = 51 * MiB, WS_PCNT = WS_BAR + 16384, WS_XSLOT = 52 * MiB; constexpr int LDS_ST_OFF = LDS_BYTES - 64;
#define XB_TMO      128
#define XB_XCNT(j)  (256  + 64 * (j))
#define XB_XSUB(j)  (1280 + 64 * (j))
#define XB_XGEN(j)  (2304 + 64 * (j))
#define XB_TOP      3328
#define XB_TOPGEN   3392
#define XCD_BAR_WORDS 3456
#define XB_SPIN_CAP (1u << 18)

__device__ __forceinline__ unsigned xb_ld(unsigned* p)              { return __hip_atomic_load(p, __ATOMIC_RELAXED, __HIP_MEMORY_SCOPE_AGENT); }
__device__ __forceinline__ unsigned xb_add(unsigned* p, unsigned v) { return __hip_atomic_fetch_add(p, v, __ATOMIC_RELAXED, __HIP_MEMORY_SCOPE_AGENT); }
__device__ __forceinline__ unsigned xb_xcc_id() { return (unsigned)__builtin_amdgcn_s_getreg((3 << 11) | 20) & 0xFu; }
#define XB_SPIN(cond, bar) do { unsigned _sp = 0; while (cond) { __builtin_amdgcn_s_sleep(1); \
    if ((++_sp & 255u) == 0u) { if (xb_ld(&(bar)[XB_TMO])) break; if (_sp > XB_SPIN_CAP) { atomicAdd(&(bar)[XB_TMO], 1u); break; } } } } while (0)

struct XcdBarrier {
    unsigned* bar; unsigned x;
    volatile LAS unsigned* st;
};

__device__ __forceinline__ XcdBarrier xcd_barrier_post(unsigned* bar, volatile LAS unsigned* st) {
    XcdBarrier b; b.bar = bar; b.x = xb_xcc_id(); b.st = st;
    if (threadIdx.x == 0) (void)xb_add(&bar[XB_XCNT(b.x)], 1u);
    return b;
}
__device__ __forceinline__ void xcd_barrier_complete(unsigned* bar, unsigned x, unsigned& nloc, unsigned& nx) {
    const unsigned G = gridDim.x * gridDim.y * gridDim.z;
    unsigned sum, cnt, mine, sp = 0u;
    for (;;) {
        sum = 0u; cnt = 0u; mine = 0u;
#pragma unroll
        for (unsigned j = 0; j < 16; ++j) { const unsigned c = xb_ld(&bar[XB_XCNT(j)]); sum += c; cnt += (c > 0u) ? 1u : 0u; mine = (j == x) ? c : mine; }
        if (sum == G) break;
        __builtin_amdgcn_s_sleep(1);
        if ((++sp & 255u) == 0u) { if (xb_ld(&bar[XB_TMO])) break; if (sp > XB_SPIN_CAP) { atomicAdd(&bar[XB_TMO], 1u); break; } }
    }
    nloc = mine > 0u ? mine : 1u; nx = cnt > 0u ? cnt : 1u;
}

__device__ __forceinline__ void xcd_barrier(const XcdBarrier& b) {
    asm volatile("s_waitcnt vmcnt(0)" ::: "memory");
    __syncthreads();
    if (threadIdx.x == 0) {
        unsigned* bar = b.bar;
        __builtin_amdgcn_s_waitcnt(0);
        unsigned nloc = b.st[0], nx = b.st[1];
        if (nloc == 0u) { xcd_barrier_complete(bar, b.x, nloc, nx); b.st[0] = nloc; b.st[1] = nx; }
        const unsigned old = xb_add(&bar[XB_XSUB(b.x)], 1u);
        const unsigned gen = old / nloc;
        if (old + 1u == (gen + 1u) * nloc) {
            __builtin_amdgcn_fence(__ATOMIC_RELEASE, "agent");
            asm volatile("s_waitcnt vmcnt(0)" ::: "memory");
            const unsigned og = xb_add(&bar[XB_TOP], 1u);
            const unsigned tg = og / nx;
            if (og + 1u == (tg + 1u) * nx) xb_add(&bar[XB_TOPGEN], 1u);
            else XB_SPIN(xb_ld(&bar[XB_TOPGEN]) == tg, bar);
            __builtin_amdgcn_fence(__ATOMIC_ACQUIRE, "agent");
            xb_add(&bar[XB_XGEN(b.x)], 1u);
            asm volatile("s_waitcnt vmcnt(0)" ::: "memory");
        } else {
            XB_SPIN(xb_ld(&bar[XB_XGEN(b.x)]) == gen, bar);
            __builtin_amdgcn_fence(__ATOMIC_ACQUIRE, "agent");
            asm volatile("s_waitcnt vmcnt(0)" ::: "memory");
        }
    }
    __syncthreads();
}


struct Args { const float* in[22]; float* out; unsigned char* ws; int ph_lo, ph_hi; };

__device__ __forceinline__ void transpose_item(const float* W, int ldw, int src_n0, int k0, bf16_t* WT, int K, int dst_n0, LAS float* scr, int lane) {
    if (src_n0 >= 0) {
#pragma unroll
        for (int i = 0; i < 32; ++i) { const int kk = 2 * i + (lane >> 5); scr[kk * 33 + (lane & 31)] = W[(size_t)(k0 + kk) * ldw + src_n0 + (lane & 31)]; }
    }
    LDS_WAIT();
    const int c = lane & 7;
#pragma unroll
    for (int j = 0; j < 4; ++j) { const int n = (lane >> 3) + 8 * j; const LAS float* s = scr + (8 * c) * 33 + n;
        u32x4 o = (u32x4){0u, 0u, 0u, 0u};
        if (src_n0 >= 0) { o.x = pkbf(s[0 * 33], s[1 * 33]); o.y = pkbf(s[2 * 33], s[3 * 33]); o.z = pkbf(s[4 * 33], s[5 * 33]); o.w = pkbf(s[6 * 33], s[7 * 33]); }
        *(u32x4*)(WT + (size_t)(dst_n0 + n) * K + k0 + 8 * c) = o; }
    LDS_WAIT();
}

__device__ __forceinline__ void phase0(const Args& a, LAS unsigned char* lds, int G, int blk, int tid, int wid, int lane) {
    unsigned char* ws = a.ws;
    LAS float* scr = (LAS float*)(lds + wid * 8448);
    LAS float* sil = (LAS float*)(lds + 69632);
    const int gw = blk * 8 + wid, NGW = G * 8;
    for (int k = tid; k < 2 * DM; k += 512) { const float cv = a.in[1][k]; sil[k] = cv / (1.0f + __expf(-cv)); }
    __syncthreads();
    {
        const float* wa = a.in[2]; const float* ba = a.in[3]; float* modp = (float*)(ws + WS_MODP);
        constexpr int NJ = 3 * DM / 64, KL = DM / KPARTS;
        for (int it = gw; it < NJ * KPARTS; it += NGW) {
            const int jg = it % NJ, kp = it / NJ, j = 64 * jg + lane; float a0 = 0.f, a1 = 0.f;
            const float* wp = wa + (size_t)(kp * KL) * (3 * DM) + j;
#pragma unroll 32
            for (int k = 0; k < KL; ++k) { const float w = wp[(size_t)k * (3 * DM)]; a0 += sil[kp * KL + k] * w; a1 += sil[DM + kp * KL + k] * w; }
            if (kp == 0) { const float bb = ba[j]; a0 += bb; a1 += bb; }
            modp[(size_t)(kp * 2 + 0) * (3 * DM) + j] = a0; modp[(size_t)(kp * 2 + 1) * (3 * DM) + j] = a1;
        }
    }
    { float* bp = (float*)(ws + WS_BIASP); const float* bi = a.in[6];
      for (int n = blk * 512 + tid; n < NP; n += G * 512) bp[n] = n < 1920 ? bi[n] : (n < 2048 ? 0.f : bi[n - 128]); }
    {
        const float *lre = a.in[9], *lim = a.in[10], *lst = a.in[11], *bre = a.in[12], *bim = a.in[13], *cre = a.in[14], *cim = a.in[15];
        float* abar = (float*)(ws + WS_ABAR); float* a64 = (float*)(ws + WS_A64); bf16_t* Bcat = (bf16_t*)(ws + WS_BCAT); bf16_t* Ccat = (bf16_t*)(ws + WS_CCAT);
        for (int e = (G - 1 - blk) * 512 + tid; e < 32 * 64 * 16; e += G * 512) {
            const int gp = e >> 4, cch = e & 15, g = gp >> 6, p = gp & 63;
            const float step = expf(lst[g]), lr = lre[gp], li = lim[gp];
            const float decay = expf(lr * step); const float ar = decay * cosf(li * step), ai = decay * sinf(li * step);
            const float den = lr * lr + li * li, nr = ar - 1.0f, ni = ai;
            const float cr_ = (nr * lr + ni * li) / den, ci_ = (ni * lr - nr * li) / den;
            if (cch == 0) { abar[2 * gp] = ar; abar[2 * gp + 1] = ai; float pr = ar, pi = ai;
#pragma unroll
                for (int s = 0; s < 6; ++s) { const float tr = pr * pr - pi * pi, ti = 2.0f * pr * pi; pr = tr; pi = ti; }
                a64[2 * gp] = pr; a64[2 * gp + 1] = pi; }
            const float br = bre[e], bi = bim[e];
            const float xr = cr_ * br - ci_ * bi, xi = cr_ * bi + ci_ * br;
            Bcat[((size_t)g * 128 + 2 * p) * 16 + cch] = (bf16_t)(pkbf(xr, 0.f) & 0xffffu);
            Bcat[((size_t)g * 128 + 2 * p + 1) * 16 + cch] = (bf16_t)(pkbf(xi, 0.f) & 0xffffu);
            const float c_r = cre[((size_t)g * 16 + cch) * 64 + p], c_i = cim[((size_t)g * 16 + cch) * 64 + p];
            *(unsigned*)(Ccat + ((size_t)g * 16 + cch) * 128 + 2 * p) = pkbf(c_r, -c_i);
        }
    }
}

__device__ __forceinline__ void phase1(const Args& a, LAS unsigned char* lds, int G, int blk, int tid, int wid, int lane) {
    unsigned char* ws = a.ws;
    const int rpb = MTOK / G, row_lo = blk * rpb, batch = row_lo / SEQ;
    LAS float* gs = (LAS float*)lds; LAS float* sh = gs + DM;
    const float* modp = (const float*)(ws + WS_MODP); const float* ng = a.in[4];
    for (int j = tid; j < DM; j += 512) { float s0 = 0.f, s1 = 0.f, s2 = 0.f;
#pragma unroll
        for (int kp = 0; kp < KPARTS; ++kp) { const float* mp = modp + (size_t)(kp * 2 + batch) * (3 * DM); s0 += mp[j]; s1 += mp[DM + j]; s2 += mp[2 * DM + j]; }
        gs[j] = ng[j] * (1.0f + s1); sh[j] = s0;
        if (row_lo % SEQ == 0) ((float*)(ws + WS_GATE))[batch * DM + j] = s2; }
    __syncthreads();
    if (wid >= 4) {
        LAS float* scr = (LAS float*)(lds + 16384 + (wid - 4) * 8448);
        const int gw = blk * 4 + (wid - 4), NGW = G * 4;
    constexpr int I_IN = (DM / 64) * (NP / 32), I_OUT = (DM / 64) * (DM / 32), I_GLU = (SW / 64) * (SW / 32);
    for (int it = gw; it < I_IN + I_OUT + I_GLU; it += NGW) {
        int r = it;
        if (r < I_IN) { const int nblk = NP / 32, kb = r / nblk, nb = r % nblk, n0 = 32 * nb; const int src = n0 < 1920 ? n0 : (n0 < 2048 ? -1 : n0 - 128);
            transpose_item(a.in[5], INW, src, 64 * kb, (bf16_t*)(ws + WS_WIN), DM, n0, scr, lane); continue; }
        r -= I_IN;
        if (r < I_OUT) { const int nblk = DM / 32, kb = r / nblk, nb = r % nblk; transpose_item(a.in[20], DM, 32 * nb, 64 * kb, (bf16_t*)(ws + WS_WOUT), DM, 32 * nb, scr, lane); continue; }
        r -= I_OUT;
        { const int nblk = SW / 32, kb = r / nblk, nb = r % nblk; transpose_item(a.in[17], SW, 32 * nb, 64 * kb, (bf16_t*)(ws + WS_GLU), SW, 32 * nb, scr, lane); }
    }
        return;
    }
    const float* x = a.in[0]; bf16_t* hb = (bf16_t*)(ws + WS_HB);
    for (int r = row_lo + 2 * wid; r < row_lo + rpb; r += 8) {
        const f32x4* xr = (const f32x4*)(x + (size_t)r * DM) + lane; f32x4 v[2][8]; float ss[2] = {0.f, 0.f};
#pragma unroll
        for (int q = 0; q < 2; ++q)
#pragma unroll
            for (int i = 0; i < 8; ++i) v[q][i] = xr[q * (DM / 4) + 64 * i];
#pragma unroll
        for (int q = 0; q < 2; ++q)
#pragma unroll
            for (int i = 0; i < 8; ++i) ss[q] += (v[q][i][0] * v[q][i][0] + v[q][i][1] * v[q][i][1]) + (v[q][i][2] * v[q][i][2] + v[q][i][3] * v[q][i][3]);
#pragma unroll
        for (int q = 0; q < 2; ++q) {
            const float rstd = 1.0f / sqrtf(wave_sum(ss[q]) * (1.0f / DM) + EPSN);
            u32x2* o = (u32x2*)(hb + (size_t)(r + q) * DM) + lane;
#pragma unroll
            for (int i = 0; i < 8; ++i) { const f32x4 g4 = *(const LAS f32x4*)(gs + 4 * (lane + 64 * i)), s4 = *(const LAS f32x4*)(sh + 4 * (lane + 64 * i));
                const f32x4 h = v[q][i] * rstd * g4 + s4; u32x2 w; w.x = pkbf(h[0], h[1]); w.y = pkbf(h[2], h[3]); o[64 * i] = w; }
        }
    }
}

#define MFMA32(A, B, C) __builtin_amdgcn_mfma_f32_32x32x16_bf16(A, B, C, 0, 0, 0)
#define MFMA16(A, B, C) __builtin_amdgcn_mfma_f32_16x16x32_bf16(A, B, C, 0, 0, 0)
__device__ __forceinline__ void attn_unit(const Args& a, LAS unsigned char* lds, int b, int kvh, int qb, int tid, int wid, int lane) {
    const bf16_t* proj = (const bf16_t*)(a.ws + WS_PROJ); bf16_t* mixed = (bf16_t*)(a.ws + WS_HB); float* ssqa = (float*)(a.ws + WS_SSQA);
    const int r32 = lane & 31, hi = lane >> 5;
    LAS bf16_t* KS = (LAS bf16_t*)lds;
    LAS bf16_t* VT = (LAS bf16_t*)(lds + 36864);
    LAS bf16_t* OST = (LAS bf16_t*)(lds + 70656 + wid * 4608);
    LAS float* SSQ = (LAS float*)(lds + 107520);
    const long tok0 = (long)b * SEQ + qb * 128;
#pragma unroll
    for (int i = 0; i < 4; ++i) { const int id = tid + 512 * i, row = id >> 3, ch = id & 7;
        u32x4 v = (u32x4){0u, 0u, 0u, 0u};
        if (qb > 0 || row >= 128) v = *(const u32x4*)(proj + (size_t)(tok0 - 128 + row) * NP + COL_K + kvh * 64 + ch * 8);
        *(LAS u32x4*)(KS + row * 72 + ch * 8) = v; }
#pragma unroll
    for (int i = 0; i < 4; ++i) { const int id = tid + 512 * i, row = id & 255, ch = id >> 8;
        u32x4 v = (u32x4){0u, 0u, 0u, 0u};
        if (qb > 0 || row >= 128) v = *(const u32x4*)(proj + (size_t)(tok0 - 128 + row) * NP + COL_V + kvh * 64 + ch * 8);
#pragma unroll
        for (int e = 0; e < 8; ++e) VT[(ch * 8 + e) * 264 + row] = (bf16_t)((v[e >> 1] >> (16 * (e & 1))) & 0xffffu); }
    const int head = kvh * 8 + wid;
    bf16x8 qn[4];
#pragma unroll
    for (int ds = 0; ds < 4; ++ds) qn[ds] = *(const bf16x8*)(proj + (size_t)(tok0 + r32) * NP + COL_Q + head * 64 + 16 * ds + 8 * hi);
    __syncthreads();
    const float sink2 = a.in[7][head] * LOG2E;
    const int oc = (lane & 7) * 8;
    const f32x4 g0 = *(const f32x4*)(a.in[8] + head * 64 + oc), g1 = *(const f32x4*)(a.in[8] + head * 64 + oc + 4);
    const float NEG = -1.0e30f;
    for (int s = 0; s < 4; ++s) {
        bf16x8 qf[4];
#pragma unroll
        for (int ds = 0; ds < 4; ++ds) qf[ds] = qn[ds];
        if (s < 3) { const size_t qtok = (size_t)(tok0 + 32 * (s + 1) + r32);
#pragma unroll
            for (int ds = 0; ds < 4; ++ds) qn[ds] = *(const bf16x8*)(proj + qtok * NP + COL_Q + head * 64 + 16 * ds + 8 * hi); }
        u32x4 zp[4];
#pragma unroll
        for (int i = 0; i < 4; ++i) zp[i] = *(const u32x4*)(proj + (size_t)(tok0 + 32 * s + 8 * i + (lane >> 3)) * NP + COL_ZA + head * 64 + oc);
        f32x16 S[5];
#pragma unroll
        for (int j = 0; j < 5; ++j) { const int kb0 = 32 * (s + j); f32x16 acc = {};
#pragma unroll
            for (int ds = 0; ds < 4; ++ds) { const bf16x8 kf = *(const LAS bf16x8*)(KS + (kb0 + r32) * 72 + 16 * ds + 8 * hi); acc = MFMA32(kf, qf[ds], acc); }
            S[j] = acc; }
#pragma unroll
        for (int r = 0; r < 16; ++r) { const int kk = (r & 3) + 8 * (r >> 2) + 4 * hi; if (kk <= r32) S[0][r] = NEG; if (kk > r32) S[4][r] = NEG; }
        if (qb == 0) {
#pragma unroll
            for (int j = 0; j < 4; ++j) if (s + j < 4) {
#pragma unroll
                for (int r = 0; r < 16; ++r) S[j][r] = NEG; } }
        float m = NEG;
#pragma unroll
        for (int j = 0; j < 5; ++j)
#pragma unroll
            for (int r = 0; r < 16; ++r) m = fmaxf(m, S[j][r]);
        m = fmaxf(m, __shfl_xor(m, 32));
        float l = 0.f;
#pragma unroll
        for (int j = 0; j < 5; ++j)
#pragma unroll
            for (int r = 0; r < 16; ++r) { const float p = __builtin_amdgcn_exp2f(S[j][r] - m); S[j][r] = p; l += p; }
        l += __shfl_xor(l, 32); l += __builtin_amdgcn_exp2f(sink2 - m);
        f32x16 O[2]; O[0] = (f32x16){}; O[1] = (f32x16){};
#pragma unroll
        for (int j = 0; j < 5; ++j)
#pragma unroll
            for (int s2 = 0; s2 < 2; ++s2) {
                u32x4 pw; pw.x = pkbf(S[j][8 * s2 + 0], S[j][8 * s2 + 1]); pw.y = pkbf(S[j][8 * s2 + 2], S[j][8 * s2 + 3]); pw.z = pkbf(S[j][8 * s2 + 4], S[j][8 * s2 + 5]); pw.w = pkbf(S[j][8 * s2 + 6], S[j][8 * s2 + 7]);
                const bf16x8 pf = __builtin_bit_cast(bf16x8, pw);
                const int kv0 = 32 * (s + j) + 16 * s2 + 4 * hi;
#pragma unroll
                for (int dt = 0; dt < 2; ++dt) { const int d = 32 * dt + r32;
                    const u32x2 lo = *(const LAS u32x2*)(VT + d * 264 + kv0), hh = *(const LAS u32x2*)(VT + d * 264 + kv0 + 8);
                    const u32x4 vw = (u32x4){lo.x, lo.y, hh.x, hh.y};
                    O[dt] = MFMA32(__builtin_bit_cast(bf16x8, vw), pf, O[dt]); }
            }
        const float inv = 1.0f / l; float ss = 0.f;
#pragma unroll
        for (int dt = 0; dt < 2; ++dt)
#pragma unroll
            for (int r = 0; r < 16; ++r) { const float o = O[dt][r] * inv; O[dt][r] = o; ss += o * o; }
        ss += __shfl_xor(ss, 32);
        if (hi == 0) SSQ[wid * 128 + 32 * s + r32] = ss;
#pragma unroll
        for (int dt = 0; dt < 2; ++dt)
#pragma unroll
            for (int rg = 0; rg < 4; ++rg) { u32x2 w; w.x = pkbf(O[dt][4 * rg], O[dt][4 * rg + 1]); w.y = pkbf(O[dt][4 * rg + 2], O[dt][4 * rg + 3]);
                *(LAS u32x2*)(OST + r32 * 72 + 32 * dt + 8 * rg + 4 * hi) = w; }
        LDS_WAIT();
#pragma unroll
        for (int i = 0; i < 4; ++i) { const int row = 8 * i + (lane >> 3); const size_t tok = (size_t)(tok0 + 32 * s + row);
            const u32x4 o8 = *(const LAS u32x4*)(OST + row * 72 + oc);
            const u32x4 z8 = zp[i];
            u32x4 w;
            w.x = pkbf(bflo(o8.x) * g0[0] * bflo(z8.x), bfhi(o8.x) * g0[1] * bfhi(z8.x));
            w.y = pkbf(bflo(o8.y) * g0[2] * bflo(z8.y), bfhi(o8.y) * g0[3] * bfhi(z8.y));
            w.z = pkbf(bflo(o8.z) * g1[0] * bflo(z8.z), bfhi(o8.z) * g1[1] * bfhi(z8.z));
            w.w = pkbf(bflo(o8.w) * g1[2] * bflo(z8.w), bfhi(o8.w) * g1[3] * bfhi(z8.w));
#ifdef DBG_NO_ATTN
            w = (u32x4){0u, 0u, 0u, 0u};
#endif
            *(u32x4*)(mixed + tok * DM + head * 64 + oc) = w; }
        LDS_WAIT();
    }
    __syncthreads();
    if (tid < 128) { float t = 0.f;
#pragma unroll
        for (int w = 0; w < 8; ++w) t += SSQ[w * 128 + tid];
        ssqa[(size_t)kvh * MTOK + tok0 + tid] = t; }
    __syncthreads();
}

__device__ __forceinline__ f32x2 gelu_pk(f32x2 v) {
    const f32x2 av = __builtin_elementwise_abs(v), d = av * 0.2316418882f + 1.0f;
    f32x2 t; t.x = __builtin_amdgcn_rcpf(d.x); t.y = __builtin_amdgcn_rcpf(d.y);
    f32x2 q = t * 0.5307027145f + (-0.7265760135f); q = q * t + 0.7107068705f; q = q * t + (-0.142248368f); q = q * t + 0.127414796f; q = q * t;
    const f32x2 s = (v * v) * (-0.72134752044f);
    f32x2 e; e.x = __builtin_amdgcn_exp2f(s.x); e.y = __builtin_amdgcn_exp2f(s.y);
    const f32x2 mm = v * (q * e), r = v - mm;
    f32x2 o; o.x = v.x < 0.f ? mm.x : r.x; o.y = v.y < 0.f ? mm.y : r.y; return o;
}
template <bool FINAL>
__device__ __forceinline__ void ssm_unit(const Args& a, LAS unsigned char* lds, int b, int c64, int tid, int wid, int lane, int next_u = -1) {
    const bf16_t* proj = (const bf16_t*)(a.ws + WS_PROJ); bf16_t* mixed = (bf16_t*)(a.ws + WS_HB);
    const float* abar = (const float*)(a.ws + WS_ABAR); const bf16_t* Bcat = (const bf16_t*)(a.ws + WS_BCAT); const bf16_t* Ccat = (const bf16_t*)(a.ws + WS_CCAT);
    f32x2* Sc = (f32x2*)(a.ws + WS_SC); const f32x2* Hc = (const f32x2*)(a.ws + WS_HC);
    LAS bf16_t* BUF = (LAS bf16_t*)(lds + wid * 8704);
    LAS bf16_t* TILE = (LAS bf16_t*)(lds + 69632);
    LAS float* SSQ2 = (LAS float*)(lds + 136192);
    const size_t tok0 = (size_t)b * SEQ + 64 * c64;
    const int r32 = lane & 31, hi = lane >> 5, r16 = lane & 15, q4 = lane >> 4;
#if defined(PROBE_P5) && PROBE_P5 == 2
    for (int rp_ = 0; rp_ < (FINAL ? 2 : 1); ++rp_) {
    if (rp_) __syncthreads();
#else
    {
#endif
    if (!FINAL) {
#pragma unroll
    for (int i = 0; i < 8; ++i) { const int id = tid + 512 * i, row = id >> 6, ch = id & 63;
        *(LAS u32x4*)(TILE + row * 520 + ch * 8) = *(const u32x4*)(proj + (tok0 + row) * NP + COL_U + ch * 8); }
    }
    bf16x8 bcN[4], ccN[4]; f32x2 abN, h0N = {0.f, 0.f}; f32x4 d4N = {0.f, 0.f, 0.f, 0.f};
#define SSM_LOADC(G_) do { const int g_ = (G_); \
        _Pragma("unroll") for (int jt = 0; jt < 4; ++jt) bcN[jt] = *(const bf16x8*)(Bcat + ((size_t)(g_ * 128 + 32 * jt + r32) * 16 + 8 * hi)); \
        abN = *(const f32x2*)(abar + (size_t)(g_ * 64 + lane) * 2); \
        if (FINAL) { h0N = Hc[((size_t)(b * NCH + c64) * 32 + g_) * 64 + lane]; d4N = *(const f32x4*)(a.in[16] + g_ * 16 + 4 * q4); \
            _Pragma("unroll") for (int ks = 0; ks < 4; ++ks) ccN[ks] = *(const bf16x8*)(Ccat + ((size_t)(g_ * 16 + r16) * 128 + 32 * ks + 8 * q4)); } } while (0)
    SSM_LOADC(wid);
    __syncthreads();
    for (int gi = 0; gi < 4; ++gi) {
        const int g = wid + 8 * gi;
        bf16x8 bc[4], cc[4];
#pragma unroll
        for (int i = 0; i < 4; ++i) { bc[i] = bcN[i]; cc[i] = ccN[i]; }
        const float ar = abN[0], ai = abN[1]; float hr = h0N[0], hq = h0N[1]; const f32x4 d4 = d4N;
        const size_t sidx = ((size_t)(b * NCH + c64) * 32 + g) * 64 + lane;
        if (gi < 3) SSM_LOADC(g + 8);
        for (int hh = 0; hh < 2; ++hh) {
            const bf16x8 uf = *(const LAS bf16x8*)(TILE + (32 * hh + r32) * 520 + g * 16 + 8 * hi);
#pragma unroll
            for (int jt = 0; jt < 4; ++jt) { f32x16 d = {}; d = MFMA32(bc[jt], uf, d);
#pragma unroll
                for (int rg = 0; rg < 4; ++rg) { u32x2 w; w.x = pkbf(d[4 * rg], d[4 * rg + 1]); w.y = pkbf(d[4 * rg + 2], d[4 * rg + 3]);
                    *(LAS u32x2*)(BUF + r32 * 136 + 32 * jt + 8 * rg + 4 * hi) = w; } }
            LDS_WAIT();
#pragma unroll
            for (int t0 = 0; t0 < 32; t0 += 8) { unsigned v[8];
#pragma unroll
                for (int i = 0; i < 8; ++i) v[i] = *(const LAS unsigned*)(BUF + (t0 + i) * 136 + 2 * lane);
#pragma unroll
                for (int i = 0; i < 8; ++i) { const float bur = bflo(v[i]), bui = bfhi(v[i]);
                    const float nr = fmaf(ar, hr, fmaf(-ai, hq, bur)), ni = fmaf(ar, hq, fmaf(ai, hr, bui)); hr = nr; hq = ni;
                    if (FINAL) *(LAS unsigned*)(BUF + (t0 + i) * 136 + 2 * lane) = pkbf(hr, hq); } }
            if (FINAL) {
                LDS_WAIT();
#pragma unroll
                for (int tt = 0; tt < 2; ++tt) { f32x4 y = {};
#pragma unroll
                    for (int ks = 0; ks < 4; ++ks) { const bf16x8 hf = *(const LAS bf16x8*)(BUF + (16 * tt + r16) * 136 + 32 * ks + 8 * q4); y = MFMA16(cc[ks], hf, y); }
                    const int tl = 32 * hh + 16 * tt + r16;
                    const u32x2 u4 = *(const LAS u32x2*)(TILE + tl * 520 + g * 16 + 4 * q4);
                    const f32x2 ga = gelu_pk((f32x2){y[0] + d4[0] * bflo(u4.x), y[1] + d4[1] * bfhi(u4.x)}), gb = gelu_pk((f32x2){y[2] + d4[2] * bflo(u4.y), y[3] + d4[3] * bfhi(u4.y)});
                    u32x2 w; w.x = pkbf(ga.x, ga.y); w.y = pkbf(gb.x, gb.y);
                    *(LAS u32x2*)(TILE + tl * 520 + g * 16 + 4 * q4) = w; }
                LDS_WAIT();
            }
        }
        if (!FINAL) Sc[sidx] = (f32x2){hr, hq};
    }
    }
#undef SSM_LOADC
    if (!FINAL) __syncthreads();
    if (FINAL) {
        const bf16_t* glu = (const bf16_t*)(a.ws + WS_GLU);
        __syncthreads();
#if defined(PROBE_P5) && PROBE_P5 == 3
        for (int i = tid; i < 64 * 65; i += 512) ((LAS u32x4*)lds)[i] = ((const LAS u32x4*)(lds + 69632))[i];
        __syncthreads();
        _Pragma("nounroll") for (int rp3_ = 0; rp3_ < a.ph_hi - 5; ++rp3_) {
        if (rp3_) { for (int i = tid; i < 64 * 65; i += 512) ((LAS u32x4*)(lds + 69632))[i] = ((const LAS u32x4*)lds)[i]; __syncthreads(); }
#else
        {
#endif
        f32x16 acc[2][2];
#pragma unroll
        for (int i = 0; i < 2; ++i)
#pragma unroll
            for (int j = 0; j < 2; ++j) acc[i][j] = (f32x16){};
        const int nb = 64 * wid;
        bf16x8 gA0[4][2], gA1[4][2];
        const bf16_t* gl0 = glu + (size_t)(nb + r32) * SW + 8 * hi;
#define GLU_LOAD(BUFV, c) do { _Pragma("unroll") for (int k4 = 0; k4 < 4; ++k4) { BUFV[k4][0] = *(const bf16x8*)(gl0 + 16 * (4 * (c) + k4)); BUFV[k4][1] = *(const bf16x8*)(gl0 + 32 * SW + 16 * (4 * (c) + k4)); } } while (0)
#define GLU_MMA(BUFV, c) do { _Pragma("unroll") for (int k4 = 0; k4 < 4; ++k4) { const int ks = 4 * (c) + k4; bf16x8 bf[2]; \
            _Pragma("unroll") for (int tt = 0; tt < 2; ++tt) bf[tt] = *(const LAS bf16x8*)(TILE + (32 * tt + r32) * 520 + 16 * ks + 8 * hi); \
            _Pragma("unroll") for (int nt = 0; nt < 2; ++nt) _Pragma("unroll") for (int tt = 0; tt < 2; ++tt) acc[nt][tt] = MFMA32(BUFV[k4][nt], bf[tt], acc[nt][tt]); } } while (0)
#if defined(PROBE_P5) && PROBE_P5 == 1
        for (int rp_ = 0; rp_ < 2; ++rp_) {
        for (int i = 0; i < 2; ++i) for (int j = 0; j < 2; ++j) acc[i][j] = (f32x16){};
#else
        {
#endif
        GLU_LOAD(gA0, 0);
#pragma unroll 1
        for (int c = 0; c < 8; c += 2) {
            GLU_LOAD(gA1, c + 1);
            asm volatile("" ::: "memory");
            GLU_MMA(gA0, c);
            if (c + 2 < 8) GLU_LOAD(gA0, c + 2);
            asm volatile("" ::: "memory");
            GLU_MMA(gA1, c + 1);
        }
        }
#undef GLU_LOAD
#undef GLU_MMA
#pragma unroll
        for (int tt = 0; tt < 2; ++tt) { const int t = 32 * tt + r32; float ss = 0.f;
#pragma unroll
            for (int nt = 0; nt < 2; ++nt)
#pragma unroll
                for (int rg = 0; rg < 4; ++rg) { const int n0 = nb + 32 * nt + 8 * rg + 4 * hi;
                    const u32x2 s4 = *(const LAS u32x2*)(TILE + t * 520 + n0); const f32x4 b4 = *(const f32x4*)(a.in[18] + n0);
                    const float sv[4] = {bflo(s4.x), bfhi(s4.x), bflo(s4.y), bfhi(s4.y)};
#pragma unroll
                    for (int e = 0; e < 4; ++e) { const float gl = acc[nt][tt][4 * rg + e] + b4[e]; const float gv = sv[e] * __builtin_amdgcn_rcpf(1.0f + __builtin_amdgcn_exp2f(-LOG2E * gl));
                        acc[nt][tt][4 * rg + e] = gv; ss += gv * gv; } }
            ss += __shfl_xor(ss, 32);
            if (hi == 0) SSQ2[wid * 64 + t] = ss; }
        u32x4 zpre[8];
#pragma unroll
        for (int i = 0; i < 8; ++i) { const int id = tid + 512 * i, row = id >> 6, ch = id & 63; zpre[i] = *(const u32x4*)(proj + (tok0 + row) * NP + COL_ZS + ch * 8); }
        __syncthreads();
#pragma unroll
        for (int tt = 0; tt < 2; ++tt) { const int t = 32 * tt + r32; float tot = 0.f;
#pragma unroll
            for (int w = 0; w < 8; ++w) tot += SSQ2[w * 64 + t];
            const float* sq = (const float*)(a.ws + WS_SSQA) + tok0 + t;
            const float rstd = sqrtf((((sq[0] + sq[MTOK]) + sq[2 * MTOK]) * (1.0f / AW) + EPSN) / (tot * (1.0f / SW) + EPSN));
#pragma unroll
            for (int nt = 0; nt < 2; ++nt)
#pragma unroll
                for (int rg = 0; rg < 4; ++rg) { const int n0 = nb + 32 * nt + 8 * rg + 4 * hi; const f32x4 g4 = *(const f32x4*)(a.in[19] + n0);
                    u32x2 w; w.x = pkbf(acc[nt][tt][4 * rg] * rstd * g4[0], acc[nt][tt][4 * rg + 1] * rstd * g4[1]); w.y = pkbf(acc[nt][tt][4 * rg + 2] * rstd * g4[2], acc[nt][tt][4 * rg + 3] * rstd * g4[3]);
                    *(LAS u32x2*)(TILE + t * 520 + n0) = w; } }
        __syncthreads();
#pragma unroll
        for (int i = 0; i < 8; ++i) { const int id = tid + 512 * i, row = id >> 6, ch = id & 63;
            const u32x4 o8 = *(const LAS u32x4*)(TILE + row * 520 + ch * 8);
            const u32x4 z8 = zpre[i];
            u32x4 w;
            w.x = pkbf(bflo(o8.x) * bflo(z8.x), bfhi(o8.x) * bfhi(z8.x)); w.y = pkbf(bflo(o8.y) * bflo(z8.y), bfhi(o8.y) * bfhi(z8.y));
            w.z = pkbf(bflo(o8.z) * bflo(z8.z), bfhi(o8.z) * bfhi(z8.z)); w.w = pkbf(bflo(o8.w) * bflo(z8.w), bfhi(o8.w) * bfhi(z8.w));
#ifdef DBG_NO_SSM
            w = (u32x4){0u, 0u, 0u, 0u};
#endif
#ifdef DBG_SAN_SSM
            { unsigned* wp = (unsigned*)&w; for (int e = 0; e < 4; ++e) { unsigned x = wp[e]; if ((x & 0x7f80u) == 0x7f80u) x &= 0xffff0000u; if ((x & 0x7f800000u) == 0x7f800000u) x &= 0xffffu; wp[e] = x; } }
#endif
            *(u32x4*)(mixed + (tok0 + row) * DM + AW + ch * 8) = w; }
        __syncthreads();
        if (next_u >= 0) { const size_t tokn = (size_t)(next_u / NCH) * SEQ + 64 * (next_u % NCH);
#pragma unroll
            for (int i = 0; i < 8; ++i) { const int id = tid + 512 * i, row = id >> 6, ch = id & 63;
                *(LAS u32x4*)(TILE + row * 520 + ch * 8) = *(const u32x4*)(proj + (tokn + row) * NP + COL_U + ch * 8); } }
        }
    }
}

__device__ __forceinline__ void ssm_local_unit2(const Args& a, LAS unsigned char* lds, int b, int c64, int wid, int lane) {
    const bf16_t* proj = (const bf16_t*)(a.ws + WS_PROJ);
    const float* abar = (const float*)(a.ws + WS_ABAR); const bf16_t* Bcat = (const bf16_t*)(a.ws + WS_BCAT);
    f32x2* Sc = (f32x2*)(a.ws + WS_SC);
    LAS bf16_t* BA = (LAS bf16_t*)(lds + wid * 17408);
    LAS bf16_t* BB = BA + 32 * 136;
    const size_t tok0 = (size_t)b * SEQ + 64 * c64;
    const int r32 = lane & 31, hi = lane >> 5;
    bf16x8 uf[4][2];
#pragma unroll
    for (int gi = 0; gi < 4; ++gi)
#pragma unroll
        for (int hh = 0; hh < 2; ++hh) uf[gi][hh] = *(const bf16x8*)(proj + (tok0 + 32 * hh + r32) * NP + COL_U + (wid + 8 * gi) * 16 + 8 * hi);
#pragma unroll
    for (int pr = 0; pr < 2; ++pr) {
        const int gA = wid + 16 * pr, gB = gA + 8;
        bf16x8 bcA[4], bcB[4];
#pragma unroll
        for (int jt = 0; jt < 4; ++jt) { bcA[jt] = *(const bf16x8*)(Bcat + ((size_t)(gA * 128 + 32 * jt + r32) * 16 + 8 * hi)); bcB[jt] = *(const bf16x8*)(Bcat + ((size_t)(gB * 128 + 32 * jt + r32) * 16 + 8 * hi)); }
        const f32x2 aA = *(const f32x2*)(abar + (size_t)(gA * 64 + lane) * 2), aB = *(const f32x2*)(abar + (size_t)(gB * 64 + lane) * 2);
        float hrA = 0.f, hqA = 0.f, hrB = 0.f, hqB = 0.f;
#pragma unroll
        for (int hh = 0; hh < 2; ++hh) {
#pragma unroll
            for (int jt = 0; jt < 4; ++jt) { f32x16 dA = {}, dB = {}; dA = MFMA32(bcA[jt], uf[2 * pr][hh], dA); dB = MFMA32(bcB[jt], uf[2 * pr + 1][hh], dB);
#pragma unroll
                for (int rg = 0; rg < 4; ++rg) { u32x2 w; w.x = pkbf(dA[4 * rg], dA[4 * rg + 1]); w.y = pkbf(dA[4 * rg + 2], dA[4 * rg + 3]);
                    *(LAS u32x2*)(BA + r32 * 136 + 32 * jt + 8 * rg + 4 * hi) = w;
                    u32x2 x; x.x = pkbf(dB[4 * rg], dB[4 * rg + 1]); x.y = pkbf(dB[4 * rg + 2], dB[4 * rg + 3]);
                    *(LAS u32x2*)(BB + r32 * 136 + 32 * jt + 8 * rg + 4 * hi) = x; } }
            LDS_WAIT();
#pragma unroll
            for (int t0 = 0; t0 < 32; t0 += 8) { unsigned vA[8], vB[8];
#pragma unroll
                for (int i = 0; i < 8; ++i) { vA[i] = *(const LAS unsigned*)(BA + (t0 + i) * 136 + 2 * lane); vB[i] = *(const LAS unsigned*)(BB + (t0 + i) * 136 + 2 * lane); }
#pragma unroll
                for (int i = 0; i < 8; ++i) {
                    const float nrA = fmaf(aA[0], hrA, fmaf(-aA[1], hqA, bflo(vA[i]))), niA = fmaf(aA[0], hqA, fmaf(aA[1], hrA, bfhi(vA[i]))); hrA = nrA; hqA = niA;
                    const float nrB = fmaf(aB[0], hrB, fmaf(-aB[1], hqB, bflo(vB[i]))), niB = fmaf(aB[0], hqB, fmaf(aB[1], hrB, bfhi(vB[i]))); hrB = nrB; hqB = niB; } }
            LDS_WAIT();
        }
        Sc[((size_t)(b * NCH + c64) * 32 + gA) * 64 + lane] = (f32x2){hrA, hqA};
        Sc[((size_t)(b * NCH + c64) * 32 + gB) * 64 + lane] = (f32x2){hrB, hqB};
    }
}

__device__ __forceinline__ void phase_carry(const Args& a, LAS unsigned char* lds, int blk, int wid, int lane) {
    if (blk >= NB * 32) return;
    const int b = blk >> 5, g = blk & 31;
    const f32x2 aa = *(const f32x2*)((const float*)(a.ws + WS_A64) + (size_t)(g * 64 + lane) * 2);
    const f32x2* Sc = (const f32x2*)(a.ws + WS_SC); f32x2* Hc = (f32x2*)(a.ws + WS_HC);
    LAS f32x2* E = (LAS f32x2*)lds;
    const size_t base = ((size_t)(b * NCH + 32 * wid) * 32 + g) * 64 + lane;
    f32x2 s[32];
#pragma unroll
    for (int i = 0; i < 32; ++i) s[i] = Sc[base + (size_t)i * 2048];
    float hr = 0.f, hq = 0.f;
#pragma unroll
    for (int i = 0; i < 32; ++i) { const float sr = s[i][0], si = s[i][1]; s[i] = (f32x2){hr, hq};
        const float nr = fmaf(aa[0], hr, fmaf(-aa[1], hq, sr)), ni = fmaf(aa[0], hq, fmaf(aa[1], hr, si)); hr = nr; hq = ni; }
    E[wid * 64 + lane] = (f32x2){hr, hq};
    float pr = aa[0], pi = aa[1];
#pragma unroll
    for (int q = 0; q < 5; ++q) { const float tr = pr * pr - pi * pi, ti = 2.0f * pr * pi; pr = tr; pi = ti; }
    __syncthreads();
    float cr = 0.f, ci = 0.f;
    for (int v = 0; v < wid; ++v) { const f32x2 e = E[v * 64 + lane]; const float nr = fmaf(pr, cr, fmaf(-pi, ci, e[0])), ni = fmaf(pr, ci, fmaf(pi, cr, e[1])); cr = nr; ci = ni; }
#pragma unroll
    for (int i = 0; i < 32; ++i) { Hc[base + (size_t)i * 2048] = (f32x2){s[i][0] + cr, s[i][1] + ci};
        const float nr = aa[0] * cr - aa[1] * ci, ni = aa[0] * ci + aa[1] * cr; cr = nr; ci = ni; }
    __syncthreads();
}

__device__ __forceinline__ void phase_final(const Args& a, int G, int blk, int wid, int lane) {
    const float* ssqo = (const float*)(a.ws + WS_SSQO); const float* fg = a.in[21]; float* out = a.out;
    f32x4 g4[8];
#pragma unroll
    for (int i = 0; i < 8; ++i) g4[i] = *((const f32x4*)fg + lane + 64 * i);
    for (int r = blk * 8 + wid; r < MTOK; r += G * 8) {
        float s = lane < 32 ? ssqo[(size_t)lane * MTOK + r] : 0.f;
        const float rstd = 1.0f / sqrtf(wave_sum(s) * (1.0f / DM) + EPSN);
        f32x4* o = (f32x4*)(out + (size_t)r * DM) + lane;
#pragma unroll
        for (int i = 0; i < 8; ++i) { const f32x4 v = o[64 * i]; o[64 * i] = v * rstd * g4[i]; }
    }
}

__global__ void __launch_bounds__(512, 2) mk_fwd(Args a) {
    extern __shared__ __attribute__((aligned(16))) unsigned char lds_raw[];
    LAS unsigned char* lds = (LAS unsigned char*)lds_raw;
    cg::grid_group grid = cg::this_grid();
    const int tid = threadIdx.x, lane = tid & 63, wid = __builtin_amdgcn_readfirstlane(tid >> 6);
    const int G = gridDim.x, blk = blockIdx.x;
    const int lo = a.ph_lo, hi_ph = a.ph_hi;
    if (tid < 16) ((LAS unsigned*)(lds + LDS_ST_OFF))[tid] = 0u;
    __syncthreads();
    XcdBarrier bar = xcd_barrier_post((unsigned*)(a.ws + WS_BAR), (volatile LAS unsigned*)(lds + LDS_ST_OFF));
    if (hi_ph > 1000) grid.sync();
#define IN(k) (lo <= (k) && (k) < hi_ph)
#define SEAM(k) do { if ((k) + 1 < hi_ph) xcd_barrier(bar); } while (0)
#ifndef REPMASK
#define REPMASK 0
#endif
#define NREP(k) (((REPMASK >> (k)) & 1) ? 2 : 1)
    if (IN(0)) for (int rep_ = 0; rep_ < NREP(0); ++rep_) { if (rep_) xcd_barrier(bar);
#ifndef OFF_P0
        phase0(a, lds, G, blk, tid, wid, lane);
#endif
        SEAM(0); }
#ifdef EXTRA_SYNCS
    for (int es_ = 0; es_ < EXTRA_SYNCS; ++es_) xcd_barrier(bar);
#endif
    if (IN(1)) for (int rep_ = 0; rep_ < NREP(1); ++rep_) { if (rep_) xcd_barrier(bar);
#ifndef OFF_P1
        phase1(a, lds, G, blk, tid, wid, lane);
#endif
        SEAM(1); }
    if (IN(2)) for (int rep_ = 0; rep_ < NREP(2); ++rep_) { if (rep_) xcd_barrier(bar);
#ifndef OFF_P2
        pg8::Gemm g{(const bf16_t*)(a.ws + WS_HB), (const bf16_t*)(a.ws + WS_WIN), MTOK, NP, DM}; pg8::StaticOrder S; S.init(MTOK, NP, G, blk);
        pg8::EpiProj E{(bf16_t*)(a.ws + WS_PROJ), NP, (const float*)(a.ws + WS_BIASP), QSCALE};
        pg8::gemm_phase<pg8::EpiProj, pg8::StaticOrder, true, true>(lds, g, S, E);
#endif
        SEAM(2); }
    if (IN(3)) for (int rep_ = 0; rep_ < NREP(3); ++rep_) { if (rep_) xcd_barrier(bar);
        constexpr int NATT = NB * 3 * (SEQ / 128), NSSM = NB * NCH;
#ifndef OFF_P3A
        for (int L = blk; L < NATT; L += G) { const int qb = L % (SEQ / 128), r = L / (SEQ / 128), kvh = r % 3, b = r / 3; attn_unit(a, lds, b, kvh, qb, tid, wid, lane); }
#endif
#ifndef OFF_P3B
        for (int u = blk; u < NSSM; u += G) ssm_local_unit2(a, lds, u / NCH, u % NCH, wid, lane);
        __syncthreads();
#endif
        SEAM(3); }
    if (IN(4)) for (int rep_ = 0; rep_ < NREP(4); ++rep_) { if (rep_) xcd_barrier(bar);
#ifndef OFF_P4
        phase_carry(a, lds, blk, wid, lane);
#endif
        if (blk < NB * NCH) {
            const bf16_t* proj = (const bf16_t*)(a.ws + WS_PROJ); const size_t tok0 = (size_t)(blk / NCH) * SEQ + 64 * (blk % NCH);
#pragma unroll
            for (int i = 0; i < 8; ++i) { const int id = tid + 512 * i, row = id >> 6, ch = id & 63;
                *(LAS u32x4*)((LAS bf16_t*)(lds + 69632) + row * 520 + ch * 8) = *(const u32x4*)(proj + (tok0 + row) * NP + COL_U + ch * 8); }
        }
        SEAM(4); }
    if (IN(5)) for (int rep_ = 0; rep_ < NREP(5); ++rep_) { if (rep_) xcd_barrier(bar);
#ifndef OFF_P5
        for (int u = blk; u < NB * NCH; u += G) ssm_unit<true>(a, lds, u / NCH, u % NCH, tid, wid, lane, (u + G < NB * NCH) ? u + G : -1);
#endif
        SEAM(5); }
    if (IN(6)) for (int rep_ = 0; rep_ < NREP(6); ++rep_) { if (rep_) xcd_barrier(bar);
#ifndef OFF_P6
        pg8::Gemm g{(const bf16_t*)(a.ws + WS_HB), (const bf16_t*)(a.ws + WS_WOUT), MTOK, DM, DM};
#if MK_FUSE_FINAL
        pg8::OutOrder S{blk};
        pg8::EpiOutFused E{a.in[0], a.out, (const float*)(a.ws + WS_GATE), (const float*)(a.ws + WS_SSQA), a.in[21], (float*)(a.ws + WS_XSLOT), (unsigned*)(a.ws + WS_PCNT), MTOK, DM, SEQ};
        pg8::gemm_phase<pg8::EpiOutFused, pg8::OutOrder, true, true>(lds, g, S, E);
#else
        pg8::StaticOrder S; S.init(MTOK, DM, G, blk);
        pg8::EpiOut E{a.in[0], a.out, (const float*)(a.ws + WS_GATE), (const float*)(a.ws + WS_SSQA), (float*)(a.ws + WS_SSQO), MTOK, DM, SEQ};
        pg8::gemm_phase<pg8::EpiOut, pg8::StaticOrder, true, true>(lds, g, S, E);
#endif
#endif
        SEAM(6); }
    if (IN(7)) {
#if !defined(OFF_P7) && !MK_FUSE_FINAL
        phase_final(a, G, blk, wid, lane);
#endif
    }
#undef IN
#undef SEAM
}

extern "C" void kernel_launch(void* const* d_in, const int* in_sizes, int n_in, void* d_out, int out_size, void* d_ws, size_t ws_size, hipStream_t stream) {
    static int grid = 0;
    if (grid == 0) {
        int dev = 0, cus = 0, per_cu = 0;
        if (n_in != 22 || ws_size < WS_END) { fprintf(stderr, "kernel_launch: unexpected n_in %d / ws_size %zu\n", n_in, ws_size); grid = -1; return; }
        (void)hipGetDevice(&dev); (void)hipDeviceGetAttribute(&cus, hipDeviceAttributeMultiprocessorCount, dev);
        if (hipFuncSetAttribute((const void*)mk_fwd, hipFuncAttributeMaxDynamicSharedMemorySize, LDS_BYTES) != hipSuccess) { fprintf(stderr, "kernel_launch: hipFuncSetAttribute failed\n"); grid = -1; return; }
        if (hipOccupancyMaxActiveBlocksPerMultiprocessor(&per_cu, (const void*)mk_fwd, 512, LDS_BYTES) != hipSuccess || per_cu < 1) { fprintf(stderr, "kernel_launch: occupancy query gave %d\n", per_cu); per_cu = 1; (void)hipGetLastError(); }
        grid = cus * per_cu;
        while (grid > 0 && (MTOK % grid != 0 || SEQ % (MTOK / grid) != 0)) --grid;
    }
    if (grid <= 0) return;
#if MK_FUSE_FINAL
    if (grid != 256) { fprintf(stderr, "kernel_launch: the fused final-norm epilogue needs a 256-workgroup grid, got %d\n", grid); return; }
#endif
    (void)hipMemsetAsync((unsigned char*)d_ws + WS_BAR, 0, 16384 + 32768, stream);
    Args a{};
    for (int i = 0; i < 22; ++i) a.in[i] = (const float*)d_in[i];
    a.out = (float*)d_out; a.ws = (unsigned char*)d_ws;
#if MK_ONE_LAUNCH
    a.ph_lo = 0; a.ph_hi = NPHASE;
    void* args[] = {&a};
    hipError_t e = hipLaunchCooperativeKernel((const void*)mk_fwd, dim3(grid), dim3(512), args, LDS_BYTES, stream);
    if (e != hipSuccess) fprintf(stderr, "cooperative launch failed: %s (grid %d)\n", hipGetErrorString(e), grid);
#else
    for (int p = 0; p < NPHASE; ++p) { a.ph_lo = p; a.ph_hi = p + 1; hipLaunchKernelGGL(mk_fwd, dim3(grid), dim3(512), LDS_BYTES, stream, a); }
#endif
}
```

```cpp
#include <hip/hip_runtime.h>
#include <hip/hip_cooperative_groups.h>
#include <cstdio>
#include <cstdint>
namespace cg = cooperative_groups;
#define MK_ONE_LAUNCH 1
namespace pg8 {
#define PG8_LAS __attribute__((address_space(3)))
typedef unsigned short bf16_t;
typedef short bf16x8 __attribute__((ext_vector_type(8)));
typedef float f32x4 __attribute__((ext_vector_type(4)));
typedef unsigned u32x4 __attribute__((ext_vector_type(4)));
constexpr int BM = 256, BK = 64, HALF = 128, HTB = HALF * BK * 2  , STAGE_BYTES = 8 * HTB, NXCD = 8, WGM = 8;

__host__ __device__ __forceinline__ int lds_byte(int r, int c) { const int st = (r >> 4) * 2 + (c >> 5), rr = r & 15, cc = c & 31, ob = rr * 64 + cc * 2; return st * 1024 + (ob ^ (((ob >> 9) & 1) << 5)); }
__host__ __device__ __forceinline__ void stage_rc(int b, int& R, int& C) { const int st = b / 1024, sb = b % 1024, swz = sb ^ (((sb >> 9) & 1) << 5); R = (st >> 1) * 16 + swz / 64; C = (st & 1) * 32 + (swz % 64) / 2; }
__host__ __device__ __forceinline__ int perm32(int rho) { const int n = rho >> 4, i = rho & 15; return 8 * (i >> 2) + 4 * n + (i & 3); }

struct Unit { int pm, pn; };
struct Gemm { const bf16_t* A; const bf16_t* Bt; int M, N, K; };

struct StaticOrder {
    int nM, nN, nwg, G, c;
    __host__ __device__ void init(int M, int N, int G_, int c_) { nM = M / BM; nN = N / BM; nwg = nM * nN; G = G_; c = c_; }
    __host__ __device__ bool next(int i, Unit& u) const {
        const long L = (long)i * G + c; if (L >= nwg) return false;
        int wgid = (int)L; { const int q = nwg / NXCD, r = nwg % NXCD, xcd = wgid % NXCD, off = wgid / NXCD; wgid = (xcd < r ? xcd * (q + 1) : r * (q + 1) + (xcd - r) * q) + off; }
        const int nig = WGM * nN, gid = wgid / nig, fm = gid * WGM, gsz = (nM - fm) < WGM ? (nM - fm) : WGM;
        u.pm = fm + ((wgid % nig) % gsz); u.pn = (wgid % nig) / gsz; return true;
    }
    __device__ __forceinline__ void a_ready(const Unit&) const {}
    __device__ __forceinline__ void done(const Unit&) const {}
};

__device__ __forceinline__ unsigned cvt_pk_bf16(float lo, float hi) { unsigned r; asm volatile("v_cvt_pk_bf16_f32 %0, %1, %2" : "=v"(r) : "v"(lo), "v"(hi)); return r; }
#ifdef DBG_STAGE
#define DBG_MIX(x) ((f32x4){0.f, 0.f, 0.f, 0.f})
#else
#define DBG_MIX(x) (x)
#endif
typedef unsigned u32x4 __attribute__((ext_vector_type(4)));
__device__ __forceinline__ float silu_f(float v) { return v * __builtin_amdgcn_rcpf(1.0f + __builtin_amdgcn_exp2f(-1.4426950408889634f * v)); }
struct EpiProj {
    static constexpr bool PERM = true, AFTER_DRAIN = false, XCHG = false;
    bf16_t* O; int ldc; const float* bias; float qscale;
    __device__ __forceinline__ void operator()(const f32x4 (&acc)[2][2][4][2], const Unit& u, int wr, int wc, int fr, int fq) const {
        asm volatile("" : "+v"(fr), "+v"(fq));
        const int row0 = u.pm * BM + wr * 64 + fr; const int pn = u.pn;
        const int mode = (pn < 6) ? 1 : (((pn >= 8 && pn < 14) || pn >= 16) ? 2 : 0);
        const float sc = mode == 1 ? qscale : 1.f;
        const int col0 = pn * BM + wc * 32 + 8 * fq;
        f32x4 bv[2][2];
#pragma unroll
        for (int bj = 0; bj < 2; ++bj)
#pragma unroll
            for (int n = 0; n < 2; ++n) bv[bj][n] = *(const f32x4*)(bias + col0 + bj * HALF + 4 * n);
#pragma unroll
        for (int ai = 0; ai < 2; ++ai)
#pragma unroll
            for (int m = 0; m < 4; ++m) { bf16_t* rowp = O + (size_t)(row0 + ai * HALF + m * 16) * ldc + col0;
#pragma unroll
                for (int bj = 0; bj < 2; ++bj) { f32x4 v0 = acc[ai][bj][m][0] + bv[bj][0], v1 = acc[ai][bj][m][1] + bv[bj][1];
                    if (mode == 2) {
#pragma unroll
                        for (int e = 0; e < 4; ++e) { v0[e] = silu_f(v0[e]); v1[e] = silu_f(v1[e]); } }
                    v0 = v0 * sc; v1 = v1 * sc; u32x4 w; w.x = cvt_pk_bf16(v0[0], v0[1]); w.y = cvt_pk_bf16(v0[2], v0[3]); w.z = cvt_pk_bf16(v1[0], v1[1]); w.w = cvt_pk_bf16(v1[2], v1[3]);
                    *(u32x4*)(rowp + bj * HALF) = w; } }
    }
};
struct EpiOut {
    static constexpr bool PERM = true, AFTER_DRAIN = false, XCHG = false;
    const float* x; float* out; const float* gate; const float* ssqa; float* ssqo; int M_, ldc, seq;
    __device__ __forceinline__ void operator()(const f32x4 (&acc)[2][2][4][2], const Unit& u, int wr, int wc, int fr, int fq) const {
        const int col0 = u.pn * BM + wc * 32 + 8 * fq; const int batch = (u.pm * BM) / seq;
        f32x4 gv[2][2];
#pragma unroll
        for (int bj = 0; bj < 2; ++bj)
#pragma unroll
            for (int n = 0; n < 2; ++n) gv[bj][n] = *(const f32x4*)(gate + batch * ldc + col0 + bj * HALF + n * 4);
#pragma unroll
        for (int ai = 0; ai < 2; ++ai)
#pragma unroll
            for (int m = 0; m < 4; ++m) { const int row = u.pm * BM + ai * HALF + wr * 64 + m * 16 + fr; const size_t off = (size_t)row * ldc + col0; float ss = 0.f;
                const float ra = __builtin_amdgcn_rsqf(((ssqa[row] + ssqa[M_ + row]) + ssqa[2 * M_ + row]) * (1.0f / 1536.0f) + 1e-5f);
#pragma unroll
                for (int bj = 0; bj < 2; ++bj)
#pragma unroll
                    for (int n = 0; n < 2; ++n) { const f32x4 xv = *(const f32x4*)(x + off + bj * HALF + n * 4); const f32x4 y = xv + DBG_MIX(gv[bj][n] * (acc[ai][bj][m][n] * ra));
                        *(f32x4*)(out + off + bj * HALF + n * 4) = y; ss += (y[0] * y[0] + y[1] * y[1]) + (y[2] * y[2] + y[3] * y[3]); }
                ss += __shfl_xor(ss, 16); ss += __shfl_xor(ss, 32);
                if (fq == 0) ssqo[(size_t)(u.pn * 4 + wc) * M_ + row] = ss;
                asm volatile("" ::: "memory"); }
    }
};

struct OutOrder {
    int c;
    __device__ __forceinline__ bool next(int i, Unit& u) const { if (i >= 4) return false; const int x = c & 7, j = c >> 3; u.pm = (i * 8 + x) * 4 + (j >> 3); u.pn = j & 7; return true; }
    __device__ __forceinline__ void a_ready(const Unit&) const {}
    __device__ __forceinline__ void done(const Unit&) const {}
};
struct EpiOutFused {
    static constexpr bool PERM = true, AFTER_DRAIN = false, XCHG = true;
    __device__ __forceinline__ void touch(int pm, int pn, int tid) const {
        asm volatile("" : "+v"(tid));
        const unsigned o = (unsigned)((pm * BM + (tid >> 3)) * ldc + pn * BM + (tid & 7) * 32), st = 64u * (unsigned)ldc;
        const float t = (x[o] + x[o + st]) + (x[o + 2u * st] + x[o + 3u * st]);
        if (t == 1.2345678e-33f) out[0] = t;
    }
    const float* x; float* out; const float* gate; const float* ssqa; const float* fgain; float* slots; unsigned* cnt; int M_, ldc, seq;
    __device__ __forceinline__ void xchg(f32x4 (&acc)[2][2][4][2], const Unit& u, int wr, int wc, int fr, int fq, PG8_LAS unsigned char* xl, int wid, int lane) const {
        asm volatile("" : "+v"(fr), "+v"(fq), "+v"(lane));
        PG8_LAS float* P = (PG8_LAS float*)xl;
        PG8_LAS float* S = (PG8_LAS float*)(xl + 4096);
        asm volatile("" ::: "memory");
        const int col0 = u.pn * BM + wc * 32 + 8 * fq; const int batch = (u.pm * BM) / seq;
        {
            f32x4 gv[2][2];
#pragma unroll
            for (int bj = 0; bj < 2; ++bj)
#pragma unroll
                for (int n = 0; n < 2; ++n) gv[bj][n] = *(const f32x4*)(gate + batch * ldc + col0 + bj * HALF + n * 4);
#pragma unroll
            for (int ai = 0; ai < 2; ++ai)
#pragma unroll
                for (int m = 0; m < 4; ++m) { const int lrow = ai * HALF + wr * 64 + m * 16 + fr, row = u.pm * BM + lrow; const size_t off = (size_t)row * ldc + col0; float ss = 0.f;
                    const float ra = __builtin_amdgcn_rsqf(((ssqa[row] + ssqa[M_ + row]) + ssqa[2 * M_ + row]) * (1.0f / 1536.0f) + 1e-5f);
#pragma unroll
                    for (int bj = 0; bj < 2; ++bj)
#pragma unroll
                        for (int n = 0; n < 2; ++n) { const f32x4 xv = *(const f32x4*)(x + off + bj * HALF + n * 4); const f32x4 y = xv + gv[bj][n] * (acc[ai][bj][m][n] * ra);
                            acc[ai][bj][m][n] = y; ss += (y[0] * y[0] + y[1] * y[1]) + (y[2] * y[2] + y[3] * y[3]); }
                    ss += __shfl_xor(ss, 16); ss += __shfl_xor(ss, 32);
                    if (fq == 0) P[lrow * 4 + wc] = ss;
                    asm volatile("" ::: "memory"); }
        }
        asm volatile("s_waitcnt lgkmcnt(0)" ::: "memory"); __builtin_amdgcn_s_barrier(); asm volatile("" ::: "memory");
        const int tid = wid * 64 + lane;
        if (wid < 4) {
            const float s = (P[tid * 4 + 0] + P[tid * 4 + 1]) + (P[tid * 4 + 2] + P[tid * 4 + 3]);
            __hip_atomic_store(slots + ((size_t)(u.pm * BM + tid) * 8 + u.pn), s, __ATOMIC_RELAXED, __HIP_MEMORY_SCOPE_AGENT);
            asm volatile("s_waitcnt vmcnt(0)" ::: "memory");
            if (lane == 0) __hip_atomic_fetch_add(cnt + 64 * u.pm, 1u, __ATOMIC_RELAXED, __HIP_MEMORY_SCOPE_AGENT);
        }
        if (wid == 0) {
            unsigned sp = 0;
            while ((unsigned)__builtin_amdgcn_readfirstlane(__hip_atomic_load(cnt + 64 * u.pm, __ATOMIC_RELAXED, __HIP_MEMORY_SCOPE_AGENT)) < 32u) { __builtin_amdgcn_s_sleep(2); if (++sp > (1u << 22)) break; }
            __builtin_amdgcn_fence(__ATOMIC_ACQUIRE, "agent");
        }
        asm volatile("s_waitcnt vmcnt(0) lgkmcnt(0)" ::: "memory"); __builtin_amdgcn_s_barrier(); asm volatile("" ::: "memory");
        if (wid < 4) {
            const float* sl = slots + (size_t)(u.pm * BM + tid) * 8; float t = 0.f;
#pragma unroll
            for (int k = 0; k < 8; ++k) t += __hip_atomic_load(sl + k, __ATOMIC_RELAXED, __HIP_MEMORY_SCOPE_AGENT);
            S[tid] = __builtin_amdgcn_rsqf(t * (1.0f / 2048.0f) + 1e-5f);
        }
        asm volatile("s_waitcnt lgkmcnt(0)" ::: "memory"); __builtin_amdgcn_s_barrier(); asm volatile("" ::: "memory");
#pragma unroll
        for (int ai = 0; ai < 2; ++ai)
#pragma unroll
            for (int m = 0; m < 4; ++m) { const int lrow = ai * HALF + wr * 64 + m * 16 + fr; const float r = S[lrow]; const size_t off = (size_t)(u.pm * BM + lrow) * ldc + col0;
#pragma unroll
                for (int bj = 0; bj < 2; ++bj)
#pragma unroll
                    for (int n = 0; n < 2; ++n) *(f32x4*)(out + off + bj * HALF + n * 4) = acc[ai][bj][m][n] * r * *(const f32x4*)(fgain + col0 + bj * HALF + n * 4); }
    }
};
template <class Epi, class Sched, bool ALIGN_EPI = false, bool SP2 = false>
__device__ __forceinline__ void gemm_phase(PG8_LAS unsigned char* lds, const Gemm g, const Sched& S, const Epi& E) {
    const int tid = threadIdx.x, wid = __builtin_amdgcn_readfirstlane(tid >> 6), lane = tid & 63, wr = wid >> 2, wc = wid & 3, fr = lane & 15, fq = lane >> 4;
    const int K = g.K, nt = K / BK;
    unsigned voffA[2], voffB[2];
#pragma unroll
    for (int i = 0; i < 2; ++i) { int R, C; stage_rc(tid * 16 + i * 8192, R, C); const int Rb = Epi::PERM ? ((R & ~31) + perm32(R & 31)) : R;
        voffA[i] = (unsigned)(R * K + C) * 2u; voffB[i] = (unsigned)(Rb * K + C) * 2u; }
    const size_t kstep = (size_t)(BK * 2);
    const size_t hstep = (size_t)HALF * K * 2;
    const size_t tstep = 2 * hstep;
    const unsigned ldsw = (unsigned)wid * 1024u;
    const int aoff = lds_byte(wr * 64 + fr, fq * 8), boff = lds_byte(wc * 32 + fr, fq * 8);
#define PG8_SA(b, h) (((b) * 2 + (h)) * HTB)
#define PG8_SB(b, h) ((4 + (b) * 2 + (h)) * HTB)
#define PG8_STAGE(bufoff, gbase, voff) do { _Pragma("unroll") for (int _i = 0; _i < 2; ++_i) \
        __builtin_amdgcn_global_load_lds((const unsigned*)((const char*)(gbase) + (voff)[_i]), (PG8_LAS unsigned*)(lds + (bufoff) + ldsw + _i * 8192), 16, 0, 0); } while (0)
#define PG8_LDA(dst, b, h) do { _Pragma("unroll") for (int m = 0; m < 4; ++m) _Pragma("unroll") for (int k = 0; k < 2; ++k) dst[m][k] = *(const PG8_LAS bf16x8*)(lds + PG8_SA(b, h) + aoff + m * 2048 + k * 1024); } while (0)
#define PG8_LDB(dst, b, h) do { _Pragma("unroll") for (int n = 0; n < 2; ++n) _Pragma("unroll") for (int k = 0; k < 2; ++k) dst[n][k] = *(const PG8_LAS bf16x8*)(lds + PG8_SB(b, h) + boff + n * 2048 + k * 1024); } while (0)
#define PG8_MMA(ai, bj, At, Bt) do { __builtin_amdgcn_s_setprio(1); _Pragma("unroll") for (int m = 0; m < 4; ++m) _Pragma("unroll") for (int n = 0; n < 2; ++n) _Pragma("unroll") for (int k = 0; k < 2; ++k) \
        acc[ai][bj][m][n] = __builtin_amdgcn_mfma_f32_16x16x32_bf16(Bt[n][k], At[m][k], acc[ai][bj][m][n], 0, 0, 0); __builtin_amdgcn_s_setprio(0); } while (0)
#define PG8_WAIT_V(n) asm volatile("s_waitcnt vmcnt(" #n ")" ::: "memory")
#define PG8_WAIT_L(n) asm volatile("s_waitcnt lgkmcnt(" #n ")" ::: "memory")
#define PG8_BAR __builtin_amdgcn_s_barrier()
#define PG8_SCHED __builtin_amdgcn_sched_barrier(0)
    Unit cur, nxt; int ui = 0;
    if (!S.next(0, cur)) return;
    f32x4 acc[2][2][4][2];
#pragma unroll
    for (int a = 0; a < 2; ++a)
#pragma unroll
        for (int b = 0; b < 2; ++b)
#pragma unroll
            for (int m = 0; m < 4; ++m)
#pragma unroll
                for (int n = 0; n < 2; ++n) acc[a][b][m][n] = (f32x4){0.f, 0.f, 0.f, 0.f};
    bf16x8 At[4][2], B0[2][2], B1[2][2];
    const char* cA = (const char*)g.A + (size_t)cur.pm * tstep; const char* cB = (const char*)g.Bt + (size_t)cur.pn * tstep;
    S.a_ready(cur);
    if constexpr (SP2) {
        PG8_STAGE(PG8_SB(0, 0), cB, voffB); PG8_STAGE(PG8_SB(0, 1), cB + hstep, voffB); PG8_STAGE(PG8_SA(0, 0), cA, voffA); PG8_STAGE(PG8_SA(0, 1), cA + hstep, voffA);
        if (wr == 1) PG8_BAR;
        PG8_WAIT_V(2); PG8_BAR;
        PG8_STAGE(PG8_SB(1, 0), cB + kstep, voffB); PG8_STAGE(PG8_SA(1, 0), cA + kstep, voffA); PG8_STAGE(PG8_SB(1, 1), cB + hstep + kstep, voffB);
        PG8_WAIT_V(6); PG8_BAR;
    } else {
        PG8_STAGE(PG8_SB(0, 0), cB, voffB); PG8_STAGE(PG8_SA(0, 0), cA, voffA); PG8_STAGE(PG8_SB(0, 1), cB + hstep, voffB); PG8_STAGE(PG8_SA(0, 1), cA + hstep, voffA);
        if (wr == 1) PG8_BAR;
        PG8_WAIT_V(4); PG8_BAR;
        PG8_STAGE(PG8_SB(1, 0), cB + kstep, voffB); PG8_STAGE(PG8_SA(1, 0), cA + kstep, voffA); PG8_STAGE(PG8_SB(1, 1), cB + hstep + kstep, voffB);
        PG8_WAIT_V(6); PG8_BAR;
    }
    for (;;) {
        const bool has_next = S.next(ui + 1, nxt);
        const char* nA = has_next ? (const char*)g.A + (size_t)nxt.pm * tstep : cA; const char* nB = has_next ? (const char*)g.Bt + (size_t)nxt.pn * tstep : cB;
        for (int t = 0; t < nt; t += 2) {
            const bool last = (t == nt - 2);
            const char* a1 = cA + (size_t)(t + 1) * kstep;
            const char* a2 = last ? nA : cA + (size_t)(t + 2) * kstep; const char* b2 = last ? nB : cB + (size_t)(t + 2) * kstep;
            const char* a3 = a2 + kstep; const char* b3 = b2 + kstep;
            if (last && has_next) S.a_ready(nxt);
            if constexpr (SP2) {
            PG8_LDB(B0, 0, 0); PG8_LDB(B1, 0, 1); PG8_SCHED; PG8_LDA(At, 0, 0); PG8_STAGE(PG8_SA(1, 1), a1 + hstep, voffA);
            PG8_WAIT_V(8); PG8_WAIT_L(0); PG8_BAR; PG8_MMA(0, 0, At, B0); PG8_MMA(0, 1, At, B1); PG8_BAR; PG8_SCHED;
            PG8_LDA(At, 0, 1); PG8_STAGE(PG8_SB(0, 0), b2, voffB); PG8_STAGE(PG8_SB(0, 1), b2 + hstep, voffB); PG8_STAGE(PG8_SA(0, 0), a2, voffA);
            PG8_WAIT_V(8); PG8_WAIT_L(0); PG8_BAR; PG8_MMA(1, 0, At, B0); PG8_MMA(1, 1, At, B1); PG8_BAR; PG8_SCHED;
            PG8_LDB(B0, 1, 0); PG8_LDB(B1, 1, 1); PG8_SCHED; PG8_LDA(At, 1, 0); PG8_STAGE(PG8_SA(0, 1), a2 + hstep, voffA);
            PG8_WAIT_V(8); PG8_WAIT_L(0); PG8_BAR; PG8_MMA(0, 0, At, B0); PG8_MMA(0, 1, At, B1); PG8_BAR; PG8_SCHED;
            PG8_LDA(At, 1, 1); PG8_STAGE(PG8_SB(1, 0), b3, voffB); PG8_STAGE(PG8_SB(1, 1), b3 + hstep, voffB); PG8_STAGE(PG8_SA(1, 0), a3, voffA);
            PG8_WAIT_V(8); PG8_WAIT_L(0); PG8_BAR; PG8_MMA(1, 0, At, B0); PG8_MMA(1, 1, At, B1); PG8_BAR; PG8_SCHED;
            } else {
            PG8_LDB(B0, 0, 0); PG8_SCHED; PG8_LDA(At, 0, 0); PG8_STAGE(PG8_SA(1, 1), a1 + hstep, voffA);
            PG8_WAIT_L(8); PG8_BAR; PG8_WAIT_L(0); PG8_MMA(0, 0, At, B0); PG8_BAR; PG8_SCHED;
            PG8_LDB(B1, 0, 1); PG8_STAGE(PG8_SB(0, 0), b2, voffB);
            PG8_BAR; PG8_WAIT_L(0); PG8_MMA(0, 1, At, B1); PG8_BAR;
            PG8_LDA(At, 0, 1); PG8_STAGE(PG8_SA(0, 0), a2, voffA);
            PG8_BAR; PG8_WAIT_L(0); PG8_MMA(1, 0, At, B0); PG8_BAR; PG8_SCHED;
            PG8_STAGE(PG8_SB(0, 1), b2 + hstep, voffB);
            PG8_WAIT_V(6); PG8_BAR; PG8_MMA(1, 1, At, B1); PG8_BAR;
            PG8_LDB(B0, 1, 0); PG8_SCHED; PG8_LDA(At, 1, 0); PG8_STAGE(PG8_SA(0, 1), a2 + hstep, voffA);
            PG8_WAIT_L(8); PG8_BAR; PG8_WAIT_L(0); PG8_MMA(0, 0, At, B0); PG8_BAR; PG8_SCHED;
            PG8_LDB(B1, 1, 1); PG8_STAGE(PG8_SB(1, 0), b3, voffB);
            PG8_BAR; PG8_WAIT_L(0); PG8_MMA(0, 1, At, B1); PG8_BAR;
            PG8_LDA(At, 1, 1); PG8_STAGE(PG8_SA(1, 0), a3, voffA);
            PG8_BAR; PG8_WAIT_L(0); PG8_MMA(1, 0, At, B0); PG8_BAR; PG8_SCHED;
            PG8_STAGE(PG8_SB(1, 1), b3 + hstep, voffB);
            PG8_WAIT_V(6); PG8_BAR; PG8_MMA(1, 1, At, B1); PG8_BAR;
            }
        }
        if constexpr (ALIGN_EPI) { if (wr == 0) PG8_BAR; }
        if constexpr (!Epi::AFTER_DRAIN) { if constexpr (Epi::XCHG) E.xchg(acc, cur, wr, wc, fr, fq, lds + STAGE_BYTES, wid, lane); else E(acc, cur, wr, wc, fr, fq); S.done(cur); }
        if (!has_next) break;
#pragma unroll
        for (int a = 0; a < 2; ++a)
#pragma unroll
            for (int b = 0; b < 2; ++b)
#pragma unroll
                for (int m = 0; m < 4; ++m)
#pragma unroll
                    for (int n = 0; n < 2; ++n) acc[a][b][m][n] = (f32x4){0.f, 0.f, 0.f, 0.f};
        cur = nxt; cA = nA; cB = nB; ++ui;
        if constexpr (ALIGN_EPI) { if (wr == 1) PG8_BAR; }
    }
    PG8_WAIT_V(0);
    if constexpr (!ALIGN_EPI) { if (wr == 0) PG8_BAR; }
    PG8_BAR;
    if constexpr (Epi::AFTER_DRAIN) { E.fused(acc, cur, wr, wc, fr, fq, lds, wid, lane); S.done(cur); }
#undef PG8_SA
#undef PG8_SB
#undef PG8_STAGE
#undef PG8_LDA
#undef PG8_LDB
#undef PG8_MMA
#undef PG8_WAIT_V
#undef PG8_WAIT_L
#undef PG8_BAR
#undef PG8_SCHED
}
}
#define LAS __attribute__((address_space(3)))
typedef unsigned short bf16_t;
typedef short bf16x8 __attribute__((ext_vector_type(8)));
typedef float f32x4 __attribute__((ext_vector_type(4)));
typedef float f32x2 __attribute__((ext_vector_type(2)));
typedef float f32x16 __attribute__((ext_vector_type(16)));
typedef unsigned u32x4 __attribute__((ext_vector_type(4)));
typedef unsigned u32x2 __attribute__((ext_vector_type(2)));
constexpr int NB = 2, SEQ = 16384, MTOK = NB * SEQ, DM = 2048, NP = 4608, INW = 4480, AW = 1536, SW = 512;
constexpr int COL_Q = 0, COL_K = 1536, COL_V = 1728, COL_ZA = 2048, COL_U = 3584, COL_ZS = 4096;
constexpr int NCH = SEQ / 64;
constexpr float EPSN = 1e-5f, LOG2E = 1.4426950408889634f, QSCALE = 0.125f * LOG2E;
constexpr int KPARTS = 16;
constexpr size_t MiB = 1u << 20;
constexpr size_t WS_WIN = 0, WS_WOUT = 18 * MiB, WS_GLU = 26 * MiB, WS_MODP = 27 * MiB, WS_GATE = 28 * MiB, WS_BIASP = 28 * MiB + 65536,
                 WS_ABAR = 28 * MiB + 131072, WS_A64 = WS_ABAR + 16384, WS_BCAT = 28 * MiB + 196608, WS_CCAT = WS_BCAT + 131072,
                 WS_SSQA = 29 * MiB, WS_SSQO = 30 * MiB, WS_SC = 34 * MiB, WS_HC = 42 * MiB, WS_HB = 64 * MiB, WS_PROJ = 192 * MiB, WS_END = 480 * MiB;
constexpr int LDS_BYTES = 147456;
#ifndef MK_FUSE_FINAL
#define MK_FUSE_FINAL 1
#endif
constexpr int NPHASE = MK_FUSE_FINAL ? 7 : 8;
#ifndef MK_ONE_LAUNCH
#define MK_ONE_LAUNCH 1
#endif

typedef __bf16 bf16x2_t __attribute__((ext_vector_type(2)));
__device__ __forceinline__ unsigned pkbf(float lo, float hi) { const f32x2 v = {lo, hi}; const bf16x2_t b = __builtin_convertvector(v, bf16x2_t); return __builtin_bit_cast(unsigned, b); }
__device__ __forceinline__ float bflo(unsigned v) { return __uint_as_float(v << 16); }
__device__ __forceinline__ float bfhi(unsigned v) { return __uint_as_float(v & 0xffff0000u); }
__device__ __forceinline__ float wave_sum(float v) {
#pragma unroll
    for (int o = 1; o < 64; o <<= 1) v += __shfl_xor(v, o);
    return v;
}
#define LDS_WAIT() asm volatile("s_waitcnt lgkmcnt(0)" ::: "memory")

constexpr size_t WS_BAR = 51 * MiB, WS_PCNT = WS_BAR + 16384, WS_XSLOT = 52 * MiB; constexpr int LDS_ST_OFF = LDS_BYTES - 64;
#define XB_TMO      128
#define XB_XCNT(j)  (256  + 64 * (j))
#define XB_XSUB(j)  (1280 + 64 * (j))
#define XB_XGEN(j)  (2304 + 64 * (j))
#define XB_TOP      3328
#define XB_TOPGEN   3392
#define XCD_BAR_WORDS 3456
#define XB_SPIN_CAP (1u << 18)

__device__ __forceinline__ unsigned xb_ld(unsigned* p)              { return __hip_atomic_load(p, __ATOMIC_RELAXED, __HIP_MEMORY_SCOPE_AGENT); }
__device__ __forceinline__ unsigned xb_add(unsigned* p, unsigned v) { return __hip_atomic_fetch_add(p, v, __ATOMIC_RELAXED, __HIP_MEMORY_SCOPE_AGENT); }
__device__ __forceinline__ unsigned xb_xcc_id() { return (unsigned)__builtin_amdgcn_s_getreg((3 << 11) | 20) & 0xFu; }
#define XB_SPIN(cond, bar) do { unsigned _sp = 0; while (cond) { __builtin_amdgcn_s_sleep(1); \
    if ((++_sp & 255u) == 0u) { if (xb_ld(&(bar)[XB_TMO])) break; if (_sp > XB_SPIN_CAP) { atomicAdd(&(bar)[XB_TMO], 1u); break; } } } } while (0)

struct XcdBarrier {
    unsigned* bar; unsigned x;
    volatile LAS unsigned* st;
};

__device__ __forceinline__ XcdBarrier xcd_barrier_post(unsigned* bar, volatile LAS unsigned* st) {
    XcdBarrier b; b.bar = bar; b.x = xb_xcc_id(); b.st = st;
    if (threadIdx.x == 0) (void)xb_add(&bar[XB_XCNT(b.x)], 1u);
    return b;
}
__device__ __forceinline__ void xcd_barrier_complete(unsigned* bar, unsigned x, unsigned& nloc, unsigned& nx) {
    const unsigned G = gridDim.x * gridDim.y * gridDim.z;
    unsigned sum, cnt, mine, sp = 0u;
    for (;;) {
        sum = 0u; cnt = 0u; mine = 0u;
#pragma unroll
        for (unsigned j = 0; j < 16; ++j) { const unsigned c = xb_ld(&bar[XB_XCNT(j)]); sum += c; cnt += (c > 0u) ? 1u : 0u; mine = (j == x) ? c : mine; }
        if (sum == G) break;
        __builtin_amdgcn_s_sleep(1);
        if ((++sp & 255u) == 0u) { if (xb_ld(&bar[XB_TMO])) break; if (sp > XB_SPIN_CAP) { atomicAdd(&bar[XB_TMO], 1u); break; } }
    }
    nloc = mine > 0u ? mine : 1u; nx = cnt > 0u ? cnt : 1u;
}

__device__ __forceinline__ void xcd_barrier(const XcdBarrier& b) {
    asm volatile("s_waitcnt vmcnt(0)" ::: "memory");
    __syncthreads();
    if (threadIdx.x == 0) {
        unsigned* bar = b.bar;
        __builtin_amdgcn_s_waitcnt(0);
        unsigned nloc = b.st[0], nx = b.st[1];
        if (nloc == 0u) { xcd_barrier_complete(bar, b.x, nloc, nx); b.st[0] = nloc; b.st[1] = nx; }
        const unsigned old = xb_add(&bar[XB_XSUB(b.x)], 1u);
        const unsigned gen = old / nloc;
        if (old + 1u == (gen + 1u) * nloc) {
            __builtin_amdgcn_fence(__ATOMIC_RELEASE, "agent");
            asm volatile("s_waitcnt vmcnt(0)" ::: "memory");
            const unsigned og = xb_add(&bar[XB_TOP], 1u);
            const unsigned tg = og / nx;
            if (og + 1u == (tg + 1u) * nx) xb_add(&bar[XB_TOPGEN], 1u);
            else XB_SPIN(xb_ld(&bar[XB_TOPGEN]) == tg, bar);
            __builtin_amdgcn_fence(__ATOMIC_ACQUIRE, "agent");
            xb_add(&bar[XB_XGEN(b.x)], 1u);
            asm volatile("s_waitcnt vmcnt(0)" ::: "memory");
        } else {
            XB_SPIN(xb_ld(&bar[XB_XGEN(b.x)]) == gen, bar);
            __builtin_amdgcn_fence(__ATOMIC_ACQUIRE, "agent");
            asm volatile("s_waitcnt vmcnt(0)" ::: "memory");
        }
    }
    __syncthreads();
}


struct Args { const float* in[22]; float* out; unsigned char* ws; int ph_lo, ph_hi; };

__device__ __forceinline__ void transpose_item(const float* W, int ldw, int src_n0, int k0, bf16_t* WT, int K, int dst_n0, LAS float* scr, int lane) {
    if (src_n0 >= 0) {
#pragma unroll
        for (int i = 0; i < 32; ++i) { const int kk = 2 * i + (lane >> 5); scr[kk * 33 + (lane & 31)] = W[(size_t)(k0 + kk) * ldw + src_n0 + (lane & 31)]; }
    }
    LDS_WAIT();
    const int c = lane & 7;
#pragma unroll
    for (int j = 0; j < 4; ++j) { const int n = (lane >> 3) + 8 * j; const LAS float* s = scr + (8 * c) * 33 + n;
        u32x4 o = (u32x4){0u, 0u, 0u, 0u};
        if (src_n0 >= 0) { o.x = pkbf(s[0 * 33], s[1 * 33]); o.y = pkbf(s[2 * 33], s[3 * 33]); o.z = pkbf(s[4 * 33], s[5 * 33]); o.w = pkbf(s[6 * 33], s[7 * 33]); }
        *(u32x4*)(WT + (size_t)(dst_n0 + n) * K + k0 + 8 * c) = o; }
    LDS_WAIT();
}

__device__ __forceinline__ void phase0(const Args& a, LAS unsigned char* lds, int G, int blk, int tid, int wid, int lane) {
    unsigned char* ws = a.ws;
    LAS float* scr = (LAS float*)(lds + wid * 8448);
    LAS float* sil = (LAS float*)(lds + 69632);
    const int gw = blk * 8 + wid, NGW = G * 8;
    for (int k = tid; k < 2 * DM; k += 512) { const float cv = a.in[1][k]; sil[k] = cv / (1.0f + __expf(-cv)); }
    __syncthreads();
    {
        const float* wa = a.in[2]; const float* ba = a.in[3]; float* modp = (float*)(ws + WS_MODP);
        constexpr int NJ = 3 * DM / 64, KL = DM / KPARTS;
        for (int it = gw; it < NJ * KPARTS; it += NGW) {
            const int jg = it % NJ, kp = it / NJ, j = 64 * jg + lane; float a0 = 0.f, a1 = 0.f;
            const float* wp = wa + (size_t)(kp * KL) * (3 * DM) + j;
#pragma unroll 32
            for (int k = 0; k < KL; ++k) { const float w = wp[(size_t)k * (3 * DM)]; a0 += sil[kp * KL + k] * w; a1 += sil[DM + kp * KL + k] * w; }
            if (kp == 0) { const float bb = ba[j]; a0 += bb; a1 += bb; }
            modp[(size_t)(kp * 2 + 0) * (3 * DM) + j] = a0; modp[(size_t)(kp * 2 + 1) * (3 * DM) + j] = a1;
        }
    }
    { float* bp = (float*)(ws + WS_BIASP); const float* bi = a.in[6];
      for (int n = blk * 512 + tid; n < NP; n += G * 512) bp[n] = n < 1920 ? bi[n] : (n < 2048 ? 0.f : bi[n - 128]); }
    {
        const float *lre = a.in[9], *lim = a.in[10], *lst = a.in[11], *bre = a.in[12], *bim = a.in[13], *cre = a.in[14], *cim = a.in[15];
        float* abar = (float*)(ws + WS_ABAR); float* a64 = (float*)(ws + WS_A64); bf16_t* Bcat = (bf16_t*)(ws + WS_BCAT); bf16_t* Ccat = (bf16_t*)(ws + WS_CCAT);
        for (int e = (G - 1 - blk) * 512 + tid; e < 32 * 64 * 16; e += G * 512) {
            const int gp = e >> 4, cch = e & 15, g = gp >> 6, p = gp & 63;
            const float step = expf(lst[g]), lr = lre[gp], li = lim[gp];
            const float decay = expf(lr * step); const float ar = decay * cosf(li * step), ai = decay * sinf(li * step);
            const float den = lr * lr + li * li, nr = ar - 1.0f, ni = ai;
            const float cr_ = (nr * lr + ni * li) / den, ci_ = (ni * lr - nr * li) / den;
            if (cch == 0) { abar[2 * gp] = ar; abar[2 * gp + 1] = ai; float pr = ar, pi = ai;
#pragma unroll
                for (int s = 0; s < 6; ++s) { const float tr = pr * pr - pi * pi, ti = 2.0f * pr * pi; pr = tr; pi = ti; }
                a64[2 * gp] = pr; a64[2 * gp + 1] = pi; }
            const float br = bre[e], bi = bim[e];
            const float xr = cr_ * br - ci_ * bi, xi = cr_ * bi + ci_ * br;
            Bcat[((size_t)g * 128 + 2 * p) * 16 + cch] = (bf16_t)(pkbf(xr, 0.f) & 0xffffu);
            Bcat[((size_t)g * 128 + 2 * p + 1) * 16 + cch] = (bf16_t)(pkbf(xi, 0.f) & 0xffffu);
            const float c_r = cre[((size_t)g * 16 + cch) * 64 + p], c_i = cim[((size_t)g * 16 + cch) * 64 + p];
            *(unsigned*)(Ccat + ((size_t)g * 16 + cch) * 128 + 2 * p) = pkbf(c_r, -c_i);
        }
    }
}

__device__ __forceinline__ void phase1(const Args& a, LAS unsigned char* lds, int G, int blk, int tid, int wid, int lane) {
    unsigned char* ws = a.ws;
    const int rpb = MTOK / G, row_lo = blk * rpb, batch = row_lo / SEQ;
    LAS float* gs = (LAS float*)lds; LAS float* sh = gs + DM;
    const float* modp = (const float*)(ws + WS_MODP); const float* ng = a.in[4];
    for (int j = tid; j < DM; j += 512) { float s0 = 0.f, s1 = 0.f, s2 = 0.f;
#pragma unroll
        for (int kp = 0; kp < KPARTS; ++kp) { const float* mp = modp + (size_t)(kp * 2 + batch) * (3 * DM); s0 += mp[j]; s1 += mp[DM + j]; s2 += mp[2 * DM + j]; }
        gs[j] = ng[j] * (1.0f + s1); sh[j] = s0;
        if (row_lo % SEQ == 0) ((float*)(ws + WS_GATE))[batch * DM + j] = s2; }
    __syncthreads();
    if (wid >= 4) {
        LAS float* scr = (LAS float*)(lds + 16384 + (wid - 4) * 8448);
        const int gw = blk * 4 + (wid - 4), NGW = G * 4;
    constexpr int I_IN = (DM / 64) * (NP / 32), I_OUT = (DM / 64) * (DM / 32), I_GLU = (SW / 64) * (SW / 32);
    for (int it = gw; it < I_IN + I_OUT + I_GLU; it += NGW) {
        int r = it;
        if (r < I_IN) { const int nblk = NP / 32, kb = r / nblk, nb = r % nblk, n0 = 32 * nb; const int src = n0 < 1920 ? n0 : (n0 < 2048 ? -1 : n0 - 128);
            transpose_item(a.in[5], INW, src, 64 * kb, (bf16_t*)(ws + WS_WIN), DM, n0, scr, lane); continue; }
        r -= I_IN;
        if (r < I_OUT) { const int nblk = DM / 32, kb = r / nblk, nb = r % nblk; transpose_item(a.in[20], DM, 32 * nb, 64 * kb, (bf16_t*)(ws + WS_WOUT), DM, 32 * nb, scr, lane); continue; }
        r -= I_OUT;
        { const int nblk = SW / 32, kb = r / nblk, nb = r % nblk; transpose_item(a.in[17], SW, 32 * nb, 64 * kb, (bf16_t*)(ws + WS_GLU), SW, 32 * nb, scr, lane); }
    }
        return;
    }
    const float* x = a.in[0]; bf16_t* hb = (bf16_t*)(ws + WS_HB);
    for (int r = row_lo + 2 * wid; r < row_lo + rpb; r += 8) {
        const f32x4* xr = (const f32x4*)(x + (size_t)r * DM) + lane; f32x4 v[2][8]; float ss[2] = {0.f, 0.f};
#pragma unroll
        for (int q = 0; q < 2; ++q)
#pragma unroll
            for (int i = 0; i < 8; ++i) v[q][i] = __builtin_nontemporal_load(xr + q * (DM / 4) + 64 * i);
#pragma unroll
        for (int q = 0; q < 2; ++q)
#pragma unroll
            for (int i = 0; i < 8; ++i) ss[q] += (v[q][i][0] * v[q][i][0] + v[q][i][1] * v[q][i][1]) + (v[q][i][2] * v[q][i][2] + v[q][i][3] * v[q][i][3]);
#pragma unroll
        for (int q = 0; q < 2; ++q) {
            const float rstd = 1.0f / sqrtf(wave_sum(ss[q]) * (1.0f / DM) + EPSN);
            u32x2* o = (u32x2*)(hb + (size_t)(r + q) * DM) + lane;
#pragma unroll
            for (int i = 0; i < 8; ++i) { const f32x4 g4 = *(const LAS f32x4*)(gs + 4 * (lane + 64 * i)), s4 = *(const LAS f32x4*)(sh + 4 * (lane + 64 * i));
                const f32x4 h = v[q][i] * rstd * g4 + s4; u32x2 w; w.x = pkbf(h[0], h[1]); w.y = pkbf(h[2], h[3]); o[64 * i] = w; }
        }
    }
}

#define MFMA32(A, B, C) __builtin_amdgcn_mfma_f32_32x32x16_bf16(A, B, C, 0, 0, 0)
#define MFMA16(A, B, C) __builtin_amdgcn_mfma_f32_16x16x32_bf16(A, B, C, 0, 0, 0)
__device__ __forceinline__ void attn_unit(const Args& a, LAS unsigned char* lds, int b, int kvh, int qb, int tid, int wid, int lane) {
    const bf16_t* proj = (const bf16_t*)(a.ws + WS_PROJ); bf16_t* mixed = (bf16_t*)(a.ws + WS_HB); float* ssqa = (float*)(a.ws + WS_SSQA);
    const int r32 = lane & 31, hi = lane >> 5;
    LAS bf16_t* KS = (LAS bf16_t*)lds;
    LAS bf16_t* VT = (LAS bf16_t*)(lds + 36864);
    LAS bf16_t* OST = (LAS bf16_t*)(lds + 70656 + wid * 4608);
    LAS float* SSQ = (LAS float*)(lds + 107520);
    const long tok0 = (long)b * SEQ + qb * 128;
#pragma unroll
    for (int i = 0; i < 4; ++i) { const int id = tid + 512 * i, row = id >> 3, ch = id & 7;
        u32x4 v = (u32x4){0u, 0u, 0u, 0u};
        if (qb > 0 || row >= 128) v = *(const u32x4*)(proj + (size_t)(tok0 - 128 + row) * NP + COL_K + kvh * 64 + ch * 8);
        *(LAS u32x4*)(KS + row * 72 + ch * 8) = v; }
#pragma unroll
    for (int i = 0; i < 4; ++i) { const int id = tid + 512 * i, row = id & 255, ch = id >> 8;
        u32x4 v = (u32x4){0u, 0u, 0u, 0u};
        if (qb > 0 || row >= 128) v = *(const u32x4*)(proj + (size_t)(tok0 - 128 + row) * NP + COL_V + kvh * 64 + ch * 8);
#pragma unroll
        for (int e = 0; e < 8; ++e) VT[(ch * 8 + e) * 264 + row] = (bf16_t)((v[e >> 1] >> (16 * (e & 1))) & 0xffffu); }
    const int head = kvh * 8 + wid;
    bf16x8 qn[4];
#pragma unroll
    for (int ds = 0; ds < 4; ++ds) qn[ds] = *(const bf16x8*)(proj + (size_t)(tok0 + r32) * NP + COL_Q + head * 64 + 16 * ds + 8 * hi);
    __syncthreads();
    const float sink2 = a.in[7][head] * LOG2E;
    const int oc = (lane & 7) * 8;
    const f32x4 g0 = *(const f32x4*)(a.in[8] + head * 64 + oc), g1 = *(const f32x4*)(a.in[8] + head * 64 + oc + 4);
    const float NEG = -1.0e30f;
    for (int s = 0; s < 4; ++s) {
        bf16x8 qf[4];
#pragma unroll
        for (int ds = 0; ds < 4; ++ds) qf[ds] = qn[ds];
        if (s < 3) { const size_t qtok = (size_t)(tok0 + 32 * (s + 1) + r32);
#pragma unroll
            for (int ds = 0; ds < 4; ++ds) qn[ds] = *(const bf16x8*)(proj + qtok * NP + COL_Q + head * 64 + 16 * ds + 8 * hi); }
        u32x4 zp[4];
#pragma unroll
        for (int i = 0; i < 4; ++i) zp[i] = *(const u32x4*)(proj + (size_t)(tok0 + 32 * s + 8 * i + (lane >> 3)) * NP + COL_ZA + head * 64 + oc);
        f32x16 S[5];
#pragma unroll
        for (int j = 0; j < 5; ++j) { const int kb0 = 32 * (s + j); f32x16 acc = {};
#pragma unroll
            for (int ds = 0; ds < 4; ++ds) { const bf16x8 kf = *(const LAS bf16x8*)(KS + (kb0 + r32) * 72 + 16 * ds + 8 * hi); acc = MFMA32(kf, qf[ds], acc); }
            S[j] = acc; }
#pragma unroll
        for (int r = 0; r < 16; ++r) { const int kk = (r & 3) + 8 * (r >> 2) + 4 * hi; if (kk <= r32) S[0][r] = NEG; if (kk > r32) S[4][r] = NEG; }
        if (qb == 0) {
#pragma unroll
            for (int j = 0; j < 4; ++j) if (s + j < 4) {
#pragma unroll
                for (int r = 0; r < 16; ++r) S[j][r] = NEG; } }
        float m = NEG;
#pragma unroll
        for (int j = 0; j < 5; ++j)
#pragma unroll
            for (int r = 0; r < 16; ++r) m = fmaxf(m, S[j][r]);
        m = fmaxf(m, __shfl_xor(m, 32));
        float l = 0.f;
#pragma unroll
        for (int j = 0; j < 5; ++j)
#pragma unroll
            for (int r = 0; r < 16; ++r) { const float p = __builtin_amdgcn_exp2f(S[j][r] - m); S[j][r] = p; l += p; }
        l += __shfl_xor(l, 32); l += __builtin_amdgcn_exp2f(sink2 - m);
        f32x16 O[2]; O[0] = (f32x16){}; O[1] = (f32x16){};
#pragma unroll
        for (int j = 0; j < 5; ++j)
#pragma unroll
            for (int s2 = 0; s2 < 2; ++s2) {
                u32x4 pw; pw.x = pkbf(S[j][8 * s2 + 0], S[j][8 * s2 + 1]); pw.y = pkbf(S[j][8 * s2 + 2], S[j][8 * s2 + 3]); pw.z = pkbf(S[j][8 * s2 + 4], S[j][8 * s2 + 5]); pw.w = pkbf(S[j][8 * s2 + 6], S[j][8 * s2 + 7]);
                const bf16x8 pf = __builtin_bit_cast(bf16x8, pw);
                const int kv0 = 32 * (s + j) + 16 * s2 + 4 * hi;
#pragma unroll
                for (int dt = 0; dt < 2; ++dt) { const int d = 32 * dt + r32;
                    const u32x2 lo = *(const LAS u32x2*)(VT + d * 264 + kv0), hh = *(const LAS u32x2*)(VT + d * 264 + kv0 + 8);
                    const u32x4 vw = (u32x4){lo.x, lo.y, hh.x, hh.y};
                    O[dt] = MFMA32(__builtin_bit_cast(bf16x8, vw), pf, O[dt]); }
            }
        const float inv = 1.0f / l; float ss = 0.f;
#pragma unroll
        for (int dt = 0; dt < 2; ++dt)
#pragma unroll
            for (int r = 0; r < 16; ++r) { const float o = O[dt][r] * inv; O[dt][r] = o; ss += o * o; }
        ss += __shfl_xor(ss, 32);
        if (hi == 0) SSQ[wid * 128 + 32 * s + r32] = ss;
#pragma unroll
        for (int dt = 0; dt < 2; ++dt)
#pragma unroll
            for (int rg = 0; rg < 4; ++rg) { u32x2 w; w.x = pkbf(O[dt][4 * rg], O[dt][4 * rg + 1]); w.y = pkbf(O[dt][4 * rg + 2], O[dt][4 * rg + 3]);
                *(LAS u32x2*)(OST + r32 * 72 + 32 * dt + 8 * rg + 4 * hi) = w; }
        LDS_WAIT();
#pragma unroll
        for (int i = 0; i < 4; ++i) { const int row = 8 * i + (lane >> 3); const size_t tok = (size_t)(tok0 + 32 * s + row);
            const u32x4 o8 = *(const LAS u32x4*)(OST + row * 72 + oc);
            const u32x4 z8 = zp[i];
            u32x4 w;
            w.x = pkbf(bflo(o8.x) * g0[0] * bflo(z8.x), bfhi(o8.x) * g0[1] * bfhi(z8.x));
            w.y = pkbf(bflo(o8.y) * g0[2] * bflo(z8.y), bfhi(o8.y) * g0[3] * bfhi(z8.y));
            w.z = pkbf(bflo(o8.z) * g1[0] * bflo(z8.z), bfhi(o8.z) * g1[1] * bfhi(z8.z));
            w.w = pkbf(bflo(o8.w) * g1[2] * bflo(z8.w), bfhi(o8.w) * g1[3] * bfhi(z8.w));
#ifdef DBG_NO_ATTN
            w = (u32x4){0u, 0u, 0u, 0u};
#endif
            *(u32x4*)(mixed + tok * DM + head * 64 + oc) = w; }
        LDS_WAIT();
    }
    __syncthreads();
    if (tid < 128) { float t = 0.f;
#pragma unroll
        for (int w = 0; w < 8; ++w) t += SSQ[w * 128 + tid];
        ssqa[(size_t)kvh * MTOK + tok0 + tid] = t; }
    __syncthreads();
}

__device__ __forceinline__ f32x2 gelu_pk(f32x2 v) {
    const f32x2 av = __builtin_elementwise_abs(v), d = av * 0.2316418882f + 1.0f;
    f32x2 t; t.x = __builtin_amdgcn_rcpf(d.x); t.y = __builtin_amdgcn_rcpf(d.y);
    f32x2 q = t * 0.5307027145f + (-0.7265760135f); q = q * t + 0.7107068705f; q = q * t + (-0.142248368f); q = q * t + 0.127414796f; q = q * t;
    const f32x2 s = (v * v) * (-0.72134752044f);
    f32x2 e; e.x = __builtin_amdgcn_exp2f(s.x); e.y = __builtin_amdgcn_exp2f(s.y);
    const f32x2 mm = v * (q * e), r = v - mm;
    f32x2 o; o.x = v.x < 0.f ? mm.x : r.x; o.y = v.y < 0.f ? mm.y : r.y; return o;
}
template <bool FINAL>
__device__ __forceinline__ void ssm_unit(const Args& a, LAS unsigned char* lds, int b, int c64, int tid, int wid, int lane, int next_u = -1) {
    const bf16_t* proj = (const bf16_t*)(a.ws + WS_PROJ); bf16_t* mixed = (bf16_t*)(a.ws + WS_HB);
    const float* abar = (const float*)(a.ws + WS_ABAR); const bf16_t* Bcat = (const bf16_t*)(a.ws + WS_BCAT); const bf16_t* Ccat = (const bf16_t*)(a.ws + WS_CCAT);
    f32x2* Sc = (f32x2*)(a.ws + WS_SC); const f32x2* Hc = (const f32x2*)(a.ws + WS_HC);
    LAS bf16_t* BUF = (LAS bf16_t*)(lds + wid * 8704);
    LAS bf16_t* TILE = (LAS bf16_t*)(lds + 69632);
    LAS float* SSQ2 = (LAS float*)(lds + 136192);
    const size_t tok0 = (size_t)b * SEQ + 64 * c64;
    const int r32 = lane & 31, hi = lane >> 5, r16 = lane & 15, q4 = lane >> 4;
#if defined(PROBE_P5) && PROBE_P5 == 2
    for (int rp_ = 0; rp_ < (FINAL ? 2 : 1); ++rp_) {
    if (rp_) __syncthreads();
#else
    {
#endif
    if (!FINAL) {
#pragma unroll
    for (int i = 0; i < 8; ++i) { const int id = tid + 512 * i, row = id >> 6, ch = id & 63;
        *(LAS u32x4*)(TILE + row * 520 + ch * 8) = *(const u32x4*)(proj + (tok0 + row) * NP + COL_U + ch * 8); }
    }
    bf16x8 bcN[4], ccN[4]; f32x2 abN, h0N = {0.f, 0.f}; f32x4 d4N = {0.f, 0.f, 0.f, 0.f};
#define SSM_LOADC(G_) do { const int g_ = (G_); \
        _Pragma("unroll") for (int jt = 0; jt < 4; ++jt) bcN[jt] = *(const bf16x8*)(Bcat + ((size_t)(g_ * 128 + 32 * jt + r32) * 16 + 8 * hi)); \
        abN = *(const f32x2*)(abar + (size_t)(g_ * 64 + lane) * 2); \
        if (FINAL) { h0N = Hc[((size_t)(b * NCH + c64) * 32 + g_) * 64 + lane]; d4N = *(const f32x4*)(a.in[16] + g_ * 16 + 4 * q4); \
            _Pragma("unroll") for (int ks = 0; ks < 4; ++ks) ccN[ks] = *(const bf16x8*)(Ccat + ((size_t)(g_ * 16 + r16) * 128 + 32 * ks + 8 * q4)); } } while (0)
    SSM_LOADC(wid);
    __syncthreads();
    for (int gi = 0; gi < 4; ++gi) {
        const int g = wid + 8 * gi;
        bf16x8 bc[4], cc[4];
#pragma unroll
        for (int i = 0; i < 4; ++i) { bc[i] = bcN[i]; cc[i] = ccN[i]; }
        const float ar = abN[0], ai = abN[1]; float hr = h0N[0], hq = h0N[1]; const f32x4 d4 = d4N;
        const size_t sidx = ((size_t)(b * NCH + c64) * 32 + g) * 64 + lane;
        if (gi < 3) SSM_LOADC(g + 8);
        for (int hh = 0; hh < 2; ++hh) {
            const bf16x8 uf = *(const LAS bf16x8*)(TILE + (32 * hh + r32) * 520 + g * 16 + 8 * hi);
#pragma unroll
            for (int jt = 0; jt < 4; ++jt) { f32x16 d = {}; d = MFMA32(bc[jt], uf, d);
#pragma unroll
                for (int rg = 0; rg < 4; ++rg) { u32x2 w; w.x = pkbf(d[4 * rg], d[4 * rg + 1]); w.y = pkbf(d[4 * rg + 2], d[4 * rg + 3]);
                    *(LAS u32x2*)(BUF + r32 * 136 + 32 * jt + 8 * rg + 4 * hi) = w; } }
            LDS_WAIT();
#pragma unroll
            for (int t0 = 0; t0 < 32; t0 += 8) { unsigned v[8];
#pragma unroll
                for (int i = 0; i < 8; ++i) v[i] = *(const LAS unsigned*)(BUF + (t0 + i) * 136 + 2 * lane);
#pragma unroll
                for (int i = 0; i < 8; ++i) { const float bur = bflo(v[i]), bui = bfhi(v[i]);
                    const float nr = fmaf(ar, hr, fmaf(-ai, hq, bur)), ni = fmaf(ar, hq, fmaf(ai, hr, bui)); hr = nr; hq = ni;
                    if (FINAL) *(LAS unsigned*)(BUF + (t0 + i) * 136 + 2 * lane) = pkbf(hr, hq); } }
            if (FINAL) {
                LDS_WAIT();
#pragma unroll
                for (int tt = 0; tt < 2; ++tt) { f32x4 y = {};
#pragma unroll
                    for (int ks = 0; ks < 4; ++ks) { const bf16x8 hf = *(const LAS bf16x8*)(BUF + (16 * tt + r16) * 136 + 32 * ks + 8 * q4); y = MFMA16(cc[ks], hf, y); }
                    const int tl = 32 * hh + 16 * tt + r16;
                    const u32x2 u4 = *(const LAS u32x2*)(TILE + tl * 520 + g * 16 + 4 * q4);
                    const f32x2 ga = gelu_pk((f32x2){y[0] + d4[0] * bflo(u4.x), y[1] + d4[1] * bfhi(u4.x)}), gb = gelu_pk((f32x2){y[2] + d4[2] * bflo(u4.y), y[3] + d4[3] * bfhi(u4.y)});
                    u32x2 w; w.x = pkbf(ga.x, ga.y); w.y = pkbf(gb.x, gb.y);
                    *(LAS u32x2*)(TILE + tl * 520 + g * 16 + 4 * q4) = w; }
                LDS_WAIT();
            }
        }
        if (!FINAL) Sc[sidx] = (f32x2){hr, hq};
    }
    }
#undef SSM_LOADC
    if (!FINAL) __syncthreads();
    if (FINAL) {
        const bf16_t* glu = (const bf16_t*)(a.ws + WS_GLU);
        __syncthreads();
#if defined(PROBE_P5) && PROBE_P5 == 3
        for (int i = tid; i < 64 * 65; i += 512) ((LAS u32x4*)lds)[i] = ((const LAS u32x4*)(lds + 69632))[i];
        __syncthreads();
        _Pragma("nounroll") for (int rp3_ = 0; rp3_ < a.ph_hi - 5; ++rp3_) {
        if (rp3_) { for (int i = tid; i < 64 * 65; i += 512) ((LAS u32x4*)(lds + 69632))[i] = ((const LAS u32x4*)lds)[i]; __syncthreads(); }
#else
        {
#endif
        f32x16 acc[2][2];
#pragma unroll
        for (int i = 0; i < 2; ++i)
#pragma unroll
            for (int j = 0; j < 2; ++j) acc[i][j] = (f32x16){};
        const int nb = 64 * wid;
        bf16x8 gA0[4][2], gA1[4][2];
        const bf16_t* gl0 = glu + (size_t)(nb + r32) * SW + 8 * hi;
#define GLU_LOAD(BUFV, c) do { _Pragma("unroll") for (int k4 = 0; k4 < 4; ++k4) { BUFV[k4][0] = *(const bf16x8*)(gl0 + 16 * (4 * (c) + k4)); BUFV[k4][1] = *(const bf16x8*)(gl0 + 32 * SW + 16 * (4 * (c) + k4)); } } while (0)
#define GLU_MMA(BUFV, c) do { _Pragma("unroll") for (int k4 = 0; k4 < 4; ++k4) { const int ks = 4 * (c) + k4; bf16x8 bf[2]; \
            _Pragma("unroll") for (int tt = 0; tt < 2; ++tt) bf[tt] = *(const LAS bf16x8*)(TILE + (32 * tt + r32) * 520 + 16 * ks + 8 * hi); \
            _Pragma("unroll") for (int nt = 0; nt < 2; ++nt) _Pragma("unroll") for (int tt = 0; tt < 2; ++tt) acc[nt][tt] = MFMA32(BUFV[k4][nt], bf[tt], acc[nt][tt]); } } while (0)
#if defined(PROBE_P5) && PROBE_P5 == 1
        for (int rp_ = 0; rp_ < 2; ++rp_) {
        for (int i = 0; i < 2; ++i) for (int j = 0; j < 2; ++j) acc[i][j] = (f32x16){};
#else
        {
#endif
        GLU_LOAD(gA0, 0);
#pragma unroll 1
        for (int c = 0; c < 8; c += 2) {
            GLU_LOAD(gA1, c + 1);
            asm volatile("" ::: "memory");
            GLU_MMA(gA0, c);
            if (c + 2 < 8) GLU_LOAD(gA0, c + 2);
            asm volatile("" ::: "memory");
            GLU_MMA(gA1, c + 1);
        }
        }
#undef GLU_LOAD
#undef GLU_MMA
#pragma unroll
        for (int tt = 0; tt < 2; ++tt) { const int t = 32 * tt + r32; float ss = 0.f;
#pragma unroll
            for (int nt = 0; nt < 2; ++nt)
#pragma unroll
                for (int rg = 0; rg < 4; ++rg) { const int n0 = nb + 32 * nt + 8 * rg + 4 * hi;
                    const u32x2 s4 = *(const LAS u32x2*)(TILE + t * 520 + n0); const f32x4 b4 = *(const f32x4*)(a.in[18] + n0);
                    const float sv[4] = {bflo(s4.x), bfhi(s4.x), bflo(s4.y), bfhi(s4.y)};
#pragma unroll
                    for (int e = 0; e < 4; ++e) { const float gl = acc[nt][tt][4 * rg + e] + b4[e]; const float gv = sv[e] * __builtin_amdgcn_rcpf(1.0f + __builtin_amdgcn_exp2f(-LOG2E * gl));
                        acc[nt][tt][4 * rg + e] = gv; ss += gv * gv; } }
            ss += __shfl_xor(ss, 32);
            if (hi == 0) SSQ2[wid * 64 + t] = ss; }
        u32x4 zpre[8];
#pragma unroll
        for (int i = 0; i < 8; ++i) { const int id = tid + 512 * i, row = id >> 6, ch = id & 63; zpre[i] = *(const u32x4*)(proj + (tok0 + row) * NP + COL_ZS + ch * 8); }
        __syncthreads();
#pragma unroll
        for (int tt = 0; tt < 2; ++tt) { const int t = 32 * tt + r32; float tot = 0.f;
#pragma unroll
            for (int w = 0; w < 8; ++w) tot += SSQ2[w * 64 + t];
            const float* sq = (const float*)(a.ws + WS_SSQA) + tok0 + t;
            const float rstd = sqrtf((((sq[0] + sq[MTOK]) + sq[2 * MTOK]) * (1.0f / AW) + EPSN) / (tot * (1.0f / SW) + EPSN));
#pragma unroll
            for (int nt = 0; nt < 2; ++nt)
#pragma unroll
                for (int rg = 0; rg < 4; ++rg) { const int n0 = nb + 32 * nt + 8 * rg + 4 * hi; const f32x4 g4 = *(const f32x4*)(a.in[19] + n0);
                    u32x2 w; w.x = pkbf(acc[nt][tt][4 * rg] * rstd * g4[0], acc[nt][tt][4 * rg + 1] * rstd * g4[1]); w.y = pkbf(acc[nt][tt][4 * rg + 2] * rstd * g4[2], acc[nt][tt][4 * rg + 3] * rstd * g4[3]);
                    *(LAS u32x2*)(TILE + t * 520 + n0) = w; } }
        __syncthreads();
#pragma unroll
        for (int i = 0; i < 8; ++i) { const int id = tid + 512 * i, row = id >> 6, ch = id & 63;
            const u32x4 o8 = *(const LAS u32x4*)(TILE + row * 520 + ch * 8);
            const u32x4 z8 = zpre[i];
            u32x4 w;
            w.x = pkbf(bflo(o8.x) * bflo(z8.x), bfhi(o8.x) * bfhi(z8.x)); w.y = pkbf(bflo(o8.y) * bflo(z8.y), bfhi(o8.y) * bfhi(z8.y));
            w.z = pkbf(bflo(o8.z) * bflo(z8.z), bfhi(o8.z) * bfhi(z8.z)); w.w = pkbf(bflo(o8.w) * bflo(z8.w), bfhi(o8.w) * bfhi(z8.w));
#ifdef DBG_NO_SSM
            w = (u32x4){0u, 0u, 0u, 0u};
#endif
#ifdef DBG_SAN_SSM
            { unsigned* wp = (unsigned*)&w; for (int e = 0; e < 4; ++e) { unsigned x = wp[e]; if ((x & 0x7f80u) == 0x7f80u) x &= 0xffff0000u; if ((x & 0x7f800000u) == 0x7f800000u) x &= 0xffffu; wp[e] = x; } }
#endif
            *(u32x4*)(mixed + (tok0 + row) * DM + AW + ch * 8) = w; }
        __syncthreads();
        if (next_u >= 0) { const size_t tokn = (size_t)(next_u / NCH) * SEQ + 64 * (next_u % NCH);
#pragma unroll
            for (int i = 0; i < 8; ++i) { const int id = tid + 512 * i, row = id >> 6, ch = id & 63;
                *(LAS u32x4*)(TILE + row * 520 + ch * 8) = *(const u32x4*)(proj + (tokn + row) * NP + COL_U + ch * 8); } }
        }
    }
}

__device__ __forceinline__ void phase_carry(const Args& a, LAS unsigned char* lds, int blk, int wid, int lane) {
    if (blk >= NB * 32) return;
    const int b = blk >> 5, g = blk & 31;
    const f32x2 aa = *(const f32x2*)((const float*)(a.ws + WS_A64) + (size_t)(g * 64 + lane) * 2);
    const f32x2* Sc = (const f32x2*)(a.ws + WS_SC); f32x2* Hc = (f32x2*)(a.ws + WS_HC);
    LAS f32x2* E = (LAS f32x2*)lds;
    const size_t base = ((size_t)(b * NCH + 32 * wid) * 32 + g) * 64 + lane;
    f32x2 s[32];
#pragma unroll
    for (int i = 0; i < 32; ++i) s[i] = Sc[base + (size_t)i * 2048];
    float hr = 0.f, hq = 0.f;
#pragma unroll
    for (int i = 0; i < 32; ++i) { const float sr = s[i][0], si = s[i][1]; s[i] = (f32x2){hr, hq};
        const float nr = fmaf(aa[0], hr, fmaf(-aa[1], hq, sr)), ni = fmaf(aa[0], hq, fmaf(aa[1], hr, si)); hr = nr; hq = ni; }
    E[wid * 64 + lane] = (f32x2){hr, hq};
    float pr = aa[0], pi = aa[1];
#pragma unroll
    for (int q = 0; q < 5; ++q) { const float tr = pr * pr - pi * pi, ti = 2.0f * pr * pi; pr = tr; pi = ti; }
    __syncthreads();
    float cr = 0.f, ci = 0.f;
    for (int v = 0; v < wid; ++v) { const f32x2 e = E[v * 64 + lane]; const float nr = fmaf(pr, cr, fmaf(-pi, ci, e[0])), ni = fmaf(pr, ci, fmaf(pi, cr, e[1])); cr = nr; ci = ni; }
#pragma unroll
    for (int i = 0; i < 32; ++i) { Hc[base + (size_t)i * 2048] = (f32x2){s[i][0] + cr, s[i][1] + ci};
        const float nr = aa[0] * cr - aa[1] * ci, ni = aa[0] * ci + aa[1] * cr; cr = nr; ci = ni; }
    __syncthreads();
}

__device__ __forceinline__ void phase_final(const Args& a, int G, int blk, int wid, int lane) {
    const float* ssqo = (const float*)(a.ws + WS_SSQO); const float* fg = a.in[21]; float* out = a.out;
    f32x4 g4[8];
#pragma unroll
    for (int i = 0; i < 8; ++i) g4[i] = *((const f32x4*)fg + lane + 64 * i);
    for (int r = blk * 8 + wid; r < MTOK; r += G * 8) {
        float s = lane < 32 ? ssqo[(size_t)lane * MTOK + r] : 0.f;
        const float rstd = 1.0f / sqrtf(wave_sum(s) * (1.0f / DM) + EPSN);
        f32x4* o = (f32x4*)(out + (size_t)r * DM) + lane;
#pragma unroll
        for (int i = 0; i < 8; ++i) { const f32x4 v = o[64 * i]; o[64 * i] = v * rstd * g4[i]; }
    }
}

__global__ void __launch_bounds__(512, 2) mk_fwd(Args a) {
    extern __shared__ __attribute__((aligned(16))) unsigned char lds_raw[];
    LAS unsigned char* lds = (LAS unsigned char*)lds_raw;
    cg::grid_group grid = cg::this_grid();
    const int tid = threadIdx.x, lane = tid & 63, wid = __builtin_amdgcn_readfirstlane(tid >> 6);
    const int G = gridDim.x, blk = blockIdx.x;
    const int lo = a.ph_lo, hi_ph = a.ph_hi;
    if (tid < 16) ((LAS unsigned*)(lds + LDS_ST_OFF))[tid] = 0u;
    __syncthreads();
    XcdBarrier bar = xcd_barrier_post((unsigned*)(a.ws + WS_BAR), (volatile LAS unsigned*)(lds + LDS_ST_OFF));
    if (hi_ph > 1000) grid.sync();
#define IN(k) (lo <= (k) && (k) < hi_ph)
#define SEAM(k) do { if ((k) + 1 < hi_ph) xcd_barrier(bar); } while (0)
#ifndef REPMASK
#define REPMASK 0
#endif
#define NREP(k) (((REPMASK >> (k)) & 1) ? 2 : 1)
    if (IN(0)) for (int rep_ = 0; rep_ < NREP(0); ++rep_) { if (rep_) xcd_barrier(bar);
#ifndef OFF_P0
        phase0(a, lds, G, blk, tid, wid, lane);
#endif
        SEAM(0); }
#ifdef EXTRA_SYNCS
    for (int es_ = 0; es_ < EXTRA_SYNCS; ++es_) xcd_barrier(bar);
#endif
    if (IN(1)) for (int rep_ = 0; rep_ < NREP(1); ++rep_) { if (rep_) xcd_barrier(bar);
#ifndef OFF_P1
        phase1(a, lds, G, blk, tid, wid, lane);
#endif
        SEAM(1); }
    if (IN(2)) for (int rep_ = 0; rep_ < NREP(2); ++rep_) { if (rep_) xcd_barrier(bar);
#ifndef OFF_P2
        pg8::Gemm g{(const bf16_t*)(a.ws + WS_HB), (const bf16_t*)(a.ws + WS_WIN), MTOK, NP, DM}; pg8::StaticOrder S; S.init(MTOK, NP, G, blk);
        pg8::EpiProj E{(bf16_t*)(a.ws + WS_PROJ), NP, (const float*)(a.ws + WS_BIASP), QSCALE};
        pg8::gemm_phase<pg8::EpiProj, pg8::StaticOrder, true, true>(lds, g, S, E);
#endif
        SEAM(2); }
    if (IN(3)) for (int rep_ = 0; rep_ < NREP(3); ++rep_) { if (rep_) xcd_barrier(bar);
        constexpr int NATT = NB * 3 * (SEQ / 128), NSSM = NB * NCH;
#ifndef OFF_P3A
        for (int L = blk; L < NATT; L += G) { const int qb = L % (SEQ / 128), r = L / (SEQ / 128), kvh = r % 3, b = r / 3; attn_unit(a, lds, b, kvh, qb, tid, wid, lane); }
#endif
#ifndef OFF_P3B
        for (int u = blk; u < NSSM; u += G) ssm_unit<false>(a, lds, u / NCH, u % NCH, tid, wid, lane);
#endif
        SEAM(3); }
    if (IN(4)) for (int rep_ = 0; rep_ < NREP(4); ++rep_) { if (rep_) xcd_barrier(bar);
#ifndef OFF_P4
        phase_carry(a, lds, blk, wid, lane);
#endif
        if (blk < NB * NCH) {
            const bf16_t* proj = (const bf16_t*)(a.ws + WS_PROJ); const size_t tok0 = (size_t)(blk / NCH) * SEQ + 64 * (blk % NCH);
#pragma unroll
            for (int i = 0; i < 8; ++i) { const int id = tid + 512 * i, row = id >> 6, ch = id & 63;
                *(LAS u32x4*)((LAS bf16_t*)(lds + 69632) + row * 520 + ch * 8) = *(const u32x4*)(proj + (tok0 + row) * NP + COL_U + ch * 8); }
        }
        SEAM(4); }
    if (IN(5)) for (int rep_ = 0; rep_ < NREP(5); ++rep_) { if (rep_) xcd_barrier(bar);
#ifndef OFF_P5
        for (int u = blk; u < NB * NCH; u += G) ssm_unit<true>(a, lds, u / NCH, u % NCH, tid, wid, lane, (u + G < NB * NCH) ? u + G : -1);
#endif
        SEAM(5); }
    if (IN(6)) for (int rep_ = 0; rep_ < NREP(6); ++rep_) { if (rep_) xcd_barrier(bar);
#ifndef OFF_P6
        pg8::Gemm g{(const bf16_t*)(a.ws + WS_HB), (const bf16_t*)(a.ws + WS_WOUT), MTOK, DM, DM};
#if MK_FUSE_FINAL
        pg8::OutOrder S{blk};
        pg8::EpiOutFused E{a.in[0], a.out, (const float*)(a.ws + WS_GATE), (const float*)(a.ws + WS_SSQA), a.in[21], (float*)(a.ws + WS_XSLOT), (unsigned*)(a.ws + WS_PCNT), MTOK, DM, SEQ};
        pg8::gemm_phase<pg8::EpiOutFused, pg8::OutOrder, true, true>(lds, g, S, E);
#else
        pg8::StaticOrder S; S.init(MTOK, DM, G, blk);
        pg8::EpiOut E{a.in[0], a.out, (const float*)(a.ws + WS_GATE), (const float*)(a.ws + WS_SSQA), (float*)(a.ws + WS_SSQO), MTOK, DM, SEQ};
        pg8::gemm_phase<pg8::EpiOut, pg8::StaticOrder, true, true>(lds, g, S, E);
#endif
#endif
        SEAM(6); }
    if (IN(7)) {
#if !defined(OFF_P7) && !MK_FUSE_FINAL
        phase_final(a, G, blk, wid, lane);
#endif
    }
#undef IN
#undef SEAM
}

extern "C" void kernel_launch(void* const* d_in, const int* in_sizes, int n_in, void* d_out, int out_size, void* d_ws, size_t ws_size, hipStream_t stream) {
    static int grid = 0;
    if (grid == 0) {
        int dev = 0, cus = 0, per_cu = 0;
        if (n_in != 22 || ws_size < WS_END) { fprintf(stderr, "kernel_launch: unexpected n_in %d / ws_size %zu\n", n_in, ws_size); grid = -1; return; }
        (void)hipGetDevice(&dev); (void)hipDeviceGetAttribute(&cus, hipDeviceAttributeMultiprocessorCount, dev);
        if (hipFuncSetAttribute((const void*)mk_fwd, hipFuncAttributeMaxDynamicSharedMemorySize, LDS_BYTES) != hipSuccess) { fprintf(stderr, "kernel_launch: hipFuncSetAttribute failed\n"); grid = -1; return; }
        if (hipOccupancyMaxActiveBlocksPerMultiprocessor(&per_cu, (const void*)mk_fwd, 512, LDS_BYTES) != hipSuccess || per_cu < 1) { fprintf(stderr, "kernel_launch: occupancy query gave %d\n", per_cu); per_cu = 1; (void)hipGetLastError(); }
        grid = cus * per_cu;
        while (grid > 0 && (MTOK % grid != 0 || SEQ % (MTOK / grid) != 0)) --grid;
    }
    if (grid <= 0) return;
#if MK_FUSE_FINAL
    if (grid != 256) { fprintf(stderr, "kernel_launch: the fused final-norm epilogue needs a 256-workgroup grid, got %d\n", grid); return; }
#endif
    (void)hipMemsetAsync((unsigned char*)d_ws + WS_BAR, 0, 16384 + 32768, stream);
    Args a{};
    for (int i = 0; i < 22; ++i) a.in[i] = (const float*)d_in[i];
    a.out = (float*)d_out; a.ws = (unsigned char*)d_ws;
#if MK_ONE_LAUNCH
    a.ph_lo = 0; a.ph_hi = NPHASE;
    void* args[] = {&a};
    hipError_t e = hipLaunchCooperativeKernel((const void*)mk_fwd, dim3(grid), dim3(512), args, LDS_BYTES, stream);
    if (e != hipSuccess) fprintf(stderr, "cooperative launch failed: %s (grid %d)\n", hipGetErrorString(e), grid);
#else
    for (int p = 0; p < NPHASE; ++p) { a.ph_lo = p; a.ph_hi = p + 1; hipLaunchKernelGGL(mk_fwd, dim3(grid), dim3(512), LDS_BYTES, stream, a); }
#endif
}
```

```cpp
#include <hip/hip_runtime.h>
#include <hip/hip_cooperative_groups.h>
#include <cstdio>
#include <cstdint>
namespace cg = cooperative_groups;
#define MK_ONE_LAUNCH 1
namespace pg8 {
#define PG8_LAS __attribute__((address_space(3)))
typedef unsigned short bf16_t;
typedef short bf16x8 __attribute__((ext_vector_type(8)));
typedef float f32x4 __attribute__((ext_vector_type(4)));
typedef unsigned u32x4 __attribute__((ext_vector_type(4)));
constexpr int BM = 256, BK = 64, HALF = 128, HTB = HALF * BK * 2  , STAGE_BYTES = 8 * HTB, NXCD = 8, WGM = 8;

__host__ __device__ __forceinline__ int lds_byte(int r, int c) { const int st = (r >> 4) * 2 + (c >> 5), rr = r & 15, cc = c & 31, ob = rr * 64 + cc * 2; return st * 1024 + (ob ^ (((ob >> 9) & 1) << 5)); }
__host__ __device__ __forceinline__ void stage_rc(int b, int& R, int& C) { const int st = b / 1024, sb = b % 1024, swz = sb ^ (((sb >> 9) & 1) << 5); R = (st >> 1) * 16 + swz / 64; C = (st & 1) * 32 + (swz % 64) / 2; }
__host__ __device__ __forceinline__ int perm32(int rho) { const int n = rho >> 4, i = rho & 15; return 8 * (i >> 2) + 4 * n + (i & 3); }

struct Unit { int pm, pn; };
struct Gemm { const bf16_t* A; const bf16_t* Bt; int M, N, K; };

struct StaticOrder {
    int nM, nN, nwg, G, c;
    __host__ __device__ void init(int M, int N, int G_, int c_) { nM = M / BM; nN = N / BM; nwg = nM * nN; G = G_; c = c_; }
    __host__ __device__ bool next(int i, Unit& u) const {
        const long L = (long)i * G + c; if (L >= nwg) return false;
        int wgid = (int)L; { const int q = nwg / NXCD, r = nwg % NXCD, xcd = wgid % NXCD, off = wgid / NXCD; wgid = (xcd < r ? xcd * (q + 1) : r * (q + 1) + (xcd - r) * q) + off; }
        const int nig = WGM * nN, gid = wgid / nig, fm = gid * WGM, gsz = (nM - fm) < WGM ? (nM - fm) : WGM;
        u.pm = fm + ((wgid % nig) % gsz); u.pn = (wgid % nig) / gsz; return true;
    }
    __device__ __forceinline__ void a_ready(const Unit&) const {}
    __device__ __forceinline__ void done(const Unit&) const {}
};

__device__ __forceinline__ unsigned cvt_pk_bf16(float lo, float hi) { unsigned r; asm volatile("v_cvt_pk_bf16_f32 %0, %1, %2" : "=v"(r) : "v"(lo), "v"(hi)); return r; }
#ifdef DBG_STAGE
#define DBG_MIX(x) ((f32x4){0.f, 0.f, 0.f, 0.f})
#else
#define DBG_MIX(x) (x)
#endif
typedef unsigned u32x4 __attribute__((ext_vector_type(4)));
__device__ __forceinline__ float silu_f(float v) { return v * __builtin_amdgcn_rcpf(1.0f + __builtin_amdgcn_exp2f(-1.4426950408889634f * v)); }
struct EpiProj {
    static constexpr bool PERM = true, AFTER_DRAIN = false, XCHG = false;
    bf16_t* O; int ldc; const float* bias; float qscale;
    __device__ __forceinline__ void operator()(const f32x4 (&acc)[2][2][4][2], const Unit& u, int wr, int wc, int fr, int fq) const {
        asm volatile("" : "+v"(fr), "+v"(fq));
        const int row0 = u.pm * BM + wr * 64 + fr; const int pn = u.pn;
        const int mode = (pn < 6) ? 1 : (((pn >= 8 && pn < 14) || pn >= 16) ? 2 : 0);
        const float sc = mode == 1 ? qscale : 1.f;
        const int col0 = pn * BM + wc * 32 + 8 * fq;
        f32x4 bv[2][2];
#pragma unroll
        for (int bj = 0; bj < 2; ++bj)
#pragma unroll
            for (int n = 0; n < 2; ++n) bv[bj][n] = *(const f32x4*)(bias + col0 + bj * HALF + 4 * n);
#pragma unroll
        for (int ai = 0; ai < 2; ++ai)
#pragma unroll
            for (int m = 0; m < 4; ++m) { bf16_t* rowp = O + (size_t)(row0 + ai * HALF + m * 16) * ldc + col0;
#pragma unroll
                for (int bj = 0; bj < 2; ++bj) { f32x4 v0 = acc[ai][bj][m][0] + bv[bj][0], v1 = acc[ai][bj][m][1] + bv[bj][1];
                    if (mode == 2) {
#pragma unroll
                        for (int e = 0; e < 4; ++e) { v0[e] = silu_f(v0[e]); v1[e] = silu_f(v1[e]); } }
                    v0 = v0 * sc; v1 = v1 * sc; u32x4 w; w.x = cvt_pk_bf16(v0[0], v0[1]); w.y = cvt_pk_bf16(v0[2], v0[3]); w.z = cvt_pk_bf16(v1[0], v1[1]); w.w = cvt_pk_bf16(v1[2], v1[3]);
                    *(u32x4*)(rowp + bj * HALF) = w; } }
    }
};
struct EpiOut {
    static constexpr bool PERM = true, AFTER_DRAIN = false, XCHG = false;
    const float* x; float* out; const float* gate; const float* ssqa; float* ssqo; int M_, ldc, seq;
    __device__ __forceinline__ void operator()(const f32x4 (&acc)[2][2][4][2], const Unit& u, int wr, int wc, int fr, int fq) const {
        const int col0 = u.pn * BM + wc * 32 + 8 * fq; const int batch = (u.pm * BM) / seq;
        f32x4 gv[2][2];
#pragma unroll
        for (int bj = 0; bj < 2; ++bj)
#pragma unroll
            for (int n = 0; n < 2; ++n) gv[bj][n] = *(const f32x4*)(gate + batch * ldc + col0 + bj * HALF + n * 4);
#pragma unroll
        for (int ai = 0; ai < 2; ++ai)
#pragma unroll
            for (int m = 0; m < 4; ++m) { const int row = u.pm * BM + ai * HALF + wr * 64 + m * 16 + fr; const size_t off = (size_t)row * ldc + col0; float ss = 0.f;
                const float ra = __builtin_amdgcn_rsqf(((ssqa[row] + ssqa[M_ + row]) + ssqa[2 * M_ + row]) * (1.0f / 1536.0f) + 1e-5f);
#pragma unroll
                for (int bj = 0; bj < 2; ++bj)
#pragma unroll
                    for (int n = 0; n < 2; ++n) { const f32x4 xv = *(const f32x4*)(x + off + bj * HALF + n * 4); const f32x4 y = xv + DBG_MIX(gv[bj][n] * (acc[ai][bj][m][n] * ra));
                        *(f32x4*)(out + off + bj * HALF + n * 4) = y; ss += (y[0] * y[0] + y[1] * y[1]) + (y[2] * y[2] + y[3] * y[3]); }
                ss += __shfl_xor(ss, 16); ss += __shfl_xor(ss, 32);
                if (fq == 0) ssqo[(size_t)(u.pn * 4 + wc) * M_ + row] = ss;
                asm volatile("" ::: "memory"); }
    }
};

struct OutOrder {
    int c;
    __device__ __forceinline__ bool next(int i, Unit& u) const { if (i >= 4) return false; const int x = c & 7, j = c >> 3; u.pm = (i * 8 + x) * 4 + (j >> 3); u.pn = j & 7; return true; }
    __device__ __forceinline__ void a_ready(const Unit&) const {}
    __device__ __forceinline__ void done(const Unit&) const {}
};
struct EpiOutFused {
    static constexpr bool PERM = true, AFTER_DRAIN = false, XCHG = true;
    __device__ __forceinline__ void touch(int pm, int pn, int tid) const {
        asm volatile("" : "+v"(tid));
        const unsigned o = (unsigned)((pm * BM + (tid >> 3)) * ldc + pn * BM + (tid & 7) * 32), st = 64u * (unsigned)ldc;
        const float t = (x[o] + x[o + st]) + (x[o + 2u * st] + x[o + 3u * st]);
        if (t == 1.2345678e-33f) out[0] = t;
    }
    const float* x; float* out; const float* gate; const float* ssqa; const float* fgain; float* slots; unsigned* cnt; int M_, ldc, seq;
    __device__ __forceinline__ void xchg(f32x4 (&acc)[2][2][4][2], const Unit& u, int wr, int wc, int fr, int fq, PG8_LAS unsigned char* xl, int wid, int lane) const {
        asm volatile("" : "+v"(fr), "+v"(fq), "+v"(lane));
        PG8_LAS float* P = (PG8_LAS float*)xl;
        PG8_LAS float* S = (PG8_LAS float*)(xl + 4096);
        asm volatile("" ::: "memory");
        const int col0 = u.pn * BM + wc * 32 + 8 * fq; const int batch = (u.pm * BM) / seq;
        {
            f32x4 gv[2][2];
#pragma unroll
            for (int bj = 0; bj < 2; ++bj)
#pragma unroll
                for (int n = 0; n < 2; ++n) gv[bj][n] = *(const f32x4*)(gate + batch * ldc + col0 + bj * HALF + n * 4);
#pragma unroll
            for (int ai = 0; ai < 2; ++ai)
#pragma unroll
                for (int m = 0; m < 4; ++m) { const int lrow = ai * HALF + wr * 64 + m * 16 + fr, row = u.pm * BM + lrow; const size_t off = (size_t)row * ldc + col0; float ss = 0.f;
                    const float ra = __builtin_amdgcn_rsqf(((ssqa[row] + ssqa[M_ + row]) + ssqa[2 * M_ + row]) * (1.0f / 1536.0f) + 1e-5f);
#pragma unroll
                    for (int bj = 0; bj < 2; ++bj)
#pragma unroll
                        for (int n = 0; n < 2; ++n) { const f32x4 xv = __builtin_nontemporal_load((const f32x4*)(x + off + bj * HALF + n * 4)); const f32x4 y = xv + gv[bj][n] * (acc[ai][bj][m][n] * ra);
                            acc[ai][bj][m][n] = y; ss += (y[0] * y[0] + y[1] * y[1]) + (y[2] * y[2] + y[3] * y[3]); }
                    ss += __shfl_xor(ss, 16); ss += __shfl_xor(ss, 32);
                    if (fq == 0) P[lrow * 4 + wc] = ss;
                    asm volatile("" ::: "memory"); }
        }
        asm volatile("s_waitcnt lgkmcnt(0)" ::: "memory"); __builtin_amdgcn_s_barrier(); asm volatile("" ::: "memory");
        const int tid = wid * 64 + lane;
        if (wid < 4) {
            const float s = (P[tid * 4 + 0] + P[tid * 4 + 1]) + (P[tid * 4 + 2] + P[tid * 4 + 3]);
            __hip_atomic_store(slots + ((size_t)(u.pm * BM + tid) * 8 + u.pn), s, __ATOMIC_RELAXED, __HIP_MEMORY_SCOPE_AGENT);
            asm volatile("s_waitcnt vmcnt(0)" ::: "memory");
            if (lane == 0) __hip_atomic_fetch_add(cnt + 64 * u.pm, 1u, __ATOMIC_RELAXED, __HIP_MEMORY_SCOPE_AGENT);
        }
        if (wid == 0) {
            unsigned sp = 0;
            while ((unsigned)__builtin_amdgcn_readfirstlane(__hip_atomic_load(cnt + 64 * u.pm, __ATOMIC_RELAXED, __HIP_MEMORY_SCOPE_AGENT)) < 32u) { __builtin_amdgcn_s_sleep(2); if (++sp > (1u << 22)) break; }
            __builtin_amdgcn_fence(__ATOMIC_ACQUIRE, "agent");
        }
        asm volatile("s_waitcnt vmcnt(0) lgkmcnt(0)" ::: "memory"); __builtin_amdgcn_s_barrier(); asm volatile("" ::: "memory");
        if (wid < 4) {
            const float* sl = slots + (size_t)(u.pm * BM + tid) * 8; float t = 0.f;
#pragma unroll
            for (int k = 0; k < 8; ++k) t += __hip_atomic_load(sl + k, __ATOMIC_RELAXED, __HIP_MEMORY_SCOPE_AGENT);
            S[tid] = __builtin_amdgcn_rsqf(t * (1.0f / 2048.0f) + 1e-5f);
        }
        asm volatile("s_waitcnt lgkmcnt(0)" ::: "memory"); __builtin_amdgcn_s_barrier(); asm volatile("" ::: "memory");
#pragma unroll
        for (int ai = 0; ai < 2; ++ai)
#pragma unroll
            for (int m = 0; m < 4; ++m) { const int lrow = ai * HALF + wr * 64 + m * 16 + fr; const float r = S[lrow]; const size_t off = (size_t)(u.pm * BM + lrow) * ldc + col0;
#pragma unroll
                for (int bj = 0; bj < 2; ++bj)
#pragma unroll
                    for (int n = 0; n < 2; ++n) *(f32x4*)(out + off + bj * HALF + n * 4) = acc[ai][bj][m][n] * r * *(const f32x4*)(fgain + col0 + bj * HALF + n * 4); }
    }
};
template <class Epi, class Sched, bool ALIGN_EPI = false, bool SP2 = false>
__device__ __forceinline__ void gemm_phase(PG8_LAS unsigned char* lds, const Gemm g, const Sched& S, const Epi& E) {
    const int tid = threadIdx.x, wid = __builtin_amdgcn_readfirstlane(tid >> 6), lane = tid & 63, wr = wid >> 2, wc = wid & 3, fr = lane & 15, fq = lane >> 4;
    const int K = g.K, nt = K / BK;
    unsigned voffA[2], voffB[2];
#pragma unroll
    for (int i = 0; i < 2; ++i) { int R, C; stage_rc(tid * 16 + i * 8192, R, C); const int Rb = Epi::PERM ? ((R & ~31) + perm32(R & 31)) : R;
        voffA[i] = (unsigned)(R * K + C) * 2u; voffB[i] = (unsigned)(Rb * K + C) * 2u; }
    const size_t kstep = (size_t)(BK * 2);
    const size_t hstep = (size_t)HALF * K * 2;
    const size_t tstep = 2 * hstep;
    const unsigned ldsw = (unsigned)wid * 1024u;
    const int aoff = lds_byte(wr * 64 + fr, fq * 8), boff = lds_byte(wc * 32 + fr, fq * 8);
#define PG8_SA(b, h) (((b) * 2 + (h)) * HTB)
#define PG8_SB(b, h) ((4 + (b) * 2 + (h)) * HTB)
#define PG8_STAGE(bufoff, gbase, voff) do { _Pragma("unroll") for (int _i = 0; _i < 2; ++_i) \
        __builtin_amdgcn_global_load_lds((const unsigned*)((const char*)(gbase) + (voff)[_i]), (PG8_LAS unsigned*)(lds + (bufoff) + ldsw + _i * 8192), 16, 0, 0); } while (0)
#define PG8_LDA(dst, b, h) do { _Pragma("unroll") for (int m = 0; m < 4; ++m) _Pragma("unroll") for (int k = 0; k < 2; ++k) dst[m][k] = *(const PG8_LAS bf16x8*)(lds + PG8_SA(b, h) + aoff + m * 2048 + k * 1024); } while (0)
#define PG8_LDB(dst, b, h) do { _Pragma("unroll") for (int n = 0; n < 2; ++n) _Pragma("unroll") for (int k = 0; k < 2; ++k) dst[n][k] = *(const PG8_LAS bf16x8*)(lds + PG8_SB(b, h) + boff + n * 2048 + k * 1024); } while (0)
#define PG8_MMA(ai, bj, At, Bt) do { __builtin_amdgcn_s_setprio(1); _Pragma("unroll") for (int m = 0; m < 4; ++m) _Pragma("unroll") for (int n = 0; n < 2; ++n) _Pragma("unroll") for (int k = 0; k < 2; ++k) \
        acc[ai][bj][m][n] = __builtin_amdgcn_mfma_f32_16x16x32_bf16(Bt[n][k], At[m][k], acc[ai][bj][m][n], 0, 0, 0); __builtin_amdgcn_s_setprio(0); } while (0)
#define PG8_WAIT_V(n) asm volatile("s_waitcnt vmcnt(" #n ")" ::: "memory")
#define PG8_WAIT_L(n) asm volatile("s_waitcnt lgkmcnt(" #n ")" ::: "memory")
#define PG8_BAR __builtin_amdgcn_s_barrier()
#define PG8_SCHED __builtin_amdgcn_sched_barrier(0)
    Unit cur, nxt; int ui = 0;
    if (!S.next(0, cur)) return;
    f32x4 acc[2][2][4][2];
#pragma unroll
    for (int a = 0; a < 2; ++a)
#pragma unroll
        for (int b = 0; b < 2; ++b)
#pragma unroll
            for (int m = 0; m < 4; ++m)
#pragma unroll
                for (int n = 0; n < 2; ++n) acc[a][b][m][n] = (f32x4){0.f, 0.f, 0.f, 0.f};
    bf16x8 At[4][2], B0[2][2], B1[2][2];
    const char* cA = (const char*)g.A + (size_t)cur.pm * tstep; const char* cB = (const char*)g.Bt + (size_t)cur.pn * tstep;
    S.a_ready(cur);
    if constexpr (SP2) {
        PG8_STAGE(PG8_SB(0, 0), cB, voffB); PG8_STAGE(PG8_SB(0, 1), cB + hstep, voffB); PG8_STAGE(PG8_SA(0, 0), cA, voffA); PG8_STAGE(PG8_SA(0, 1), cA + hstep, voffA);
        if (wr == 1) PG8_BAR;
        PG8_WAIT_V(2); PG8_BAR;
        PG8_STAGE(PG8_SB(1, 0), cB + kstep, voffB); PG8_STAGE(PG8_SA(1, 0), cA + kstep, voffA); PG8_STAGE(PG8_SB(1, 1), cB + hstep + kstep, voffB);
        PG8_WAIT_V(6); PG8_BAR;
    } else {
        PG8_STAGE(PG8_SB(0, 0), cB, voffB); PG8_STAGE(PG8_SA(0, 0), cA, voffA); PG8_STAGE(PG8_SB(0, 1), cB + hstep, voffB); PG8_STAGE(PG8_SA(0, 1), cA + hstep, voffA);
        if (wr == 1) PG8_BAR;
        PG8_WAIT_V(4); PG8_BAR;
        PG8_STAGE(PG8_SB(1, 0), cB + kstep, voffB); PG8_STAGE(PG8_SA(1, 0), cA + kstep, voffA); PG8_STAGE(PG8_SB(1, 1), cB + hstep + kstep, voffB);
        PG8_WAIT_V(6); PG8_BAR;
    }
    for (;;) {
        const bool has_next = S.next(ui + 1, nxt);
        const char* nA = has_next ? (const char*)g.A + (size_t)nxt.pm * tstep : cA; const char* nB = has_next ? (const char*)g.Bt + (size_t)nxt.pn * tstep : cB;
        for (int t = 0; t < nt; t += 2) {
            const bool last = (t == nt - 2);
            const char* a1 = cA + (size_t)(t + 1) * kstep;
            const char* a2 = last ? nA : cA + (size_t)(t + 2) * kstep; const char* b2 = last ? nB : cB + (size_t)(t + 2) * kstep;
            const char* a3 = a2 + kstep; const char* b3 = b2 + kstep;
            if (last && has_next) S.a_ready(nxt);
            if constexpr (SP2) {
            PG8_LDB(B0, 0, 0); PG8_LDB(B1, 0, 1); PG8_SCHED; PG8_LDA(At, 0, 0); PG8_STAGE(PG8_SA(1, 1), a1 + hstep, voffA);
            PG8_WAIT_V(8); PG8_WAIT_L(0); PG8_BAR; PG8_MMA(0, 0, At, B0); PG8_MMA(0, 1, At, B1); PG8_BAR; PG8_SCHED;
            PG8_LDA(At, 0, 1); PG8_STAGE(PG8_SB(0, 0), b2, voffB); PG8_STAGE(PG8_SB(0, 1), b2 + hstep, voffB); PG8_STAGE(PG8_SA(0, 0), a2, voffA);
            PG8_WAIT_V(8); PG8_WAIT_L(0); PG8_BAR; PG8_MMA(1, 0, At, B0); PG8_MMA(1, 1, At, B1); PG8_BAR; PG8_SCHED;
            PG8_LDB(B0, 1, 0); PG8_LDB(B1, 1, 1); PG8_SCHED; PG8_LDA(At, 1, 0); PG8_STAGE(PG8_SA(0, 1), a2 + hstep, voffA);
            PG8_WAIT_V(8); PG8_WAIT_L(0); PG8_BAR; PG8_MMA(0, 0, At, B0); PG8_MMA(0, 1, At, B1); PG8_BAR; PG8_SCHED;
            PG8_LDA(At, 1, 1); PG8_STAGE(PG8_SB(1, 0), b3, voffB); PG8_STAGE(PG8_SB(1, 1), b3 + hstep, voffB); PG8_STAGE(PG8_SA(1, 0), a3, voffA);
            PG8_WAIT_V(8); PG8_WAIT_L(0); PG8_BAR; PG8_MMA(1, 0, At, B0); PG8_MMA(1, 1, At, B1); PG8_BAR; PG8_SCHED;
            } else {
            PG8_LDB(B0, 0, 0); PG8_SCHED; PG8_LDA(At, 0, 0); PG8_STAGE(PG8_SA(1, 1), a1 + hstep, voffA);
            PG8_WAIT_L(8); PG8_BAR; PG8_WAIT_L(0); PG8_MMA(0, 0, At, B0); PG8_BAR; PG8_SCHED;
            PG8_LDB(B1, 0, 1); PG8_STAGE(PG8_SB(0, 0), b2, voffB);
            PG8_BAR; PG8_WAIT_L(0); PG8_MMA(0, 1, At, B1); PG8_BAR;
            PG8_LDA(At, 0, 1); PG8_STAGE(PG8_SA(0, 0), a2, voffA);
            PG8_BAR; PG8_WAIT_L(0); PG8_MMA(1, 0, At, B0); PG8_BAR; PG8_SCHED;
            PG8_STAGE(PG8_SB(0, 1), b2 + hstep, voffB);
            PG8_WAIT_V(6); PG8_BAR; PG8_MMA(1, 1, At, B1); PG8_BAR;
            PG8_LDB(B0, 1, 0); PG8_SCHED; PG8_LDA(At, 1, 0); PG8_STAGE(PG8_SA(0, 1), a2 + hstep, voffA);
            PG8_WAIT_L(8); PG8_BAR; PG8_WAIT_L(0); PG8_MMA(0, 0, At, B0); PG8_BAR; PG8_SCHED;
            PG8_LDB(B1, 1, 1); PG8_STAGE(PG8_SB(1, 0), b3, voffB);
            PG8_BAR; PG8_WAIT_L(0); PG8_MMA(0, 1, At, B1); PG8_BAR;
            PG8_LDA(At, 1, 1); PG8_STAGE(PG8_SA(1, 0), a3, voffA);
            PG8_BAR; PG8_WAIT_L(0); PG8_MMA(1, 0, At, B0); PG8_BAR; PG8_SCHED;
            PG8_STAGE(PG8_SB(1, 1), b3 + hstep, voffB);
            PG8_WAIT_V(6); PG8_BAR; PG8_MMA(1, 1, At, B1); PG8_BAR;
            }
        }
        if constexpr (ALIGN_EPI) { if (wr == 0) PG8_BAR; }
        if constexpr (!Epi::AFTER_DRAIN) { if constexpr (Epi::XCHG) E.xchg(acc, cur, wr, wc, fr, fq, lds + STAGE_BYTES, wid, lane); else E(acc, cur, wr, wc, fr, fq); S.done(cur); }
        if (!has_next) break;
#pragma unroll
        for (int a = 0; a < 2; ++a)
#pragma unroll
            for (int b = 0; b < 2; ++b)
#pragma unroll
                for (int m = 0; m < 4; ++m)
#pragma unroll
                    for (int n = 0; n < 2; ++n) acc[a][b][m][n] = (f32x4){0.f, 0.f, 0.f, 0.f};
        cur = nxt; cA = nA; cB = nB; ++ui;
        if constexpr (ALIGN_EPI) { if (wr == 1) PG8_BAR; }
    }
    PG8_WAIT_V(0);
    if constexpr (!ALIGN_EPI) { if (wr == 0) PG8_BAR; }
    PG8_BAR;
    if constexpr (Epi::AFTER_DRAIN) { E.fused(acc, cur, wr, wc, fr, fq, lds, wid, lane); S.done(cur); }
#undef PG8_SA
#undef PG8_SB
#undef PG8_STAGE
#undef PG8_LDA
#undef PG8_LDB
#undef PG8_MMA
#undef PG8_WAIT_V
#undef PG8_WAIT_L
#undef PG8_BAR
#undef PG8_SCHED
}
}
#define LAS __attribute__((address_space(3)))
typedef unsigned short bf16_t;
typedef short bf16x8 __attribute__((ext_vector_type(8)));
typedef float f32x4 __attribute__((ext_vector_type(4)));
typedef float f32x2 __attribute__((ext_vector_type(2)));
typedef float f32x16 __attribute__((ext_vector_type(16)));
typedef unsigned u32x4 __attribute__((ext_vector_type(4)));
typedef unsigned u32x2 __attribute__((ext_vector_type(2)));
constexpr int NB = 2, SEQ = 16384, MTOK = NB * SEQ, DM = 2048, NP = 4608, INW = 4480, AW = 1536, SW = 512;
constexpr int COL_Q = 0, COL_K = 1536, COL_V = 1728, COL_ZA = 2048, COL_U = 3584, COL_ZS = 4096;
constexpr int NCH = SEQ / 64;
constexpr float EPSN = 1e-5f, LOG2E = 1.4426950408889634f, QSCALE = 0.125f * LOG2E;
constexpr int KPARTS = 16;
constexpr size_t MiB = 1u << 20;
constexpr size_t WS_WIN = 0, WS_WOUT = 18 * MiB, WS_GLU = 26 * MiB, WS_MODP = 27 * MiB, WS_GATE = 28 * MiB, WS_BIASP = 28 * MiB + 65536,
                 WS_ABAR = 28 * MiB + 131072, WS_A64 = WS_ABAR + 16384, WS_BCAT = 28 * MiB + 196608, WS_CCAT = WS_BCAT + 131072,
                 WS_SSQA = 29 * MiB, WS_SSQO = 30 * MiB, WS_SC = 34 * MiB, WS_HC = 42 * MiB, WS_HB = 64 * MiB, WS_PROJ = 192 * MiB, WS_END = 480 * MiB;
constexpr int LDS_BYTES = 147456;
#ifndef MK_FUSE_FINAL
#define MK_FUSE_FINAL 1
#endif
constexpr int NPHASE = MK_FUSE_FINAL ? 7 : 8;
#ifndef MK_ONE_LAUNCH
#define MK_ONE_LAUNCH 1
#endif

typedef __bf16 bf16x2_t __attribute__((ext_vector_type(2)));
__device__ __forceinline__ unsigned pkbf(float lo, float hi) { const f32x2 v = {lo, hi}; const bf16x2_t b = __builtin_convertvector(v, bf16x2_t); return __builtin_bit_cast(unsigned, b); }
__device__ __forceinline__ float bflo(unsigned v) { return __uint_as_float(v << 16); }
__device__ __forceinline__ float bfhi(unsigned v) { return __uint_as_float(v & 0xffff0000u); }
__device__ __forceinline__ float wave_sum(float v) {
#pragma unroll
    for (int o = 1; o < 64; o <<= 1) v += __shfl_xor(v, o);
    return v;
}
#define LDS_WAIT() asm volatile("s_waitcnt lgkmcnt(0)" ::: "memory")

constexpr size_t WS_BAR = 51 * MiB, WS_PCNT = WS_BAR + 16384, WS_XSLOT = 52 * MiB; constexpr int LDS_ST_OFF = LDS_BYTES - 64;
#define XB_TMO      128
#define XB_XCNT(j)  (256  + 64 * (j))
#define XB_XSUB(j)  (1280 + 64 * (j))
#define XB_XGEN(j)  (2304 + 64 * (j))
#define XB_TOP      3328
#define XB_TOPGEN   3392
#define XCD_BAR_WORDS 3456
#define XB_SPIN_CAP (1u << 18)

__device__ __forceinline__ unsigned xb_ld(unsigned* p)              { return __hip_atomic_load(p, __ATOMIC_RELAXED, __HIP_MEMORY_SCOPE_AGENT); }
__device__ __forceinline__ unsigned xb_add(unsigned* p, unsigned v) { return __hip_atomic_fetch_add(p, v, __ATOMIC_RELAXED, __HIP_MEMORY_SCOPE_AGENT); }
__device__ __forceinline__ unsigned xb_xcc_id() { return (unsigned)__builtin_amdgcn_s_getreg((3 << 11) | 20) & 0xFu; }
#define XB_SPIN(cond, bar) do { unsigned _sp = 0; while (cond) { __builtin_amdgcn_s_sleep(1); \
    if ((++_sp & 255u) == 0u) { if (xb_ld(&(bar)[XB_TMO])) break; if (_sp > XB_SPIN_CAP) { atomicAdd(&(bar)[XB_TMO], 1u); break; } } } } while (0)

struct XcdBarrier {
    unsigned* bar; unsigned x;
    volatile LAS unsigned* st;
};

__device__ __forceinline__ XcdBarrier xcd_barrier_post(unsigned* bar, volatile LAS unsigned* st) {
    XcdBarrier b; b.bar = bar; b.x = xb_xcc_id(); b.st = st;
    if (threadIdx.x == 0) (void)xb_add(&bar[XB_XCNT(b.x)], 1u);
    return b;
}
__device__ __forceinline__ void xcd_barrier_complete(unsigned* bar, unsigned x, unsigned& nloc, unsigned& nx) {
    const unsigned G = gridDim.x * gridDim.y * gridDim.z;
    unsigned sum, cnt, mine, sp = 0u;
    for (;;) {
        sum = 0u; cnt = 0u; mine = 0u;
#pragma unroll
        for (unsigned j = 0; j < 16; ++j) { const unsigned c = xb_ld(&bar[XB_XCNT(j)]); sum += c; cnt += (c > 0u) ? 1u : 0u; mine = (j == x) ? c : mine; }
        if (sum == G) break;
        __builtin_amdgcn_s_sleep(1);
        if ((++sp & 255u) == 0u) { if (xb_ld(&bar[XB_TMO])) break; if (sp > XB_SPIN_CAP) { atomicAdd(&bar[XB_TMO], 1u); break; } }
    }
    nloc = mine > 0u ? mine : 1u; nx = cnt > 0u ? cnt : 1u;
}

__device__ __forceinline__ void xcd_barrier(const XcdBarrier& b) {
    asm volatile("s_waitcnt vmcnt(0)" ::: "memory");
    __syncthreads();
    if (threadIdx.x == 0) {
        unsigned* bar = b.bar;
        __builtin_amdgcn_s_waitcnt(0);
        unsigned nloc = b.st[0], nx = b.st[1];
        if (nloc == 0u) { xcd_barrier_complete(bar, b.x, nloc, nx); b.st[0] = nloc; b.st[1] = nx; }
        const unsigned old = xb_add(&bar[XB_XSUB(b.x)], 1u);
        const unsigned gen = old / nloc;
        if (old + 1u == (gen + 1u) * nloc) {
            __builtin_amdgcn_fence(__ATOMIC_RELEASE, "agent");
            asm volatile("s_waitcnt vmcnt(0)" ::: "memory");
            const unsigned og = xb_add(&bar[XB_TOP], 1u);
            const unsigned tg = og / nx;
            if (og + 1u == (tg + 1u) * nx) xb_add(&bar[XB_TOPGEN], 1u);
            else XB_SPIN(xb_ld(&bar[XB_TOPGEN]) == tg, bar);
            __builtin_amdgcn_fence(__ATOMIC_ACQUIRE, "agent");
            xb_add(&bar[XB_XGEN(b.x)], 1u);
            asm volatile("s_waitcnt vmcnt(0)" ::: "memory");
        } else {
            XB_SPIN(xb_ld(&bar[XB_XGEN(b.x)]) == gen, bar);
            __builtin_amdgcn_fence(__ATOMIC_ACQUIRE, "agent");
            asm volatile("s_waitcnt vmcnt(0)" ::: "memory");
        }
    }
    __syncthreads();
}


struct Args { const float* in[22]; float* out; unsigned char* ws; int ph_lo, ph_hi; };

__device__ __forceinline__ void transpose_item(const float* W, int ldw, int src_n0, int k0, bf16_t* WT, int K, int dst_n0, LAS float* scr, int lane) {
    if (src_n0 >= 0) {
#pragma unroll
        for (int i = 0; i < 32; ++i) { const int kk = 2 * i + (lane >> 5); scr[kk * 33 + (lane & 31)] = __builtin_nontemporal_load(W + (size_t)(k0 + kk) * ldw + src_n0 + (lane & 31)); }
    }
    LDS_WAIT();
    const int c = lane & 7;
#pragma unroll
    for (int j = 0; j < 4; ++j) { const int n = (lane >> 3) + 8 * j; const LAS float* s = scr + (8 * c) * 33 + n;
        u32x4 o = (u32x4){0u, 0u, 0u, 0u};
        if (src_n0 >= 0) { o.x = pkbf(s[0 * 33], s[1 * 33]); o.y = pkbf(s[2 * 33], s[3 * 33]); o.z = pkbf(s[4 * 33], s[5 * 33]); o.w = pkbf(s[6 * 33], s[7 * 33]); }
        *(u32x4*)(WT + (size_t)(dst_n0 + n) * K + k0 + 8 * c) = o; }
    LDS_WAIT();
}

__device__ __forceinline__ void phase0(const Args& a, LAS unsigned char* lds, int G, int blk, int tid, int wid, int lane) {
    unsigned char* ws = a.ws;
    LAS float* scr = (LAS float*)(lds + wid * 8448);
    LAS float* sil = (LAS float*)(lds + 69632);
    const int gw = blk * 8 + wid, NGW = G * 8;
    for (int k = tid; k < 2 * DM; k += 512) { const float cv = a.in[1][k]; sil[k] = cv / (1.0f + __expf(-cv)); }
    __syncthreads();
    {
        const float* wa = a.in[2]; const float* ba = a.in[3]; float* modp = (float*)(ws + WS_MODP);
        constexpr int NJ = 3 * DM / 64, KL = DM / KPARTS;
        for (int it = gw; it < NJ * KPARTS; it += NGW) {
            const int jg = it % NJ, kp = it / NJ, j = 64 * jg + lane; float a0 = 0.f, a1 = 0.f;
            const float* wp = wa + (size_t)(kp * KL) * (3 * DM) + j;
#pragma unroll 32
            for (int k = 0; k < KL; ++k) { const float w = __builtin_nontemporal_load(wp + (size_t)k * (3 * DM)); a0 += sil[kp * KL + k] * w; a1 += sil[DM + kp * KL + k] * w; }
            if (kp == 0) { const float bb = ba[j]; a0 += bb; a1 += bb; }
            modp[(size_t)(kp * 2 + 0) * (3 * DM) + j] = a0; modp[(size_t)(kp * 2 + 1) * (3 * DM) + j] = a1;
        }
    }
    { float* bp = (float*)(ws + WS_BIASP); const float* bi = a.in[6];
      for (int n = blk * 512 + tid; n < NP; n += G * 512) bp[n] = n < 1920 ? bi[n] : (n < 2048 ? 0.f : bi[n - 128]); }
    {
        const float *lre = a.in[9], *lim = a.in[10], *lst = a.in[11], *bre = a.in[12], *bim = a.in[13], *cre = a.in[14], *cim = a.in[15];
        float* abar = (float*)(ws + WS_ABAR); float* a64 = (float*)(ws + WS_A64); bf16_t* Bcat = (bf16_t*)(ws + WS_BCAT); bf16_t* Ccat = (bf16_t*)(ws + WS_CCAT);
        for (int e = (G - 1 - blk) * 512 + tid; e < 32 * 64 * 16; e += G * 512) {
            const int gp = e >> 4, cch = e & 15, g = gp >> 6, p = gp & 63;
            const float step = expf(lst[g]), lr = lre[gp], li = lim[gp];
            const float decay = expf(lr * step); const float ar = decay * cosf(li * step), ai = decay * sinf(li * step);
            const float den = lr * lr + li * li, nr = ar - 1.0f, ni = ai;
            const float cr_ = (nr * lr + ni * li) / den, ci_ = (ni * lr - nr * li) / den;
            if (cch == 0) { abar[2 * gp] = ar; abar[2 * gp + 1] = ai; float pr = ar, pi = ai;
#pragma unroll
                for (int s = 0; s < 6; ++s) { const float tr = pr * pr - pi * pi, ti = 2.0f * pr * pi; pr = tr; pi = ti; }
                a64[2 * gp] = pr; a64[2 * gp + 1] = pi; }
            const float br = bre[e], bi = bim[e];
            const float xr = cr_ * br - ci_ * bi, xi = cr_ * bi + ci_ * br;
            Bcat[((size_t)g * 128 + 2 * p) * 16 + cch] = (bf16_t)(pkbf(xr, 0.f) & 0xffffu);
            Bcat[((size_t)g * 128 + 2 * p + 1) * 16 + cch] = (bf16_t)(pkbf(xi, 0.f) & 0xffffu);
            const float c_r = cre[((size_t)g * 16 + cch) * 64 + p], c_i = cim[((size_t)g * 16 + cch) * 64 + p];
            *(unsigned*)(Ccat + ((size_t)g * 16 + cch) * 128 + 2 * p) = pkbf(c_r, -c_i);
        }
    }
}

__device__ __forceinline__ void phase1(const Args& a, LAS unsigned char* lds, int G, int blk, int tid, int wid, int lane) {
    unsigned char* ws = a.ws;
    const int rpb = MTOK / G, row_lo = blk * rpb, batch = row_lo / SEQ;
    LAS float* gs = (LAS float*)lds; LAS float* sh = gs + DM;
    const float* modp = (const float*)(ws + WS_MODP); const float* ng = a.in[4];
    for (int j = tid; j < DM; j += 512) { float s0 = 0.f, s1 = 0.f, s2 = 0.f;
#pragma unroll
        for (int kp = 0; kp < KPARTS; ++kp) { const float* mp = modp + (size_t)(kp * 2 + batch) * (3 * DM); s0 += mp[j]; s1 += mp[DM + j]; s2 += mp[2 * DM + j]; }
        gs[j] = ng[j] * (1.0f + s1); sh[j] = s0;
        if (row_lo % SEQ == 0) ((float*)(ws + WS_GATE))[batch * DM + j] = s2; }
    __syncthreads();
    if (wid >= 4) {
        LAS float* scr = (LAS float*)(lds + 16384 + (wid - 4) * 8448);
        const int gw = blk * 4 + (wid - 4), NGW = G * 4;
    constexpr int I_IN = (DM / 64) * (NP / 32), I_OUT = (DM / 64) * (DM / 32), I_GLU = (SW / 64) * (SW / 32);
    for (int it = gw; it < I_IN + I_OUT + I_GLU; it += NGW) {
        int r = it;
        if (r < I_IN) { const int nblk = NP / 32, kb = r / nblk, nb = r % nblk, n0 = 32 * nb; const int src = n0 < 1920 ? n0 : (n0 < 2048 ? -1 : n0 - 128);
            transpose_item(a.in[5], INW, src, 64 * kb, (bf16_t*)(ws + WS_WIN), DM, n0, scr, lane); continue; }
        r -= I_IN;
        if (r < I_OUT) { const int nblk = DM / 32, kb = r / nblk, nb = r % nblk; transpose_item(a.in[20], DM, 32 * nb, 64 * kb, (bf16_t*)(ws + WS_WOUT), DM, 32 * nb, scr, lane); continue; }
        r -= I_OUT;
        { const int nblk = SW / 32, kb = r / nblk, nb = r % nblk; transpose_item(a.in[17], SW, 32 * nb, 64 * kb, (bf16_t*)(ws + WS_GLU), SW, 32 * nb, scr, lane); }
    }
        return;
    }
    const float* x = a.in[0]; bf16_t* hb = (bf16_t*)(ws + WS_HB);
    for (int r = row_lo + 2 * wid; r < row_lo + rpb; r += 8) {
        const f32x4* xr = (const f32x4*)(x + (size_t)r * DM) + lane; f32x4 v[2][8]; float ss[2] = {0.f, 0.f};
#pragma unroll
        for (int q = 0; q < 2; ++q)
#pragma unroll
            for (int i = 0; i < 8; ++i) v[q][i] = __builtin_nontemporal_load(xr + q * (DM / 4) + 64 * i);
#pragma unroll
        for (int q = 0; q < 2; ++q)
#pragma unroll
            for (int i = 0; i < 8; ++i) ss[q] += (v[q][i][0] * v[q][i][0] + v[q][i][1] * v[q][i][1]) + (v[q][i][2] * v[q][i][2] + v[q][i][3] * v[q][i][3]);
#pragma unroll
        for (int q = 0; q < 2; ++q) {
            const float rstd = 1.0f / sqrtf(wave_sum(ss[q]) * (1.0f / DM) + EPSN);
            u32x2* o = (u32x2*)(hb + (size_t)(r + q) * DM) + lane;
#pragma unroll
            for (int i = 0; i < 8; ++i) { const f32x4 g4 = *(const LAS f32x4*)(gs + 4 * (lane + 64 * i)), s4 = *(const LAS f32x4*)(sh + 4 * (lane + 64 * i));
                const f32x4 h = v[q][i] * rstd * g4 + s4; u32x2 w; w.x = pkbf(h[0], h[1]); w.y = pkbf(h[2], h[3]); o[64 * i] = w; }
        }
    }
}

#define MFMA32(A, B, C) __builtin_amdgcn_mfma_f32_32x32x16_bf16(A, B, C, 0, 0, 0)
#define MFMA16(A, B, C) __builtin_amdgcn_mfma_f32_16x16x32_bf16(A, B, C, 0, 0, 0)
__device__ __forceinline__ void attn_unit(const Args& a, LAS unsigned char* lds, int b, int kvh, int qb, int tid, int wid, int lane) {
    const bf16_t* proj = (const bf16_t*)(a.ws + WS_PROJ); bf16_t* mixed = (bf16_t*)(a.ws + WS_HB); float* ssqa = (float*)(a.ws + WS_SSQA);
    const int r32 = lane & 31, hi = lane >> 5;
    LAS bf16_t* KS = (LAS bf16_t*)lds;
    LAS bf16_t* VT = (LAS bf16_t*)(lds + 36864);
    LAS bf16_t* OST = (LAS bf16_t*)(lds + 70656 + wid * 4608);
    LAS float* SSQ = (LAS float*)(lds + 107520);
    const long tok0 = (long)b * SEQ + qb * 128;
#pragma unroll
    for (int i = 0; i < 4; ++i) { const int id = tid + 512 * i, row = id >> 3, ch = id & 7;
        u32x4 v = (u32x4){0u, 0u, 0u, 0u};
        if (qb > 0 || row >= 128) v = *(const u32x4*)(proj + (size_t)(tok0 - 128 + row) * NP + COL_K + kvh * 64 + ch * 8);
        *(LAS u32x4*)(KS + row * 72 + ch * 8) = v; }
#pragma unroll
    for (int i = 0; i < 4; ++i) { const int id = tid + 512 * i, row = id & 255, ch = id >> 8;
        u32x4 v = (u32x4){0u, 0u, 0u, 0u};
        if (qb > 0 || row >= 128) v = *(const u32x4*)(proj + (size_t)(tok0 - 128 + row) * NP + COL_V + kvh * 64 + ch * 8);
#pragma unroll
        for (int e = 0; e < 8; ++e) VT[(ch * 8 + e) * 264 + row] = (bf16_t)((v[e >> 1] >> (16 * (e & 1))) & 0xffffu); }
    const int head = kvh * 8 + wid;
    bf16x8 qn[4];
#pragma unroll
    for (int ds = 0; ds < 4; ++ds) qn[ds] = __builtin_nontemporal_load((const bf16x8*)(proj + (size_t)(tok0 + r32) * NP + COL_Q + head * 64 + 16 * ds + 8 * hi));
    __syncthreads();
    const float sink2 = a.in[7][head] * LOG2E;
    const int oc = (lane & 7) * 8;
    const f32x4 g0 = *(const f32x4*)(a.in[8] + head * 64 + oc), g1 = *(const f32x4*)(a.in[8] + head * 64 + oc + 4);
    const float NEG = -1.0e30f;
    for (int s = 0; s < 4; ++s) {
        bf16x8 qf[4];
#pragma unroll
        for (int ds = 0; ds < 4; ++ds) qf[ds] = qn[ds];
        if (s < 3) { const size_t qtok = (size_t)(tok0 + 32 * (s + 1) + r32);
#pragma unroll
            for (int ds = 0; ds < 4; ++ds) qn[ds] = __builtin_nontemporal_load((const bf16x8*)(proj + qtok * NP + COL_Q + head * 64 + 16 * ds + 8 * hi)); }
        u32x4 zp[4];
#pragma unroll
        for (int i = 0; i < 4; ++i) zp[i] = __builtin_nontemporal_load((const u32x4*)(proj + (size_t)(tok0 + 32 * s + 8 * i + (lane >> 3)) * NP + COL_ZA + head * 64 + oc));
        f32x16 S[5];
#pragma unroll
        for (int j = 0; j < 5; ++j) { const int kb0 = 32 * (s + j); f32x16 acc = {};
#pragma unroll
            for (int ds = 0; ds < 4; ++ds) { const bf16x8 kf = *(const LAS bf16x8*)(KS + (kb0 + r32) * 72 + 16 * ds + 8 * hi); acc = MFMA32(kf, qf[ds], acc); }
            S[j] = acc; }
#pragma unroll
        for (int r = 0; r < 16; ++r) { const int kk = (r & 3) + 8 * (r >> 2) + 4 * hi; if (kk <= r32) S[0][r] = NEG; if (kk > r32) S[4][r] = NEG; }
        if (qb == 0) {
#pragma unroll
            for (int j = 0; j < 4; ++j) if (s + j < 4) {
#pragma unroll
                for (int r = 0; r < 16; ++r) S[j][r] = NEG; } }
        float m = NEG;
#pragma unroll
        for (int j = 0; j < 5; ++j)
#pragma unroll
            for (int r = 0; r < 16; ++r) m = fmaxf(m, S[j][r]);
        m = fmaxf(m, __shfl_xor(m, 32));
        float l = 0.f;
#pragma unroll
        for (int j = 0; j < 5; ++j)
#pragma unroll
            for (int r = 0; r < 16; ++r) { const float p = __builtin_amdgcn_exp2f(S[j][r] - m); S[j][r] = p; l += p; }
        l += __shfl_xor(l, 32); l += __builtin_amdgcn_exp2f(sink2 - m);
        f32x16 O[2]; O[0] = (f32x16){}; O[1] = (f32x16){};
#pragma unroll
        for (int j = 0; j < 5; ++j)
#pragma unroll
            for (int s2 = 0; s2 < 2; ++s2) {
                u32x4 pw; pw.x = pkbf(S[j][8 * s2 + 0], S[j][8 * s2 + 1]); pw.y = pkbf(S[j][8 * s2 + 2], S[j][8 * s2 + 3]); pw.z = pkbf(S[j][8 * s2 + 4], S[j][8 * s2 + 5]); pw.w = pkbf(S[j][8 * s2 + 6], S[j][8 * s2 + 7]);
                const bf16x8 pf = __builtin_bit_cast(bf16x8, pw);
                const int kv0 = 32 * (s + j) + 16 * s2 + 4 * hi;
#pragma unroll
                for (int dt = 0; dt < 2; ++dt) { const int d = 32 * dt + r32;
                    const u32x2 lo = *(const LAS u32x2*)(VT + d * 264 + kv0), hh = *(const LAS u32x2*)(VT + d * 264 + kv0 + 8);
                    const u32x4 vw = (u32x4){lo.x, lo.y, hh.x, hh.y};
                    O[dt] = MFMA32(__builtin_bit_cast(bf16x8, vw), pf, O[dt]); }
            }
        const float inv = 1.0f / l; float ss = 0.f;
#pragma unroll
        for (int dt = 0; dt < 2; ++dt)
#pragma unroll
            for (int r = 0; r < 16; ++r) { const float o = O[dt][r] * inv; O[dt][r] = o; ss += o * o; }
        ss += __shfl_xor(ss, 32);
        if (hi == 0) SSQ[wid * 128 + 32 * s + r32] = ss;
#pragma unroll
        for (int dt = 0; dt < 2; ++dt)
#pragma unroll
            for (int rg = 0; rg < 4; ++rg) { u32x2 w; w.x = pkbf(O[dt][4 * rg], O[dt][4 * rg + 1]); w.y = pkbf(O[dt][4 * rg + 2], O[dt][4 * rg + 3]);
                *(LAS u32x2*)(OST + r32 * 72 + 32 * dt + 8 * rg + 4 * hi) = w; }
        LDS_WAIT();
#pragma unroll
        for (int i = 0; i < 4; ++i) { const int row = 8 * i + (lane >> 3); const size_t tok = (size_t)(tok0 + 32 * s + row);
            const u32x4 o8 = *(const LAS u32x4*)(OST + row * 72 + oc);
            const u32x4 z8 = zp[i];
            u32x4 w;
            w.x = pkbf(bflo(o8.x) * g0[0] * bflo(z8.x), bfhi(o8.x) * g0[1] * bfhi(z8.x));
            w.y = pkbf(bflo(o8.y) * g0[2] * bflo(z8.y), bfhi(o8.y) * g0[3] * bfhi(z8.y));
            w.z = pkbf(bflo(o8.z) * g1[0] * bflo(z8.z), bfhi(o8.z) * g1[1] * bfhi(z8.z));
            w.w = pkbf(bflo(o8.w) * g1[2] * bflo(z8.w), bfhi(o8.w) * g1[3] * bfhi(z8.w));
#ifdef DBG_NO_ATTN
            w = (u32x4){0u, 0u, 0u, 0u};
#endif
            *(u32x4*)(mixed + tok * DM + head * 64 + oc) = w; }
        LDS_WAIT();
    }
    __syncthreads();
    if (tid < 128) { float t = 0.f;
#pragma unroll
        for (int w = 0; w < 8; ++w) t += SSQ[w * 128 + tid];
        ssqa[(size_t)kvh * MTOK + tok0 + tid] = t; }
    __syncthreads();
}

__device__ __forceinline__ f32x2 gelu_pk(f32x2 v) {
    const f32x2 av = __builtin_elementwise_abs(v), d = av * 0.2316418882f + 1.0f;
    f32x2 t; t.x = __builtin_amdgcn_rcpf(d.x); t.y = __builtin_amdgcn_rcpf(d.y);
    f32x2 q = t * 0.5307027145f + (-0.7265760135f); q = q * t + 0.7107068705f; q = q * t + (-0.142248368f); q = q * t + 0.127414796f; q = q * t;
    const f32x2 s = (v * v) * (-0.72134752044f);
    f32x2 e; e.x = __builtin_amdgcn_exp2f(s.x); e.y = __builtin_amdgcn_exp2f(s.y);
    const f32x2 mm = v * (q * e), r = v - mm;
    f32x2 o; o.x = v.x < 0.f ? mm.x : r.x; o.y = v.y < 0.f ? mm.y : r.y; return o;
}
template <bool FINAL>
__device__ __forceinline__ void ssm_unit(const Args& a, LAS unsigned char* lds, int b, int c64, int tid, int wid, int lane, int next_u = -1) {
    const bf16_t* proj = (const bf16_t*)(a.ws + WS_PROJ); bf16_t* mixed = (bf16_t*)(a.ws + WS_HB);
    const float* abar = (const float*)(a.ws + WS_ABAR); const bf16_t* Bcat = (const bf16_t*)(a.ws + WS_BCAT); const bf16_t* Ccat = (const bf16_t*)(a.ws + WS_CCAT);
    f32x2* Sc = (f32x2*)(a.ws + WS_SC); const f32x2* Hc = (const f32x2*)(a.ws + WS_HC);
    LAS bf16_t* BUF = (LAS bf16_t*)(lds + wid * 8704);
    LAS bf16_t* TILE = (LAS bf16_t*)(lds + 69632);
    LAS float* SSQ2 = (LAS float*)(lds + 136192);
    const size_t tok0 = (size_t)b * SEQ + 64 * c64;
    const int r32 = lane & 31, hi = lane >> 5, r16 = lane & 15, q4 = lane >> 4;
#if defined(PROBE_P5) && PROBE_P5 == 2
    for (int rp_ = 0; rp_ < (FINAL ? 2 : 1); ++rp_) {
    if (rp_) __syncthreads();
#else
    {
#endif
    if (!FINAL) {
#pragma unroll
    for (int i = 0; i < 8; ++i) { const int id = tid + 512 * i, row = id >> 6, ch = id & 63;
        *(LAS u32x4*)(TILE + row * 520 + ch * 8) = *(const u32x4*)(proj + (tok0 + row) * NP + COL_U + ch * 8); }
    }
    bf16x8 bcN[4], ccN[4]; f32x2 abN, h0N = {0.f, 0.f}; f32x4 d4N = {0.f, 0.f, 0.f, 0.f};
#define SSM_LOADC(G_) do { const int g_ = (G_); \
        _Pragma("unroll") for (int jt = 0; jt < 4; ++jt) bcN[jt] = *(const bf16x8*)(Bcat + ((size_t)(g_ * 128 + 32 * jt + r32) * 16 + 8 * hi)); \
        abN = *(const f32x2*)(abar + (size_t)(g_ * 64 + lane) * 2); \
        if (FINAL) { h0N = Hc[((size_t)(b * NCH + c64) * 32 + g_) * 64 + lane]; d4N = *(const f32x4*)(a.in[16] + g_ * 16 + 4 * q4); \
            _Pragma("unroll") for (int ks = 0; ks < 4; ++ks) ccN[ks] = *(const bf16x8*)(Ccat + ((size_t)(g_ * 16 + r16) * 128 + 32 * ks + 8 * q4)); } } while (0)
    SSM_LOADC(wid);
    __syncthreads();
    for (int gi = 0; gi < 4; ++gi) {
        const int g = wid + 8 * gi;
        bf16x8 bc[4], cc[4];
#pragma unroll
        for (int i = 0; i < 4; ++i) { bc[i] = bcN[i]; cc[i] = ccN[i]; }
        const float ar = abN[0], ai = abN[1]; float hr = h0N[0], hq = h0N[1]; const f32x4 d4 = d4N;
        const size_t sidx = ((size_t)(b * NCH + c64) * 32 + g) * 64 + lane;
        if (gi < 3) SSM_LOADC(g + 8);
        for (int hh = 0; hh < 2; ++hh) {
            const bf16x8 uf = *(const LAS bf16x8*)(TILE + (32 * hh + r32) * 520 + g * 16 + 8 * hi);
#pragma unroll
            for (int jt = 0; jt < 4; ++jt) { f32x16 d = {}; d = MFMA32(bc[jt], uf, d);
#pragma unroll
                for (int rg = 0; rg < 4; ++rg) { u32x2 w; w.x = pkbf(d[4 * rg], d[4 * rg + 1]); w.y = pkbf(d[4 * rg + 2], d[4 * rg + 3]);
                    *(LAS u32x2*)(BUF + r32 * 136 + 32 * jt + 8 * rg + 4 * hi) = w; } }
            LDS_WAIT();
#pragma unroll
            for (int t0 = 0; t0 < 32; t0 += 8) { unsigned v[8];
#pragma unroll
                for (int i = 0; i < 8; ++i) v[i] = *(const LAS unsigned*)(BUF + (t0 + i) * 136 + 2 * lane);
#pragma unroll
                for (int i = 0; i < 8; ++i) { const float bur = bflo(v[i]), bui = bfhi(v[i]);
                    const float nr = fmaf(ar, hr, fmaf(-ai, hq, bur)), ni = fmaf(ar, hq, fmaf(ai, hr, bui)); hr = nr; hq = ni;
                    if (FINAL) *(LAS unsigned*)(BUF + (t0 + i) * 136 + 2 * lane) = pkbf(hr, hq); } }
            if (FINAL) {
                LDS_WAIT();
#pragma unroll
                for (int tt = 0; tt < 2; ++tt) { f32x4 y = {};
#pragma unroll
                    for (int ks = 0; ks < 4; ++ks) { const bf16x8 hf = *(const LAS bf16x8*)(BUF + (16 * tt + r16) * 136 + 32 * ks + 8 * q4); y = MFMA16(cc[ks], hf, y); }
                    const int tl = 32 * hh + 16 * tt + r16;
                    const u32x2 u4 = *(const LAS u32x2*)(TILE + tl * 520 + g * 16 + 4 * q4);
                    const f32x2 ga = gelu_pk((f32x2){y[0] + d4[0] * bflo(u4.x), y[1] + d4[1] * bfhi(u4.x)}), gb = gelu_pk((f32x2){y[2] + d4[2] * bflo(u4.y), y[3] + d4[3] * bfhi(u4.y)});
                    u32x2 w; w.x = pkbf(ga.x, ga.y); w.y = pkbf(gb.x, gb.y);
                    *(LAS u32x2*)(TILE + tl * 520 + g * 16 + 4 * q4) = w; }
                LDS_WAIT();
            }
        }
        if (!FINAL) Sc[sidx] = (f32x2){hr, hq};
    }
    }
#undef SSM_LOADC
    if (!FINAL) __syncthreads();
    if (FINAL) {
        const bf16_t* glu = (const bf16_t*)(a.ws + WS_GLU);
        __syncthreads();
#if defined(PROBE_P5) && PROBE_P5 == 3
        for (int i = tid; i < 64 * 65; i += 512) ((LAS u32x4*)lds)[i] = ((const LAS u32x4*)(lds + 69632))[i];
        __syncthreads();
        _Pragma("nounroll") for (int rp3_ = 0; rp3_ < a.ph_hi - 5; ++rp3_) {
        if (rp3_) { for (int i = tid; i < 64 * 65; i += 512) ((LAS u32x4*)(lds + 69632))[i] = ((const LAS u32x4*)lds)[i]; __syncthreads(); }
#else
        {
#endif
        f32x16 acc[2][2];
#pragma unroll
        for (int i = 0; i < 2; ++i)
#pragma unroll
            for (int j = 0; j < 2; ++j) acc[i][j] = (f32x16){};
        const int nb = 64 * wid;
        bf16x8 gA0[4][2], gA1[4][2];
        const bf16_t* gl0 = glu + (size_t)(nb + r32) * SW + 8 * hi;
#define GLU_LOAD(BUFV, c) do { _Pragma("unroll") for (int k4 = 0; k4 < 4; ++k4) { BUFV[k4][0] = *(const bf16x8*)(gl0 + 16 * (4 * (c) + k4)); BUFV[k4][1] = *(const bf16x8*)(gl0 + 32 * SW + 16 * (4 * (c) + k4)); } } while (0)
#define GLU_MMA(BUFV, c) do { _Pragma("unroll") for (int k4 = 0; k4 < 4; ++k4) { const int ks = 4 * (c) + k4; bf16x8 bf[2]; \
            _Pragma("unroll") for (int tt = 0; tt < 2; ++tt) bf[tt] = *(const LAS bf16x8*)(TILE + (32 * tt + r32) * 520 + 16 * ks + 8 * hi); \
            _Pragma("unroll") for (int nt = 0; nt < 2; ++nt) _Pragma("unroll") for (int tt = 0; tt < 2; ++tt) acc[nt][tt] = MFMA32(BUFV[k4][nt], bf[tt], acc[nt][tt]); } } while (0)
#if defined(PROBE_P5) && PROBE_P5 == 1
        for (int rp_ = 0; rp_ < 2; ++rp_) {
        for (int i = 0; i < 2; ++i) for (int j = 0; j < 2; ++j) acc[i][j] = (f32x16){};
#else
        {
#endif
        GLU_LOAD(gA0, 0);
#pragma unroll 1
        for (int c = 0; c < 8; c += 2) {
            GLU_LOAD(gA1, c + 1);
            asm volatile("" ::: "memory");
            GLU_MMA(gA0, c);
            if (c + 2 < 8) GLU_LOAD(gA0, c + 2);
            asm volatile("" ::: "memory");
            GLU_MMA(gA1, c + 1);
        }
        }
#undef GLU_LOAD
#undef GLU_MMA
#pragma unroll
        for (int tt = 0; tt < 2; ++tt) { const int t = 32 * tt + r32; float ss = 0.f;
#pragma unroll
            for (int nt = 0; nt < 2; ++nt)
#pragma unroll
                for (int rg = 0; rg < 4; ++rg) { const int n0 = nb + 32 * nt + 8 * rg + 4 * hi;
                    const u32x2 s4 = *(const LAS u32x2*)(TILE + t * 520 + n0); const f32x4 b4 = *(const f32x4*)(a.in[18] + n0);
                    const float sv[4] = {bflo(s4.x), bfhi(s4.x), bflo(s4.y), bfhi(s4.y)};
#pragma unroll
                    for (int e = 0; e < 4; ++e) { const float gl = acc[nt][tt][4 * rg + e] + b4[e]; const float gv = sv[e] * __builtin_amdgcn_rcpf(1.0f + __builtin_amdgcn_exp2f(-LOG2E * gl));
                        acc[nt][tt][4 * rg + e] = gv; ss += gv * gv; } }
            ss += __shfl_xor(ss, 32);
            if (hi == 0) SSQ2[wid * 64 + t] = ss; }
        u32x4 zpre[8];
#pragma unroll
        for (int i = 0; i < 8; ++i) { const int id = tid + 512 * i, row = id >> 6, ch = id & 63; zpre[i] = __builtin_nontemporal_load((const u32x4*)(proj + (tok0 + row) * NP + COL_ZS + ch * 8)); }
        __syncthreads();
#pragma unroll
        for (int tt = 0; tt < 2; ++tt) { const int t = 32 * tt + r32; float tot = 0.f;
#pragma unroll
            for (int w = 0; w < 8; ++w) tot += SSQ2[w * 64 + t];
            const float* sq = (const float*)(a.ws + WS_SSQA) + tok0 + t;
            const float rstd = sqrtf((((sq[0] + sq[MTOK]) + sq[2 * MTOK]) * (1.0f / AW) + EPSN) / (tot * (1.0f / SW) + EPSN));
#pragma unroll
            for (int nt = 0; nt < 2; ++nt)
#pragma unroll
                for (int rg = 0; rg < 4; ++rg) { const int n0 = nb + 32 * nt + 8 * rg + 4 * hi; const f32x4 g4 = *(const f32x4*)(a.in[19] + n0);
                    u32x2 w; w.x = pkbf(acc[nt][tt][4 * rg] * rstd * g4[0], acc[nt][tt][4 * rg + 1] * rstd * g4[1]); w.y = pkbf(acc[nt][tt][4 * rg + 2] * rstd * g4[2], acc[nt][tt][4 * rg + 3] * rstd * g4[3]);
                    *(LAS u32x2*)(TILE + t * 520 + n0) = w; } }
        __syncthreads();
#pragma unroll
        for (int i = 0; i < 8; ++i) { const int id = tid + 512 * i, row = id >> 6, ch = id & 63;
            const u32x4 o8 = *(const LAS u32x4*)(TILE + row * 520 + ch * 8);
            const u32x4 z8 = zpre[i];
            u32x4 w;
            w.x = pkbf(bflo(o8.x) * bflo(z8.x), bfhi(o8.x) * bfhi(z8.x)); w.y = pkbf(bflo(o8.y) * bflo(z8.y), bfhi(o8.y) * bfhi(z8.y));
            w.z = pkbf(bflo(o8.z) * bflo(z8.z), bfhi(o8.z) * bfhi(z8.z)); w.w = pkbf(bflo(o8.w) * bflo(z8.w), bfhi(o8.w) * bfhi(z8.w));
#ifdef DBG_NO_SSM
            w = (u32x4){0u, 0u, 0u, 0u};
#endif
#ifdef DBG_SAN_SSM
            { unsigned* wp = (unsigned*)&w; for (int e = 0; e < 4; ++e) { unsigned x = wp[e]; if ((x & 0x7f80u) == 0x7f80u) x &= 0xffff0000u; if ((x & 0x7f800000u) == 0x7f800000u) x &= 0xffffu; wp[e] = x; } }
#endif
            *(u32x4*)(mixed + (tok0 + row) * DM + AW + ch * 8) = w; }
        __syncthreads();
        if (next_u >= 0) { const size_t tokn = (size_t)(next_u / NCH) * SEQ + 64 * (next_u % NCH);
#pragma unroll
            for (int i = 0; i < 8; ++i) { const int id = tid + 512 * i, row = id >> 6, ch = id & 63;
                *(LAS u32x4*)(TILE + row * 520 + ch * 8) = *(const u32x4*)(proj + (tokn + row) * NP + COL_U + ch * 8); } }
        }
    }
}

__device__ __forceinline__ void phase_carry(const Args& a, LAS unsigned char* lds, int blk, int wid, int lane) {
    if (blk >= NB * 32) return;
    const int b = blk >> 5, g = blk & 31;
    const f32x2 aa = *(const f32x2*)((const float*)(a.ws + WS_A64) + (size_t)(g * 64 + lane) * 2);
    const f32x2* Sc = (const f32x2*)(a.ws + WS_SC); f32x2* Hc = (f32x2*)(a.ws + WS_HC);
    LAS f32x2* E = (LAS f32x2*)lds;
    const size_t base = ((size_t)(b * NCH + 32 * wid) * 32 + g) * 64 + lane;
    f32x2 s[32];
#pragma unroll
    for (int i = 0; i < 32; ++i) s[i] = Sc[base + (size_t)i * 2048];
    float hr = 0.f, hq = 0.f;
#pragma unroll
    for (int i = 0; i < 32; ++i) { const float sr = s[i][0], si = s[i][1]; s[i] = (f32x2){hr, hq};
        const float nr = fmaf(aa[0], hr, fmaf(-aa[1], hq, sr)), ni = fmaf(aa[0], hq, fmaf(aa[1], hr, si)); hr = nr; hq = ni; }
    E[wid * 64 + lane] = (f32x2){hr, hq};
    float pr = aa[0], pi = aa[1];
#pragma unroll
    for (int q = 0; q < 5; ++q) { const float tr = pr * pr - pi * pi, ti = 2.0f * pr * pi; pr = tr; pi = ti; }
    __syncthreads();
    float cr = 0.f, ci = 0.f;
    for (int v = 0; v < wid; ++v) { const f32x2 e = E[v * 64 + lane]; const float nr = fmaf(pr, cr, fmaf(-pi, ci, e[0])), ni = fmaf(pr, ci, fmaf(pi, cr, e[1])); cr = nr; ci = ni; }
#pragma unroll
    for (int i = 0; i < 32; ++i) { Hc[base + (size_t)i * 2048] = (f32x2){s[i][0] + cr, s[i][1] + ci};
        const float nr = aa[0] * cr - aa[1] * ci, ni = aa[0] * ci + aa[1] * cr; cr = nr; ci = ni; }
    __syncthreads();
}

__device__ __forceinline__ void phase_final(const Args& a, int G, int blk, int wid, int lane) {
    const float* ssqo = (const float*)(a.ws + WS_SSQO); const float* fg = a.in[21]; float* out = a.out;
    f32x4 g4[8];
#pragma unroll
    for (int i = 0; i < 8; ++i) g4[i] = *((const f32x4*)fg + lane + 64 * i);
    for (int r = blk * 8 + wid; r < MTOK; r += G * 8) {
        float s = lane < 32 ? ssqo[(size_t)lane * MTOK + r] : 0.f;
        const float rstd = 1.0f / sqrtf(wave_sum(s) * (1.0f / DM) + EPSN);
        f32x4* o = (f32x4*)(out + (size_t)r * DM) + lane;
#pragma unroll
        for (int i = 0; i < 8; ++i) { const f32x4 v = o[64 * i]; o[64 * i] = v * rstd * g4[i]; }
    }
}

__global__ void __launch_bounds__(512, 2) mk_fwd(Args a) {
    extern __shared__ __attribute__((aligned(16))) unsigned char lds_raw[];
    LAS unsigned char* lds = (LAS unsigned char*)lds_raw;
    cg::grid_group grid = cg::this_grid();
    const int tid = threadIdx.x, lane = tid & 63, wid = __builtin_amdgcn_readfirstlane(tid >> 6);
    const int G = gridDim.x, blk = blockIdx.x;
    const int lo = a.ph_lo, hi_ph = a.ph_hi;
    if (tid < 16) ((LAS unsigned*)(lds + LDS_ST_OFF))[tid] = 0u;
    __syncthreads();
    XcdBarrier bar = xcd_barrier_post((unsigned*)(a.ws + WS_BAR), (volatile LAS unsigned*)(lds + LDS_ST_OFF));
    if (hi_ph > 1000) grid.sync();
#define IN(k) (lo <= (k) && (k) < hi_ph)
#define SEAM(k) do { if ((k) + 1 < hi_ph) xcd_barrier(bar); } while (0)
#ifndef REPMASK
#define REPMASK 0
#endif
#define NREP(k) (((REPMASK >> (k)) & 1) ? 2 : 1)
    if (IN(0)) for (int rep_ = 0; rep_ < NREP(0); ++rep_) { if (rep_) xcd_barrier(bar);
#ifndef OFF_P0
        phase0(a, lds, G, blk, tid, wid, lane);
#endif
        SEAM(0); }
#ifdef EXTRA_SYNCS
    for (int es_ = 0; es_ < EXTRA_SYNCS; ++es_) xcd_barrier(bar);
#endif
    if (IN(1)) for (int rep_ = 0; rep_ < NREP(1); ++rep_) { if (rep_) xcd_barrier(bar);
#ifndef OFF_P1
        phase1(a, lds, G, blk, tid, wid, lane);
#endif
        SEAM(1); }
    if (IN(2)) for (int rep_ = 0; rep_ < NREP(2); ++rep_) { if (rep_) xcd_barrier(bar);
#ifndef OFF_P2
        pg8::Gemm g{(const bf16_t*)(a.ws + WS_HB), (const bf16_t*)(a.ws + WS_WIN), MTOK, NP, DM}; pg8::StaticOrder S; S.init(MTOK, NP, G, blk);
        pg8::EpiProj E{(bf16_t*)(a.ws + WS_PROJ), NP, (const float*)(a.ws + WS_BIASP), QSCALE};
        pg8::gemm_phase<pg8::EpiProj, pg8::StaticOrder, true, true>(lds, g, S, E);
#endif
        SEAM(2); }
    if (IN(3)) for (int rep_ = 0; rep_ < NREP(3); ++rep_) { if (rep_) xcd_barrier(bar);
        constexpr int NATT = NB * 3 * (SEQ / 128), NSSM = NB * NCH;
#ifndef OFF_P3A
        for (int L = blk; L < NATT; L += G) { const int qb = L % (SEQ / 128), r = L / (SEQ / 128), kvh = r % 3, b = r / 3; attn_unit(a, lds, b, kvh, qb, tid, wid, lane); }
#endif
#ifndef OFF_P3B
        for (int u = blk; u < NSSM; u += G) ssm_unit<false>(a, lds, u / NCH, u % NCH, tid, wid, lane);
#endif
        SEAM(3); }
    if (IN(4)) for (int rep_ = 0; rep_ < NREP(4); ++rep_) { if (rep_) xcd_barrier(bar);
#ifndef OFF_P4
        phase_carry(a, lds, blk, wid, lane);
#endif
        if (blk < NB * NCH) {
            const bf16_t* proj = (const bf16_t*)(a.ws + WS_PROJ); const size_t tok0 = (size_t)(blk / NCH) * SEQ + 64 * (blk % NCH);
#pragma unroll
            for (int i = 0; i < 8; ++i) { const int id = tid + 512 * i, row = id >> 6, ch = id & 63;
                *(LAS u32x4*)((LAS bf16_t*)(lds + 69632) + row * 520 + ch * 8) = *(const u32x4*)(proj + (tok0 + row) * NP + COL_U + ch * 8); }
        }
        SEAM(4); }
    if (IN(5)) for (int rep_ = 0; rep_ < NREP(5); ++rep_) { if (rep_) xcd_barrier(bar);
#ifndef OFF_P5
        for (int u = blk; u < NB * NCH; u += G) ssm_unit<true>(a, lds, u / NCH, u % NCH, tid, wid, lane, (u + G < NB * NCH) ? u + G : -1);
#endif
        SEAM(5); }
    if (IN(6)) for (int rep_ = 0; rep_ < NREP(6); ++rep_) { if (rep_) xcd_barrier(bar);
#ifndef OFF_P6
        pg8::Gemm g{(const bf16_t*)(a.ws + WS_HB), (const bf16_t*)(a.ws + WS_WOUT), MTOK, DM, DM};
#if MK_FUSE_FINAL
        pg8::OutOrder S{blk};
        pg8::EpiOutFused E{a.in[0], a.out, (const float*)(a.ws + WS_GATE), (const float*)(a.ws + WS_SSQA), a.in[21], (float*)(a.ws + WS_XSLOT), (unsigned*)(a.ws + WS_PCNT), MTOK, DM, SEQ};
        pg8::gemm_phase<pg8::EpiOutFused, pg8::OutOrder, true, true>(lds, g, S, E);
#else
        pg8::StaticOrder S; S.init(MTOK, DM, G, blk);
        pg8::EpiOut E{a.in[0], a.out, (const float*)(a.ws + WS_GATE), (const float*)(a.ws + WS_SSQA), (float*)(a.ws + WS_SSQO), MTOK, DM, SEQ};
        pg8::gemm_phase<pg8::EpiOut, pg8::StaticOrder, true, true>(lds, g, S, E);
#endif
#endif
        SEAM(6); }
    if (IN(7)) {
#if !defined(OFF_P7) && !MK_FUSE_FINAL
        phase_final(a, G, blk, wid, lane);
#endif
    }
#undef IN
#undef SEAM
}

extern "C" void kernel_launch(void* const* d_in, const int* in_sizes, int n_in, void* d_out, int out_size, void* d_ws, size_t ws_size, hipStream_t stream) {
    static int grid = 0;
    if (grid == 0) {
        int dev = 0, cus = 0, per_cu = 0;
        if (n_in != 22 || ws_size < WS_END) { fprintf(stderr, "kernel_launch: unexpected n_in %d / ws_size %zu\n", n_in, ws_size); grid = -1; return; }
        (void)hipGetDevice(&dev); (void)hipDeviceGetAttribute(&cus, hipDeviceAttributeMultiprocessorCount, dev);
        if (hipFuncSetAttribute((const void*)mk_fwd, hipFuncAttributeMaxDynamicSharedMemorySize, LDS_BYTES) != hipSuccess) { fprintf(stderr, "kernel_launch: hipFuncSetAttribute failed\n"); grid = -1; return; }
        if (hipOccupancyMaxActiveBlocksPerMultiprocessor(&per_cu, (const void*)mk_fwd, 512, LDS_BYTES) != hipSuccess || per_cu < 1) { fprintf(stderr, "kernel_launch: occupancy query gave %d\n", per_cu); per_cu = 1; (void)hipGetLastError(); }
        grid = cus * per_cu;
        while (grid > 0 && (MTOK % grid != 0 || SEQ % (MTOK / grid) != 0)) --grid;
    }
    if (grid <= 0) return;
#if MK_FUSE_FINAL
    if (grid != 256) { fprintf(stderr, "kernel_launch: the fused final-norm epilogue needs a 256-workgroup grid, got %d\n", grid); return; }
#endif
    (void)hipMemsetAsync((unsigned char*)d_ws + WS_BAR, 0, 16384 + 32768, stream);
    Args a{};
    for (int i = 0; i < 22; ++i) a.in[i] = (const float*)d_in[i];
    a.out = (float*)d_out; a.ws = (unsigned char*)d_ws;
#if MK_ONE_LAUNCH
    a.ph_lo = 0; a.ph_hi = NPHASE;
    void* args[] = {&a};
    hipError_t e = hipLaunchCooperativeKernel((const void*)mk_fwd, dim3(grid), dim3(512), args, LDS_BYTES, stream);
    if (e != hipSuccess) fprintf(stderr, "cooperative launch failed: %s (grid %d)\n", hipGetErrorString(e), grid);
#else
    for (int p = 0; p < NPHASE; ++p) { a.ph_lo = p; a.ph_hi = p + 1; hipLaunchKernelGGL(mk_fwd, dim3(grid), dim3(512), LDS_BYTES, stream, a); }
#endif
}
```

```cpp
#include <hip/hip_runtime.h>
#include <hip/hip_cooperative_groups.h>
#include <cstdio>
#include <cstdint>
namespace cg = cooperative_groups;
#define MK_ONE_LAUNCH 1
namespace pg8 {
#define PG8_LAS __attribute__((address_space(3)))
typedef unsigned short bf16_t;
typedef short bf16x8 __attribute__((ext_vector_type(8)));
typedef float f32x4 __attribute__((ext_vector_type(4)));
typedef unsigned u32x4 __attribute__((ext_vector_type(4)));
constexpr int BM = 256, BK = 64, HALF = 128, HTB = HALF * BK * 2  , STAGE_BYTES = 8 * HTB, NXCD = 8, WGM = 8;

__host__ __device__ __forceinline__ int lds_byte(int r, int c) { const int st = (r >> 4) * 2 + (c >> 5), rr = r & 15, cc = c & 31, ob = rr * 64 + cc * 2; return st * 1024 + (ob ^ (((ob >> 9) & 1) << 5)); }
__host__ __device__ __forceinline__ void stage_rc(int b, int& R, int& C) { const int st = b / 1024, sb = b % 1024, swz = sb ^ (((sb >> 9) & 1) << 5); R = (st >> 1) * 16 + swz / 64; C = (st & 1) * 32 + (swz % 64) / 2; }
__host__ __device__ __forceinline__ int perm32(int rho) { const int n = rho >> 4, i = rho & 15; return 8 * (i >> 2) + 4 * n + (i & 3); }

struct Unit { int pm, pn; };
struct Gemm { const bf16_t* A; const bf16_t* Bt; int M, N, K; };

struct StaticOrder {
    int nM, nN, nwg, G, c;
    __host__ __device__ void init(int M, int N, int G_, int c_) { nM = M / BM; nN = N / BM; nwg = nM * nN; G = G_; c = c_; }
    __host__ __device__ bool next(int i, Unit& u) const {
        const long L = (long)i * G + c; if (L >= nwg) return false;
        int wgid = (int)L; { const int q = nwg / NXCD, r = nwg % NXCD, xcd = wgid % NXCD, off = wgid / NXCD; wgid = (xcd < r ? xcd * (q + 1) : r * (q + 1) + (xcd - r) * q) + off; }
        const int nig = WGM * nN, gid = wgid / nig, fm = gid * WGM, gsz = (nM - fm) < WGM ? (nM - fm) : WGM;
        u.pm = fm + ((wgid % nig) % gsz); u.pn = (wgid % nig) / gsz; return true;
    }
    __device__ __forceinline__ void a_ready(const Unit&) const {}
    __device__ __forceinline__ void done(const Unit&) const {}
};

__device__ __forceinline__ unsigned cvt_pk_bf16(float lo, float hi) { unsigned r; asm volatile("v_cvt_pk_bf16_f32 %0, %1, %2" : "=v"(r) : "v"(lo), "v"(hi)); return r; }
#ifdef DBG_STAGE
#define DBG_MIX(x) ((f32x4){0.f, 0.f, 0.f, 0.f})
#else
#define DBG_MIX(x) (x)
#endif
typedef unsigned u32x4 __attribute__((ext_vector_type(4)));
__device__ __forceinline__ float silu_f(float v) { return v * __builtin_amdgcn_rcpf(1.0f + __builtin_amdgcn_exp2f(-1.4426950408889634f * v)); }
struct EpiProj {
    static constexpr bool PERM = true, AFTER_DRAIN = false, XCHG = false;
    bf16_t* O; int ldc; const float* bias; float qscale;
    __device__ __forceinline__ void operator()(const f32x4 (&acc)[2][2][4][2], const Unit& u, int wr, int wc, int fr, int fq) const {
        asm volatile("" : "+v"(fr), "+v"(fq));
        const int row0 = u.pm * BM + wr * 64 + fr; const int pn = u.pn;
        const int mode = (pn < 6) ? 1 : (((pn >= 8 && pn < 14) || pn >= 16) ? 2 : 0);
        const float sc = mode == 1 ? qscale : 1.f;
        const int col0 = pn * BM + wc * 32 + 8 * fq;
        f32x4 bv[2][2];
#pragma unroll
        for (int bj = 0; bj < 2; ++bj)
#pragma unroll
            for (int n = 0; n < 2; ++n) bv[bj][n] = *(const f32x4*)(bias + col0 + bj * HALF + 4 * n);
#pragma unroll
        for (int ai = 0; ai < 2; ++ai)
#pragma unroll
            for (int m = 0; m < 4; ++m) { bf16_t* rowp = O + (size_t)(row0 + ai * HALF + m * 16) * ldc + col0;
#pragma unroll
                for (int bj = 0; bj < 2; ++bj) { f32x4 v0 = acc[ai][bj][m][0] + bv[bj][0], v1 = acc[ai][bj][m][1] + bv[bj][1];
                    if (mode == 2) {
#pragma unroll
                        for (int e = 0; e < 4; ++e) { v0[e] = silu_f(v0[e]); v1[e] = silu_f(v1[e]); } }
                    v0 = v0 * sc; v1 = v1 * sc; u32x4 w; w.x = cvt_pk_bf16(v0[0], v0[1]); w.y = cvt_pk_bf16(v0[2], v0[3]); w.z = cvt_pk_bf16(v1[0], v1[1]); w.w = cvt_pk_bf16(v1[2], v1[3]);
                    __builtin_nontemporal_store(w, (u32x4*)(rowp + bj * HALF)); } }
    }
};
struct EpiOut {
    static constexpr bool PERM = true, AFTER_DRAIN = false, XCHG = false;
    const float* x; float* out; const float* gate; const float* ssqa; float* ssqo; int M_, ldc, seq;
    __device__ __forceinline__ void operator()(const f32x4 (&acc)[2][2][4][2], const Unit& u, int wr, int wc, int fr, int fq) const {
        const int col0 = u.pn * BM + wc * 32 + 8 * fq; const int batch = (u.pm * BM) / seq;
        f32x4 gv[2][2];
#pragma unroll
        for (int bj = 0; bj < 2; ++bj)
#pragma unroll
            for (int n = 0; n < 2; ++n) gv[bj][n] = *(const f32x4*)(gate + batch * ldc + col0 + bj * HALF + n * 4);
#pragma unroll
        for (int ai = 0; ai < 2; ++ai)
#pragma unroll
            for (int m = 0; m < 4; ++m) { const int row = u.pm * BM + ai * HALF + wr * 64 + m * 16 + fr; const size_t off = (size_t)row * ldc + col0; float ss = 0.f;
                const float ra = __builtin_amdgcn_rsqf(((ssqa[row] + ssqa[M_ + row]) + ssqa[2 * M_ + row]) * (1.0f / 1536.0f) + 1e-5f);
#pragma unroll
                for (int bj = 0; bj < 2; ++bj)
#pragma unroll
                    for (int n = 0; n < 2; ++n) { const f32x4 xv = *(const f32x4*)(x + off + bj * HALF + n * 4); const f32x4 y = xv + DBG_MIX(gv[bj][n] * (acc[ai][bj][m][n] * ra));
                        *(f32x4*)(out + off + bj * HALF + n * 4) = y; ss += (y[0] * y[0] + y[1] * y[1]) + (y[2] * y[2] + y[3] * y[3]); }
                ss += __shfl_xor(ss, 16); ss += __shfl_xor(ss, 32);
                if (fq == 0) ssqo[(size_t)(u.pn * 4 + wc) * M_ + row] = ss;
                asm volatile("" ::: "memory"); }
    }
};

struct OutOrder {
    int c;
    __device__ __forceinline__ bool next(int i, Unit& u) const { if (i >= 4) return false; const int x = c & 7, j = c >> 3; u.pm = (i * 8 + x) * 4 + (j >> 3); u.pn = j & 7; return true; }
    __device__ __forceinline__ void a_ready(const Unit&) const {}
    __device__ __forceinline__ void done(const Unit&) const {}
};
struct EpiOutFused {
    static constexpr bool PERM = true, AFTER_DRAIN = false, XCHG = true;
    __device__ __forceinline__ void touch(int pm, int pn, int tid) const {
        asm volatile("" : "+v"(tid));
        const unsigned o = (unsigned)((pm * BM + (tid >> 3)) * ldc + pn * BM + (tid & 7) * 32), st = 64u * (unsigned)ldc;
        const float t = (x[o] + x[o + st]) + (x[o + 2u * st] + x[o + 3u * st]);
        if (t == 1.2345678e-33f) out[0] = t;
    }
    const float* x; float* out; const float* gate; const float* ssqa; const float* fgain; float* slots; unsigned* cnt; int M_, ldc, seq;
    __device__ __forceinline__ void xchg(f32x4 (&acc)[2][2][4][2], const Unit& u, int wr, int wc, int fr, int fq, PG8_LAS unsigned char* xl, int wid, int lane) const {
        asm volatile("" : "+v"(fr), "+v"(fq), "+v"(lane));
        PG8_LAS float* P = (PG8_LAS float*)xl;
        PG8_LAS float* S = (PG8_LAS float*)(xl + 4096);
        asm volatile("" ::: "memory");
        const int col0 = u.pn * BM + wc * 32 + 8 * fq; const int batch = (u.pm * BM) / seq;
        {
            f32x4 gv[2][2];
#pragma unroll
            for (int bj = 0; bj < 2; ++bj)
#pragma unroll
                for (int n = 0; n < 2; ++n) gv[bj][n] = *(const f32x4*)(gate + batch * ldc + col0 + bj * HALF + n * 4);
#pragma unroll
            for (int ai = 0; ai < 2; ++ai)
#pragma unroll
                for (int m = 0; m < 4; ++m) { const int lrow = ai * HALF + wr * 64 + m * 16 + fr, row = u.pm * BM + lrow; const size_t off = (size_t)row * ldc + col0; float ss = 0.f;
                    const float ra = __builtin_amdgcn_rsqf(((ssqa[row] + ssqa[M_ + row]) + ssqa[2 * M_ + row]) * (1.0f / 1536.0f) + 1e-5f);
#pragma unroll
                    for (int bj = 0; bj < 2; ++bj)
#pragma unroll
                        for (int n = 0; n < 2; ++n) { const f32x4 xv = __builtin_nontemporal_load((const f32x4*)(x + off + bj * HALF + n * 4)); const f32x4 y = xv + gv[bj][n] * (acc[ai][bj][m][n] * ra);
                            acc[ai][bj][m][n] = y; ss += (y[0] * y[0] + y[1] * y[1]) + (y[2] * y[2] + y[3] * y[3]); }
                    ss += __shfl_xor(ss, 16); ss += __shfl_xor(ss, 32);
                    if (fq == 0) P[lrow * 4 + wc] = ss;
                    asm volatile("" ::: "memory"); }
        }
        asm volatile("s_waitcnt lgkmcnt(0)" ::: "memory"); __builtin_amdgcn_s_barrier(); asm volatile("" ::: "memory");
        const int tid = wid * 64 + lane;
        if (wid < 4) {
            const float s = (P[tid * 4 + 0] + P[tid * 4 + 1]) + (P[tid * 4 + 2] + P[tid * 4 + 3]);
            __hip_atomic_store(slots + ((size_t)(u.pm * BM + tid) * 8 + u.pn), s, __ATOMIC_RELAXED, __HIP_MEMORY_SCOPE_AGENT);
            asm volatile("s_waitcnt vmcnt(0)" ::: "memory");
            if (lane == 0) __hip_atomic_fetch_add(cnt + 64 * u.pm, 1u, __ATOMIC_RELAXED, __HIP_MEMORY_SCOPE_AGENT);
        }
        if (wid == 0) {
            unsigned sp = 0;
            while ((unsigned)__builtin_amdgcn_readfirstlane(__hip_atomic_load(cnt + 64 * u.pm, __ATOMIC_RELAXED, __HIP_MEMORY_SCOPE_AGENT)) < 32u) { __builtin_amdgcn_s_sleep(2); if (++sp > (1u << 22)) break; }
            __builtin_amdgcn_fence(__ATOMIC_ACQUIRE, "agent");
        }
        asm volatile("s_waitcnt vmcnt(0) lgkmcnt(0)" ::: "memory"); __builtin_amdgcn_s_barrier(); asm volatile("" ::: "memory");
        if (wid < 4) {
            const float* sl = slots + (size_t)(u.pm * BM + tid) * 8; float t = 0.f;
#pragma unroll
            for (int k = 0; k < 8; ++k) t += __hip_atomic_load(sl + k, __ATOMIC_RELAXED, __HIP_MEMORY_SCOPE_AGENT);
            S[tid] = __builtin_amdgcn_rsqf(t * (1.0f / 2048.0f) + 1e-5f);
        }
        asm volatile("s_waitcnt lgkmcnt(0)" ::: "memory"); __builtin_amdgcn_s_barrier(); asm volatile("" ::: "memory");
#pragma unroll
        for (int ai = 0; ai < 2; ++ai)
#pragma unroll
            for (int m = 0; m < 4; ++m) { const int lrow = ai * HALF + wr * 64 + m * 16 + fr; const float r = S[lrow]; const size_t off = (size_t)(u.pm * BM + lrow) * ldc + col0;
#pragma unroll
                for (int bj = 0; bj < 2; ++bj)
#pragma unroll
                    for (int n = 0; n < 2; ++n) *(f32x4*)(out + off + bj * HALF + n * 4) = acc[ai][bj][m][n] * r * *(const f32x4*)(fgain + col0 + bj * HALF + n * 4); }
    }
};
template <class Epi, class Sched, bool ALIGN_EPI = false, bool SP2 = false>
__device__ __forceinline__ void gemm_phase(PG8_LAS unsigned char* lds, const Gemm g, const Sched& S, const Epi& E) {
    const int tid = threadIdx.x, wid = __builtin_amdgcn_readfirstlane(tid >> 6), lane = tid & 63, wr = wid >> 2, wc = wid & 3, fr = lane & 15, fq = lane >> 4;
    const int K = g.K, nt = K / BK;
    unsigned voffA[2], voffB[2];
#pragma unroll
    for (int i = 0; i < 2; ++i) { int R, C; stage_rc(tid * 16 + i * 8192, R, C); const int Rb = Epi::PERM ? ((R & ~31) + perm32(R & 31)) : R;
        voffA[i] = (unsigned)(R * K + C) * 2u; voffB[i] = (unsigned)(Rb * K + C) * 2u; }
    const size_t kstep = (size_t)(BK * 2);
    const size_t hstep = (size_t)HALF * K * 2;
    const size_t tstep = 2 * hstep;
    const unsigned ldsw = (unsigned)wid * 1024u;
    const int aoff = lds_byte(wr * 64 + fr, fq * 8), boff = lds_byte(wc * 32 + fr, fq * 8);
#define PG8_SA(b, h) (((b) * 2 + (h)) * HTB)
#define PG8_SB(b, h) ((4 + (b) * 2 + (h)) * HTB)
#define PG8_STAGE(bufoff, gbase, voff) do { _Pragma("unroll") for (int _i = 0; _i < 2; ++_i) \
        __builtin_amdgcn_global_load_lds((const unsigned*)((const char*)(gbase) + (voff)[_i]), (PG8_LAS unsigned*)(lds + (bufoff) + ldsw + _i * 8192), 16, 0, 0); } while (0)
#define PG8_LDA(dst, b, h) do { _Pragma("unroll") for (int m = 0; m < 4; ++m) _Pragma("unroll") for (int k = 0; k < 2; ++k) dst[m][k] = *(const PG8_LAS bf16x8*)(lds + PG8_SA(b, h) + aoff + m * 2048 + k * 1024); } while (0)
#define PG8_LDB(dst, b, h) do { _Pragma("unroll") for (int n = 0; n < 2; ++n) _Pragma("unroll") for (int k = 0; k < 2; ++k) dst[n][k] = *(const PG8_LAS bf16x8*)(lds + PG8_SB(b, h) + boff + n * 2048 + k * 1024); } while (0)
#define PG8_MMA(ai, bj, At, Bt) do { __builtin_amdgcn_s_setprio(1); _Pragma("unroll") for (int m = 0; m < 4; ++m) _Pragma("unroll") for (int n = 0; n < 2; ++n) _Pragma("unroll") for (int k = 0; k < 2; ++k) \
        acc[ai][bj][m][n] = __builtin_amdgcn_mfma_f32_16x16x32_bf16(Bt[n][k], At[m][k], acc[ai][bj][m][n], 0, 0, 0); __builtin_amdgcn_s_setprio(0); } while (0)
#define PG8_WAIT_V(n) asm volatile("s_waitcnt vmcnt(" #n ")" ::: "memory")
#define PG8_WAIT_L(n) asm volatile("s_waitcnt lgkmcnt(" #n ")" ::: "memory")
#define PG8_BAR __builtin_amdgcn_s_barrier()
#define PG8_SCHED __builtin_amdgcn_sched_barrier(0)
    Unit cur, nxt; int ui = 0;
    if (!S.next(0, cur)) return;
    f32x4 acc[2][2][4][2];
#pragma unroll
    for (int a = 0; a < 2; ++a)
#pragma unroll
        for (int b = 0; b < 2; ++b)
#pragma unroll
            for (int m = 0; m < 4; ++m)
#pragma unroll
                for (int n = 0; n < 2; ++n) acc[a][b][m][n] = (f32x4){0.f, 0.f, 0.f, 0.f};
    bf16x8 At[4][2], B0[2][2], B1[2][2];
    const char* cA = (const char*)g.A + (size_t)cur.pm * tstep; const char* cB = (const char*)g.Bt + (size_t)cur.pn * tstep;
    S.a_ready(cur);
    if constexpr (SP2) {
        PG8_STAGE(PG8_SB(0, 0), cB, voffB); PG8_STAGE(PG8_SB(0, 1), cB + hstep, voffB); PG8_STAGE(PG8_SA(0, 0), cA, voffA); PG8_STAGE(PG8_SA(0, 1), cA + hstep, voffA);
        if (wr == 1) PG8_BAR;
        PG8_WAIT_V(2); PG8_BAR;
        PG8_STAGE(PG8_SB(1, 0), cB + kstep, voffB); PG8_STAGE(PG8_SA(1, 0), cA + kstep, voffA); PG8_STAGE(PG8_SB(1, 1), cB + hstep + kstep, voffB);
        PG8_WAIT_V(6); PG8_BAR;
    } else {
        PG8_STAGE(PG8_SB(0, 0), cB, voffB); PG8_STAGE(PG8_SA(0, 0), cA, voffA); PG8_STAGE(PG8_SB(0, 1), cB + hstep, voffB); PG8_STAGE(PG8_SA(0, 1), cA + hstep, voffA);
        if (wr == 1) PG8_BAR;
        PG8_WAIT_V(4); PG8_BAR;
        PG8_STAGE(PG8_SB(1, 0), cB + kstep, voffB); PG8_STAGE(PG8_SA(1, 0), cA + kstep, voffA); PG8_STAGE(PG8_SB(1, 1), cB + hstep + kstep, voffB);
        PG8_WAIT_V(6); PG8_BAR;
    }
    for (;;) {
        const bool has_next = S.next(ui + 1, nxt);
        const char* nA = has_next ? (const char*)g.A + (size_t)nxt.pm * tstep : cA; const char* nB = has_next ? (const char*)g.Bt + (size_t)nxt.pn * tstep : cB;
        for (int t = 0; t < nt; t += 2) {
            const bool last = (t == nt - 2);
            const char* a1 = cA + (size_t)(t + 1) * kstep;
            const char* a2 = last ? nA : cA + (size_t)(t + 2) * kstep; const char* b2 = last ? nB : cB + (size_t)(t + 2) * kstep;
            const char* a3 = a2 + kstep; const char* b3 = b2 + kstep;
            if (last && has_next) S.a_ready(nxt);
            if constexpr (SP2) {
            PG8_LDB(B0, 0, 0); PG8_LDB(B1, 0, 1); PG8_SCHED; PG8_LDA(At, 0, 0); PG8_STAGE(PG8_SA(1, 1), a1 + hstep, voffA);
            PG8_WAIT_V(8); PG8_WAIT_L(0); PG8_BAR; PG8_MMA(0, 0, At, B0); PG8_MMA(0, 1, At, B1); PG8_BAR; PG8_SCHED;
            PG8_LDA(At, 0, 1); PG8_STAGE(PG8_SB(0, 0), b2, voffB); PG8_STAGE(PG8_SB(0, 1), b2 + hstep, voffB); PG8_STAGE(PG8_SA(0, 0), a2, voffA);
            PG8_WAIT_V(8); PG8_WAIT_L(0); PG8_BAR; PG8_MMA(1, 0, At, B0); PG8_MMA(1, 1, At, B1); PG8_BAR; PG8_SCHED;
            PG8_LDB(B0, 1, 0); PG8_LDB(B1, 1, 1); PG8_SCHED; PG8_LDA(At, 1, 0); PG8_STAGE(PG8_SA(0, 1), a2 + hstep, voffA);
            PG8_WAIT_V(8); PG8_WAIT_L(0); PG8_BAR; PG8_MMA(0, 0, At, B0); PG8_MMA(0, 1, At, B1); PG8_BAR; PG8_SCHED;
            PG8_LDA(At, 1, 1); PG8_STAGE(PG8_SB(1, 0), b3, voffB); PG8_STAGE(PG8_SB(1, 1), b3 + hstep, voffB); PG8_STAGE(PG8_SA(1, 0), a3, voffA);
            PG8_WAIT_V(8); PG8_WAIT_L(0); PG8_BAR; PG8_MMA(1, 0, At, B0); PG8_MMA(1, 1, At, B1); PG8_BAR; PG8_SCHED;
            } else {
            PG8_LDB(B0, 0, 0); PG8_SCHED; PG8_LDA(At, 0, 0); PG8_STAGE(PG8_SA(1, 1), a1 + hstep, voffA);
            PG8_WAIT_L(8); PG8_BAR; PG8_WAIT_L(0); PG8_MMA(0, 0, At, B0); PG8_BAR; PG8_SCHED;
            PG8_LDB(B1, 0, 1); PG8_STAGE(PG8_SB(0, 0), b2, voffB);
            PG8_BAR; PG8_WAIT_L(0); PG8_MMA(0, 1, At, B1); PG8_BAR;
            PG8_LDA(At, 0, 1); PG8_STAGE(PG8_SA(0, 0), a2, voffA);
            PG8_BAR; PG8_WAIT_L(0); PG8_MMA(1, 0, At, B0); PG8_BAR; PG8_SCHED;
            PG8_STAGE(PG8_SB(0, 1), b2 + hstep, voffB);
            PG8_WAIT_V(6); PG8_BAR; PG8_MMA(1, 1, At, B1); PG8_BAR;
            PG8_LDB(B0, 1, 0); PG8_SCHED; PG8_LDA(At, 1, 0); PG8_STAGE(PG8_SA(0, 1), a2 + hstep, voffA);
            PG8_WAIT_L(8); PG8_BAR; PG8_WAIT_L(0); PG8_MMA(0, 0, At, B0); PG8_BAR; PG8_SCHED;
            PG8_LDB(B1, 1, 1); PG8_STAGE(PG8_SB(1, 0), b3, voffB);
            PG8_BAR; PG8_WAIT_L(0); PG8_MMA(0, 1, At, B1); PG8_BAR;
            PG8_LDA(At, 1, 1); PG8_STAGE(PG8_SA(1, 0), a3, voffA);
            PG8_BAR; PG8_WAIT_L(0); PG8_MMA(1, 0, At, B0); PG8_BAR; PG8_SCHED;
            PG8_STAGE(PG8_SB(1, 1), b3 + hstep, voffB);
            PG8_WAIT_V(6); PG8_BAR; PG8_MMA(1, 1, At, B1); PG8_BAR;
            }
        }
        if constexpr (ALIGN_EPI) { if (wr == 0) PG8_BAR; }
        if constexpr (!Epi::AFTER_DRAIN) { if constexpr (Epi::XCHG) E.xchg(acc, cur, wr, wc, fr, fq, lds + STAGE_BYTES, wid, lane); else E(acc, cur, wr, wc, fr, fq); S.done(cur); }
        if (!has_next) break;
#pragma unroll
        for (int a = 0; a < 2; ++a)
#pragma unroll
            for (int b = 0; b < 2; ++b)
#pragma unroll
                for (int m = 0; m < 4; ++m)
#pragma unroll
                    for (int n = 0; n < 2; ++n) acc[a][b][m][n] = (f32x4){0.f, 0.f, 0.f, 0.f};
        cur = nxt; cA = nA; cB = nB; ++ui;
        if constexpr (ALIGN_EPI) { if (wr == 1) PG8_BAR; }
    }
    PG8_WAIT_V(0);
    if constexpr (!ALIGN_EPI) { if (wr == 0) PG8_BAR; }
    PG8_BAR;
    if constexpr (Epi::AFTER_DRAIN) { E.fused(acc, cur, wr, wc, fr, fq, lds, wid, lane); S.done(cur); }
#undef PG8_SA
#undef PG8_SB
#undef PG8_STAGE
#undef PG8_LDA
#undef PG8_LDB
#undef PG8_MMA
#undef PG8_WAIT_V
#undef PG8_WAIT_L
#undef PG8_BAR
#undef PG8_SCHED
}
}
#define LAS __attribute__((address_space(3)))
typedef unsigned short bf16_t;
typedef short bf16x8 __attribute__((ext_vector_type(8)));
typedef float f32x4 __attribute__((ext_vector_type(4)));
typedef float f32x2 __attribute__((ext_vector_type(2)));
typedef float f32x16 __attribute__((ext_vector_type(16)));
typedef unsigned u32x4 __attribute__((ext_vector_type(4)));
typedef unsigned u32x2 __attribute__((ext_vector_type(2)));
constexpr int NB = 2, SEQ = 16384, MTOK = NB * SEQ, DM = 2048, NP = 4608, INW = 4480, AW = 1536, SW = 512;
constexpr int COL_Q = 0, COL_K = 1536, COL_V = 1728, COL_ZA = 2048, COL_U = 3584, COL_ZS = 4096;
constexpr int NCH = SEQ / 64;
constexpr float EPSN = 1e-5f, LOG2E = 1.4426950408889634f, QSCALE = 0.125f * LOG2E;
constexpr int KPARTS = 16;
constexpr size_t MiB = 1u << 20;
constexpr size_t WS_WIN = 0, WS_WOUT = 18 * MiB, WS_GLU = 26 * MiB, WS_MODP = 27 * MiB, WS_GATE = 28 * MiB, WS_BIASP = 28 * MiB + 65536,
                 WS_ABAR = 28 * MiB + 131072, WS_A64 = WS_ABAR + 16384, WS_BCAT = 28 * MiB + 196608, WS_CCAT = WS_BCAT + 131072,
                 WS_SSQA = 29 * MiB, WS_SSQO = 30 * MiB, WS_SC = 34 * MiB, WS_HC = 42 * MiB, WS_HB = 64 * MiB, WS_PROJ = 192 * MiB, WS_END = 480 * MiB;
constexpr int LDS_BYTES = 147456;
#ifndef MK_FUSE_FINAL
#define MK_FUSE_FINAL 1
#endif
constexpr int NPHASE = MK_FUSE_FINAL ? 7 : 8;
#ifndef MK_ONE_LAUNCH
#define MK_ONE_LAUNCH 1
#endif

typedef __bf16 bf16x2_t __attribute__((ext_vector_type(2)));
__device__ __forceinline__ unsigned pkbf(float lo, float hi) { const f32x2 v = {lo, hi}; const bf16x2_t b = __builtin_convertvector(v, bf16x2_t); return __builtin_bit_cast(unsigned, b); }
__device__ __forceinline__ float bflo(unsigned v) { return __uint_as_float(v << 16); }
__device__ __forceinline__ float bfhi(unsigned v) { return __uint_as_float(v & 0xffff0000u); }
__device__ __forceinline__ float wave_sum(float v) {
#pragma unroll
    for (int o = 1; o < 64; o <<= 1) v += __shfl_xor(v, o);
    return v;
}
#define LDS_WAIT() asm volatile("s_waitcnt lgkmcnt(0)" ::: "memory")

constexpr size_t WS_BAR = 51 * MiB, WS_PCNT = WS_BAR + 16384, WS_XSLOT = 52 * MiB; constexpr int LDS_ST_OFF = LDS_BYTES - 64;
#define XB_TMO      128
#define XB_XCNT(j)  (256  + 64 * (j))
#define XB_XSUB(j)  (1280 + 64 * (j))
#define XB_XGEN(j)  (2304 + 64 * (j))
#define XB_TOP      3328
#define XB_TOPGEN   3392
#define XCD_BAR_WORDS 3456
#define XB_SPIN_CAP (1u << 18)

__device__ __forceinline__ unsigned xb_ld(unsigned* p)              { return __hip_atomic_load(p, __ATOMIC_RELAXED, __HIP_MEMORY_SCOPE_AGENT); }
__device__ __forceinline__ unsigned xb_add(unsigned* p, unsigned v) { return __hip_atomic_fetch_add(p, v, __ATOMIC_RELAXED, __HIP_MEMORY_SCOPE_AGENT); }
__device__ __forceinline__ unsigned xb_xcc_id() { return (unsigned)__builtin_amdgcn_s_getreg((3 << 11) | 20) & 0xFu; }
#define XB_SPIN(cond, bar) do { unsigned _sp = 0; while (cond) { __builtin_amdgcn_s_sleep(1); \
    if ((++_sp & 255u) == 0u) { if (xb_ld(&(bar)[XB_TMO])) break; if (_sp > XB_SPIN_CAP) { atomicAdd(&(bar)[XB_TMO], 1u); break; } } } } while (0)

struct XcdBarrier {
    unsigned* bar; unsigned x;
    volatile LAS unsigned* st;
};

__device__ __forceinline__ XcdBarrier xcd_barrier_post(unsigned* bar, volatile LAS unsigned* st) {
    XcdBarrier b; b.bar = bar; b.x = xb_xcc_id(); b.st = st;
    if (threadIdx.x == 0) (void)xb_add(&bar[XB_XCNT(b.x)], 1u);
    return b;
}
__device__ __forceinline__ void xcd_barrier_complete(unsigned* bar, unsigned x, unsigned& nloc, unsigned& nx) {
    const unsigned G = gridDim.x * gridDim.y * gridDim.z;
    unsigned sum, cnt, mine, sp = 0u;
    for (;;) {
        sum = 0u; cnt = 0u; mine = 0u;
#pragma unroll
        for (unsigned j = 0; j < 16; ++j) { const unsigned c = xb_ld(&bar[XB_XCNT(j)]); sum += c; cnt += (c > 0u) ? 1u : 0u; mine = (j == x) ? c : mine; }
        if (sum == G) break;
        __builtin_amdgcn_s_sleep(1);
        if ((++sp & 255u) == 0u) { if (xb_ld(&bar[XB_TMO])) break; if (sp > XB_SPIN_CAP) { atomicAdd(&bar[XB_TMO], 1u); break; } }
    }
    nloc = mine > 0u ? mine : 1u; nx = cnt > 0u ? cnt : 1u;
}

__device__ __forceinline__ void xcd_barrier(const XcdBarrier& b) {
    asm volatile("s_waitcnt vmcnt(0)" ::: "memory");
    __syncthreads();
    if (threadIdx.x == 0) {
        unsigned* bar = b.bar;
        __builtin_amdgcn_s_waitcnt(0);
        unsigned nloc = b.st[0], nx = b.st[1];
        if (nloc == 0u) { xcd_barrier_complete(bar, b.x, nloc, nx); b.st[0] = nloc; b.st[1] = nx; }
        const unsigned old = xb_add(&bar[XB_XSUB(b.x)], 1u);
        const unsigned gen = old / nloc;
        if (old + 1u == (gen + 1u) * nloc) {
            __builtin_amdgcn_fence(__ATOMIC_RELEASE, "agent");
            asm volatile("s_waitcnt vmcnt(0)" ::: "memory");
            const unsigned og = xb_add(&bar[XB_TOP], 1u);
            const unsigned tg = og / nx;
            if (og + 1u == (tg + 1u) * nx) xb_add(&bar[XB_TOPGEN], 1u);
            else XB_SPIN(xb_ld(&bar[XB_TOPGEN]) == tg, bar);
            __builtin_amdgcn_fence(__ATOMIC_ACQUIRE, "agent");
            xb_add(&bar[XB_XGEN(b.x)], 1u);
            asm volatile("s_waitcnt vmcnt(0)" ::: "memory");
        } else {
            XB_SPIN(xb_ld(&bar[XB_XGEN(b.x)]) == gen, bar);
            __builtin_amdgcn_fence(__ATOMIC_ACQUIRE, "agent");
            asm volatile("s_waitcnt vmcnt(0)" ::: "memory");
        }
    }
    __syncthreads();
}


struct Args { const float* in[22]; float* out; unsigned char* ws; int ph_lo, ph_hi; };

__device__ __forceinline__ void transpose_item(const float* W, int ldw, int src_n0, int k0, bf16_t* WT, int K, int dst_n0, LAS float* scr, int lane) {
    if (src_n0 >= 0) {
#pragma unroll
        for (int i = 0; i < 32; ++i) { const int kk = 2 * i + (lane >> 5); scr[kk * 33 + (lane & 31)] = __builtin_nontemporal_load(W + (size_t)(k0 + kk) * ldw + src_n0 + (lane & 31)); }
    }
    LDS_WAIT();
    const int c = lane & 7;
#pragma unroll
    for (int j = 0; j < 4; ++j) { const int n = (lane >> 3) + 8 * j; const LAS float* s = scr + (8 * c) * 33 + n;
        u32x4 o = (u32x4){0u, 0u, 0u, 0u};
        if (src_n0 >= 0) { o.x = pkbf(s[0 * 33], s[1 * 33]); o.y = pkbf(s[2 * 33], s[3 * 33]); o.z = pkbf(s[4 * 33], s[5 * 33]); o.w = pkbf(s[6 * 33], s[7 * 33]); }
        *(u32x4*)(WT + (size_t)(dst_n0 + n) * K + k0 + 8 * c) = o; }
    LDS_WAIT();
}

__device__ __forceinline__ void phase0(const Args& a, LAS unsigned char* lds, int G, int blk, int tid, int wid, int lane) {
    unsigned char* ws = a.ws;
    LAS float* scr = (LAS float*)(lds + wid * 8448);
    LAS float* sil = (LAS float*)(lds + 69632);
    const int gw = blk * 8 + wid, NGW = G * 8;
    for (int k = tid; k < 2 * DM; k += 512) { const float cv = a.in[1][k]; sil[k] = cv / (1.0f + __expf(-cv)); }
    __syncthreads();
    {
        const float* wa = a.in[2]; const float* ba = a.in[3]; float* modp = (float*)(ws + WS_MODP);
        constexpr int NJ = 3 * DM / 64, KL = DM / KPARTS;
        for (int it = gw; it < NJ * KPARTS; it += NGW) {
            const int jg = it % NJ, kp = it / NJ, j = 64 * jg + lane; float a0 = 0.f, a1 = 0.f;
            const float* wp = wa + (size_t)(kp * KL) * (3 * DM) + j;
#pragma unroll 32
            for (int k = 0; k < KL; ++k) { const float w = __builtin_nontemporal_load(wp + (size_t)k * (3 * DM)); a0 += sil[kp * KL + k] * w; a1 += sil[DM + kp * KL + k] * w; }
            if (kp == 0) { const float bb = ba[j]; a0 += bb; a1 += bb; }
            modp[(size_t)(kp * 2 + 0) * (3 * DM) + j] = a0; modp[(size_t)(kp * 2 + 1) * (3 * DM) + j] = a1;
        }
    }
    { float* bp = (float*)(ws + WS_BIASP); const float* bi = a.in[6];
      for (int n = blk * 512 + tid; n < NP; n += G * 512) bp[n] = n < 1920 ? bi[n] : (n < 2048 ? 0.f : bi[n - 128]); }
    {
        const float *lre = a.in[9], *lim = a.in[10], *lst = a.in[11], *bre = a.in[12], *bim = a.in[13], *cre = a.in[14], *cim = a.in[15];
        float* abar = (float*)(ws + WS_ABAR); float* a64 = (float*)(ws + WS_A64); bf16_t* Bcat = (bf16_t*)(ws + WS_BCAT); bf16_t* Ccat = (bf16_t*)(ws + WS_CCAT);
        for (int e = (G - 1 - blk) * 512 + tid; e < 32 * 64 * 16; e += G * 512) {
            const int gp = e >> 4, cch = e & 15, g = gp >> 6, p = gp & 63;
            const float step = expf(lst[g]), lr = lre[gp], li = lim[gp];
            const float decay = expf(lr * step); const float ar = decay * cosf(li * step), ai = decay * sinf(li * step);
            const float den = lr * lr + li * li, nr = ar - 1.0f, ni = ai;
            const float cr_ = (nr * lr + ni * li) / den, ci_ = (ni * lr - nr * li) / den;
            if (cch == 0) { abar[2 * gp] = ar; abar[2 * gp + 1] = ai; float pr = ar, pi = ai;
#pragma unroll
                for (int s = 0; s < 6; ++s) { const float tr = pr * pr - pi * pi, ti = 2.0f * pr * pi; pr = tr; pi = ti; }
                a64[2 * gp] = pr; a64[2 * gp + 1] = pi; }
            const float br = bre[e], bi = bim[e];
            const float xr = cr_ * br - ci_ * bi, xi = cr_ * bi + ci_ * br;
            Bcat[((size_t)g * 128 + 2 * p) * 16 + cch] = (bf16_t)(pkbf(xr, 0.f) & 0xffffu);
            Bcat[((size_t)g * 128 + 2 * p + 1) * 16 + cch] = (bf16_t)(pkbf(xi, 0.f) & 0xffffu);
            const float c_r = cre[((size_t)g * 16 + cch) * 64 + p], c_i = cim[((size_t)g * 16 + cch) * 64 + p];
            *(unsigned*)(Ccat + ((size_t)g * 16 + cch) * 128 + 2 * p) = pkbf(c_r, -c_i);
        }
    }
}

__device__ __forceinline__ void phase1(const Args& a, LAS unsigned char* lds, int G, int blk, int tid, int wid, int lane) {
    unsigned char* ws = a.ws;
    const int rpb = MTOK / G, row_lo = blk * rpb, batch = row_lo / SEQ;
    LAS float* gs = (LAS float*)lds; LAS float* sh = gs + DM;
    const float* modp = (const float*)(ws + WS_MODP); const float* ng = a.in[4];
    for (int j = tid; j < DM; j += 512) { float s0 = 0.f, s1 = 0.f, s2 = 0.f;
#pragma unroll
        for (int kp = 0; kp < KPARTS; ++kp) { const float* mp = modp + (size_t)(kp * 2 + batch) * (3 * DM); s0 += mp[j]; s1 += mp[DM + j]; s2 += mp[2 * DM + j]; }
        gs[j] = ng[j] * (1.0f + s1); sh[j] = s0;
        if (row_lo % SEQ == 0) ((float*)(ws + WS_GATE))[batch * DM + j] = s2; }
    __syncthreads();
    if (wid >= 4) {
        LAS float* scr = (LAS float*)(lds + 16384 + (wid - 4) * 8448);
        const int gw = blk * 4 + (wid - 4), NGW = G * 4;
    constexpr int I_IN = (DM / 64) * (NP / 32), I_OUT = (DM / 64) * (DM / 32), I_GLU = (SW / 64) * (SW / 32);
    for (int it = gw; it < I_IN + I_OUT + I_GLU; it += NGW) {
        int r = it;
        if (r < I_IN) { const int nblk = NP / 32, kb = r / nblk, nb = r % nblk, n0 = 32 * nb; const int src = n0 < 1920 ? n0 : (n0 < 2048 ? -1 : n0 - 128);
            transpose_item(a.in[5], INW, src, 64 * kb, (bf16_t*)(ws + WS_WIN), DM, n0, scr, lane); continue; }
        r -= I_IN;
        if (r < I_OUT) { const int nblk = DM / 32, kb = r / nblk, nb = r % nblk; transpose_item(a.in[20], DM, 32 * nb, 64 * kb, (bf16_t*)(ws + WS_WOUT), DM, 32 * nb, scr, lane); continue; }
        r -= I_OUT;
        { const int nblk = SW / 32, kb = r / nblk, nb = r % nblk; transpose_item(a.in[17], SW, 32 * nb, 64 * kb, (bf16_t*)(ws + WS_GLU), SW, 32 * nb, scr, lane); }
    }
        return;
    }
    const float* x = a.in[0]; bf16_t* hb = (bf16_t*)(ws + WS_HB);
    for (int r = row_lo + 2 * wid; r < row_lo + rpb; r += 8) {
        const f32x4* xr = (const f32x4*)(x + (size_t)r * DM) + lane; f32x4 v[2][8]; float ss[2] = {0.f, 0.f};
#pragma unroll
        for (int q = 0; q < 2; ++q)
#pragma unroll
            for (int i = 0; i < 8; ++i) v[q][i] = __builtin_nontemporal_load(xr + q * (DM / 4) + 64 * i);
#pragma unroll
        for (int q = 0; q < 2; ++q)
#pragma unroll
            for (int i = 0; i < 8; ++i) ss[q] += (v[q][i][0] * v[q][i][0] + v[q][i][1] * v[q][i][1]) + (v[q][i][2] * v[q][i][2] + v[q][i][3] * v[q][i][3]);
#pragma unroll
        for (int q = 0; q < 2; ++q) {
            const float rstd = 1.0f / sqrtf(wave_sum(ss[q]) * (1.0f / DM) + EPSN);
            u32x2* o = (u32x2*)(hb + (size_t)(r + q) * DM) + lane;
#pragma unroll
            for (int i = 0; i < 8; ++i) { const f32x4 g4 = *(const LAS f32x4*)(gs + 4 * (lane + 64 * i)), s4 = *(const LAS f32x4*)(sh + 4 * (lane + 64 * i));
                const f32x4 h = v[q][i] * rstd * g4 + s4; u32x2 w; w.x = pkbf(h[0], h[1]); w.y = pkbf(h[2], h[3]); o[64 * i] = w; }
        }
    }
}

#define MFMA32(A, B, C) __builtin_amdgcn_mfma_f32_32x32x16_bf16(A, B, C, 0, 0, 0)
#define MFMA16(A, B, C) __builtin_amdgcn_mfma_f32_16x16x32_bf16(A, B, C, 0, 0, 0)
__device__ __forceinline__ void attn_unit(const Args& a, LAS unsigned char* lds, int b, int kvh, int qb, int tid, int wid, int lane) {
    const bf16_t* proj = (const bf16_t*)(a.ws + WS_PROJ); bf16_t* mixed = (bf16_t*)(a.ws + WS_HB); float* ssqa = (float*)(a.ws + WS_SSQA);
    const int r32 = lane & 31, hi = lane >> 5;
    LAS bf16_t* KS = (LAS bf16_t*)lds;
    LAS bf16_t* VT = (LAS bf16_t*)(lds + 36864);
    LAS bf16_t* OST = (LAS bf16_t*)(lds + 70656 + wid * 4608);
    LAS float* SSQ = (LAS float*)(lds + 107520);
    const long tok0 = (long)b * SEQ + qb * 128;
#pragma unroll
    for (int i = 0; i < 4; ++i) { const int id = tid + 512 * i, row = id >> 3, ch = id & 7;
        u32x4 v = (u32x4){0u, 0u, 0u, 0u};
        if (qb > 0 || row >= 128) v = *(const u32x4*)(proj + (size_t)(tok0 - 128 + row) * NP + COL_K + kvh * 64 + ch * 8);
        *(LAS u32x4*)(KS + row * 72 + ch * 8) = v; }
#pragma unroll
    for (int i = 0; i < 4; ++i) { const int id = tid + 512 * i, row = id & 255, ch = id >> 8;
        u32x4 v = (u32x4){0u, 0u, 0u, 0u};
        if (qb > 0 || row >= 128) v = *(const u32x4*)(proj + (size_t)(tok0 - 128 + row) * NP + COL_V + kvh * 64 + ch * 8);
#pragma unroll
        for (int e = 0; e < 8; ++e) VT[(ch * 8 + e) * 264 + row] = (bf16_t)((v[e >> 1] >> (16 * (e & 1))) & 0xffffu); }
    const int head = kvh * 8 + wid;
    bf16x8 qn[4];
#pragma unroll
    for (int ds = 0; ds < 4; ++ds) qn[ds] = __builtin_nontemporal_load((const bf16x8*)(proj + (size_t)(tok0 + r32) * NP + COL_Q + head * 64 + 16 * ds + 8 * hi));
    __syncthreads();
    const float sink2 = a.in[7][head] * LOG2E;
    const int oc = (lane & 7) * 8;
    const f32x4 g0 = *(const f32x4*)(a.in[8] + head * 64 + oc), g1 = *(const f32x4*)(a.in[8] + head * 64 + oc + 4);
    const float NEG = -1.0e30f;
    for (int s = 0; s < 4; ++s) {
        bf16x8 qf[4];
#pragma unroll
        for (int ds = 0; ds < 4; ++ds) qf[ds] = qn[ds];
        if (s < 3) { const size_t qtok = (size_t)(tok0 + 32 * (s + 1) + r32);
#pragma unroll
            for (int ds = 0; ds < 4; ++ds) qn[ds] = __builtin_nontemporal_load((const bf16x8*)(proj + qtok * NP + COL_Q + head * 64 + 16 * ds + 8 * hi)); }
        u32x4 zp[4];
#pragma unroll
        for (int i = 0; i < 4; ++i) zp[i] = __builtin_nontemporal_load((const u32x4*)(proj + (size_t)(tok0 + 32 * s + 8 * i + (lane >> 3)) * NP + COL_ZA + head * 64 + oc));
        f32x16 S[5];
#pragma unroll
        for (int j = 0; j < 5; ++j) { const int kb0 = 32 * (s + j); f32x16 acc = {};
#pragma unroll
            for (int ds = 0; ds < 4; ++ds) { const bf16x8 kf = *(const LAS bf16x8*)(KS + (kb0 + r32) * 72 + 16 * ds + 8 * hi); acc = MFMA32(kf, qf[ds], acc); }
            S[j] = acc; }
#pragma unroll
        for (int r = 0; r < 16; ++r) { const int kk = (r & 3) + 8 * (r >> 2) + 4 * hi; if (kk <= r32) S[0][r] = NEG; if (kk > r32) S[4][r] = NEG; }
        if (qb == 0) {
#pragma unroll
            for (int j = 0; j < 4; ++j) if (s + j < 4) {
#pragma unroll
                for (int r = 0; r < 16; ++r) S[j][r] = NEG; } }
        float m = NEG;
#pragma unroll
        for (int j = 0; j < 5; ++j)
#pragma unroll
            for (int r = 0; r < 16; ++r) m = fmaxf(m, S[j][r]);
        m = fmaxf(m, __shfl_xor(m, 32));
        float l = 0.f;
#pragma unroll
        for (int j = 0; j < 5; ++j)
#pragma unroll
            for (int r = 0; r < 16; ++r) { const float p = __builtin_amdgcn_exp2f(S[j][r] - m); S[j][r] = p; l += p; }
        l += __shfl_xor(l, 32); l += __builtin_amdgcn_exp2f(sink2 - m);
        f32x16 O[2]; O[0] = (f32x16){}; O[1] = (f32x16){};
#pragma unroll
        for (int j = 0; j < 5; ++j)
#pragma unroll
            for (int s2 = 0; s2 < 2; ++s2) {
                u32x4 pw; pw.x = pkbf(S[j][8 * s2 + 0], S[j][8 * s2 + 1]); pw.y = pkbf(S[j][8 * s2 + 2], S[j][8 * s2 + 3]); pw.z = pkbf(S[j][8 * s2 + 4], S[j][8 * s2 + 5]); pw.w = pkbf(S[j][8 * s2 + 6], S[j][8 * s2 + 7]);
                const bf16x8 pf = __builtin_bit_cast(bf16x8, pw);
                const int kv0 = 32 * (s + j) + 16 * s2 + 4 * hi;
#pragma unroll
                for (int dt = 0; dt < 2; ++dt) { const int d = 32 * dt + r32;
                    const u32x2 lo = *(const LAS u32x2*)(VT + d * 264 + kv0), hh = *(const LAS u32x2*)(VT + d * 264 + kv0 + 8);
                    const u32x4 vw = (u32x4){lo.x, lo.y, hh.x, hh.y};
                    O[dt] = MFMA32(__builtin_bit_cast(bf16x8, vw), pf, O[dt]); }
            }
        const float inv = 1.0f / l; float ss = 0.f;
#pragma unroll
        for (int dt = 0; dt < 2; ++dt)
#pragma unroll
            for (int r = 0; r < 16; ++r) { const float o = O[dt][r] * inv; O[dt][r] = o; ss += o * o; }
        ss += __shfl_xor(ss, 32);
        if (hi == 0) SSQ[wid * 128 + 32 * s + r32] = ss;
#pragma unroll
        for (int dt = 0; dt < 2; ++dt)
#pragma unroll
            for (int rg = 0; rg < 4; ++rg) { u32x2 w; w.x = pkbf(O[dt][4 * rg], O[dt][4 * rg + 1]); w.y = pkbf(O[dt][4 * rg + 2], O[dt][4 * rg + 3]);
                *(LAS u32x2*)(OST + r32 * 72 + 32 * dt + 8 * rg + 4 * hi) = w; }
        LDS_WAIT();
#pragma unroll
        for (int i = 0; i < 4; ++i) { const int row = 8 * i + (lane >> 3); const size_t tok = (size_t)(tok0 + 32 * s + row);
            const u32x4 o8 = *(const LAS u32x4*)(OST + row * 72 + oc);
            const u32x4 z8 = zp[i];
            u32x4 w;
            w.x = pkbf(bflo(o8.x) * g0[0] * bflo(z8.x), bfhi(o8.x) * g0[1] * bfhi(z8.x));
            w.y = pkbf(bflo(o8.y) * g0[2] * bflo(z8.y), bfhi(o8.y) * g0[3] * bfhi(z8.y));
            w.z = pkbf(bflo(o8.z) * g1[0] * bflo(z8.z), bfhi(o8.z) * g1[1] * bfhi(z8.z));
            w.w = pkbf(bflo(o8.w) * g1[2] * bflo(z8.w), bfhi(o8.w) * g1[3] * bfhi(z8.w));
#ifdef DBG_NO_ATTN
            w = (u32x4){0u, 0u, 0u, 0u};
#endif
            *(u32x4*)(mixed + tok * DM + head * 64 + oc) = w; }
        LDS_WAIT();
    }
    __syncthreads();
    if (tid < 128) { float t = 0.f;
#pragma unroll
        for (int w = 0; w < 8; ++w) t += SSQ[w * 128 + tid];
        ssqa[(size_t)kvh * MTOK + tok0 + tid] = t; }
    __syncthreads();
}

__device__ __forceinline__ f32x2 gelu_pk(f32x2 v) {
    const f32x2 av = __builtin_elementwise_abs(v), d = av * 0.2316418882f + 1.0f;
    f32x2 t; t.x = __builtin_amdgcn_rcpf(d.x); t.y = __builtin_amdgcn_rcpf(d.y);
    f32x2 q = t * 0.5307027145f + (-0.7265760135f); q = q * t + 0.7107068705f; q = q * t + (-0.142248368f); q = q * t + 0.127414796f; q = q * t;
    const f32x2 s = (v * v) * (-0.72134752044f);
    f32x2 e; e.x = __builtin_amdgcn_exp2f(s.x); e.y = __builtin_amdgcn_exp2f(s.y);
    const f32x2 mm = v * (q * e), r = v - mm;
    f32x2 o; o.x = v.x < 0.f ? mm.x : r.x; o.y = v.y < 0.f ? mm.y : r.y; return o;
}
template <bool FINAL>
__device__ __forceinline__ void ssm_unit(const Args& a, LAS unsigned char* lds, int b, int c64, int tid, int wid, int lane, int next_u = -1) {
    const bf16_t* proj = (const bf16_t*)(a.ws + WS_PROJ); bf16_t* mixed = (bf16_t*)(a.ws + WS_HB);
    const float* abar = (const float*)(a.ws + WS_ABAR); const bf16_t* Bcat = (const bf16_t*)(a.ws + WS_BCAT); const bf16_t* Ccat = (const bf16_t*)(a.ws + WS_CCAT);
    f32x2* Sc = (f32x2*)(a.ws + WS_SC); const f32x2* Hc = (const f32x2*)(a.ws + WS_HC);
    LAS bf16_t* BUF = (LAS bf16_t*)(lds + wid * 8704);
    LAS bf16_t* TILE = (LAS bf16_t*)(lds + 69632);
    LAS float* SSQ2 = (LAS float*)(lds + 136192);
    const size_t tok0 = (size_t)b * SEQ + 64 * c64;
    const int r32 = lane & 31, hi = lane >> 5, r16 = lane & 15, q4 = lane >> 4;
#if defined(PROBE_P5) && PROBE_P5 == 2
    for (int rp_ = 0; rp_ < (FINAL ? 2 : 1); ++rp_) {
    if (rp_) __syncthreads();
#else
    {
#endif
    if (!FINAL) {
#pragma unroll
    for (int i = 0; i < 8; ++i) { const int id = tid + 512 * i, row = id >> 6, ch = id & 63;
        *(LAS u32x4*)(TILE + row * 520 + ch * 8) = *(const u32x4*)(proj + (tok0 + row) * NP + COL_U + ch * 8); }
    }
    bf16x8 bcN[4], ccN[4]; f32x2 abN, h0N = {0.f, 0.f}; f32x4 d4N = {0.f, 0.f, 0.f, 0.f};
#define SSM_LOADC(G_) do { const int g_ = (G_); \
        _Pragma("unroll") for (int jt = 0; jt < 4; ++jt) bcN[jt] = *(const bf16x8*)(Bcat + ((size_t)(g_ * 128 + 32 * jt + r32) * 16 + 8 * hi)); \
        abN = *(const f32x2*)(abar + (size_t)(g_ * 64 + lane) * 2); \
        if (FINAL) { h0N = Hc[((size_t)(b * NCH + c64) * 32 + g_) * 64 + lane]; d4N = *(const f32x4*)(a.in[16] + g_ * 16 + 4 * q4); \
            _Pragma("unroll") for (int ks = 0; ks < 4; ++ks) ccN[ks] = *(const bf16x8*)(Ccat + ((size_t)(g_ * 16 + r16) * 128 + 32 * ks + 8 * q4)); } } while (0)
    SSM_LOADC(wid);
    __syncthreads();
    for (int gi = 0; gi < 4; ++gi) {
        const int g = wid + 8 * gi;
        bf16x8 bc[4], cc[4];
#pragma unroll
        for (int i = 0; i < 4; ++i) { bc[i] = bcN[i]; cc[i] = ccN[i]; }
        const float ar = abN[0], ai = abN[1]; float hr = h0N[0], hq = h0N[1]; const f32x4 d4 = d4N;
        const size_t sidx = ((size_t)(b * NCH + c64) * 32 + g) * 64 + lane;
        if (gi < 3) SSM_LOADC(g + 8);
        for (int hh = 0; hh < 2; ++hh) {
            const bf16x8 uf = *(const LAS bf16x8*)(TILE + (32 * hh + r32) * 520 + g * 16 + 8 * hi);
#pragma unroll
            for (int jt = 0; jt < 4; ++jt) { f32x16 d = {}; d = MFMA32(bc[jt], uf, d);
#pragma unroll
                for (int rg = 0; rg < 4; ++rg) { u32x2 w; w.x = pkbf(d[4 * rg], d[4 * rg + 1]); w.y = pkbf(d[4 * rg + 2], d[4 * rg + 3]);
                    *(LAS u32x2*)(BUF + r32 * 136 + 32 * jt + 8 * rg + 4 * hi) = w; } }
            LDS_WAIT();
#pragma unroll
            for (int t0 = 0; t0 < 32; t0 += 8) { unsigned v[8];
#pragma unroll
                for (int i = 0; i < 8; ++i) v[i] = *(const LAS unsigned*)(BUF + (t0 + i) * 136 + 2 * lane);
#pragma unroll
                for (int i = 0; i < 8; ++i) { const float bur = bflo(v[i]), bui = bfhi(v[i]);
                    const float nr = fmaf(ar, hr, fmaf(-ai, hq, bur)), ni = fmaf(ar, hq, fmaf(ai, hr, bui)); hr = nr; hq = ni;
                    if (FINAL) *(LAS unsigned*)(BUF + (t0 + i) * 136 + 2 * lane) = pkbf(hr, hq); } }
            if (FINAL) {
                LDS_WAIT();
#pragma unroll
                for (int tt = 0; tt < 2; ++tt) { f32x4 y = {};
#pragma unroll
                    for (int ks = 0; ks < 4; ++ks) { const bf16x8 hf = *(const LAS bf16x8*)(BUF + (16 * tt + r16) * 136 + 32 * ks + 8 * q4); y = MFMA16(cc[ks], hf, y); }
                    const int tl = 32 * hh + 16 * tt + r16;
                    const u32x2 u4 = *(const LAS u32x2*)(TILE + tl * 520 + g * 16 + 4 * q4);
                    const f32x2 ga = gelu_pk((f32x2){y[0] + d4[0] * bflo(u4.x), y[1] + d4[1] * bfhi(u4.x)}), gb = gelu_pk((f32x2){y[2] + d4[2] * bflo(u4.y), y[3] + d4[3] * bfhi(u4.y)});
                    u32x2 w; w.x = pkbf(ga.x, ga.y); w.y = pkbf(gb.x, gb.y);
                    *(LAS u32x2*)(TILE + tl * 520 + g * 16 + 4 * q4) = w; }
                LDS_WAIT();
            }
        }
        if (!FINAL) Sc[sidx] = (f32x2){hr, hq};
    }
    }
#undef SSM_LOADC
    if (!FINAL) __syncthreads();
    if (FINAL) {
        const bf16_t* glu = (const bf16_t*)(a.ws + WS_GLU);
        __syncthreads();
#if defined(PROBE_P5) && PROBE_P5 == 3
        for (int i = tid; i < 64 * 65; i += 512) ((LAS u32x4*)lds)[i] = ((const LAS u32x4*)(lds + 69632))[i];
        __syncthreads();
        _Pragma("nounroll") for (int rp3_ = 0; rp3_ < a.ph_hi - 5; ++rp3_) {
        if (rp3_) { for (int i = tid; i < 64 * 65; i += 512) ((LAS u32x4*)(lds + 69632))[i] = ((const LAS u32x4*)lds)[i]; __syncthreads(); }
#else
        {
#endif
        f32x16 acc[2][2];
#pragma unroll
        for (int i = 0; i < 2; ++i)
#pragma unroll
            for (int j = 0; j < 2; ++j) acc[i][j] = (f32x16){};
        const int nb = 64 * wid;
        bf16x8 gA0[4][2], gA1[4][2];
        const bf16_t* gl0 = glu + (size_t)(nb + r32) * SW + 8 * hi;
#define GLU_LOAD(BUFV, c) do { _Pragma("unroll") for (int k4 = 0; k4 < 4; ++k4) { BUFV[k4][0] = *(const bf16x8*)(gl0 + 16 * (4 * (c) + k4)); BUFV[k4][1] = *(const bf16x8*)(gl0 + 32 * SW + 16 * (4 * (c) + k4)); } } while (0)
#define GLU_MMA(BUFV, c) do { _Pragma("unroll") for (int k4 = 0; k4 < 4; ++k4) { const int ks = 4 * (c) + k4; bf16x8 bf[2]; \
            _Pragma("unroll") for (int tt = 0; tt < 2; ++tt) bf[tt] = *(const LAS bf16x8*)(TILE + (32 * tt + r32) * 520 + 16 * ks + 8 * hi); \
            _Pragma("unroll") for (int nt = 0; nt < 2; ++nt) _Pragma("unroll") for (int tt = 0; tt < 2; ++tt) acc[nt][tt] = MFMA32(BUFV[k4][nt], bf[tt], acc[nt][tt]); } } while (0)
#if defined(PROBE_P5) && PROBE_P5 == 1
        for (int rp_ = 0; rp_ < 2; ++rp_) {
        for (int i = 0; i < 2; ++i) for (int j = 0; j < 2; ++j) acc[i][j] = (f32x16){};
#else
        {
#endif
        GLU_LOAD(gA0, 0);
#pragma unroll 1
        for (int c = 0; c < 8; c += 2) {
            GLU_LOAD(gA1, c + 1);
            asm volatile("" ::: "memory");
            GLU_MMA(gA0, c);
            if (c + 2 < 8) GLU_LOAD(gA0, c + 2);
            asm volatile("" ::: "memory");
            GLU_MMA(gA1, c + 1);
        }
        }
#undef GLU_LOAD
#undef GLU_MMA
#pragma unroll
        for (int tt = 0; tt < 2; ++tt) { const int t = 32 * tt + r32; float ss = 0.f;
#pragma unroll
            for (int nt = 0; nt < 2; ++nt)
#pragma unroll
                for (int rg = 0; rg < 4; ++rg) { const int n0 = nb + 32 * nt + 8 * rg + 4 * hi;
                    const u32x2 s4 = *(const LAS u32x2*)(TILE + t * 520 + n0); const f32x4 b4 = *(const f32x4*)(a.in[18] + n0);
                    const float sv[4] = {bflo(s4.x), bfhi(s4.x), bflo(s4.y), bfhi(s4.y)};
#pragma unroll
                    for (int e = 0; e < 4; ++e) { const float gl = acc[nt][tt][4 * rg + e] + b4[e]; const float gv = sv[e] * __builtin_amdgcn_rcpf(1.0f + __builtin_amdgcn_exp2f(-LOG2E * gl));
                        acc[nt][tt][4 * rg + e] = gv; ss += gv * gv; } }
            ss += __shfl_xor(ss, 32);
            if (hi == 0) SSQ2[wid * 64 + t] = ss; }
        u32x4 zpre[8];
#pragma unroll
        for (int i = 0; i < 8; ++i) { const int id = tid + 512 * i, row = id >> 6, ch = id & 63; zpre[i] = __builtin_nontemporal_load((const u32x4*)(proj + (tok0 + row) * NP + COL_ZS + ch * 8)); }
        __syncthreads();
#pragma unroll
        for (int tt = 0; tt < 2; ++tt) { const int t = 32 * tt + r32; float tot = 0.f;
#pragma unroll
            for (int w = 0; w < 8; ++w) tot += SSQ2[w * 64 + t];
            const float* sq = (const float*)(a.ws + WS_SSQA) + tok0 + t;
            const float rstd = sqrtf((((sq[0] + sq[MTOK]) + sq[2 * MTOK]) * (1.0f / AW) + EPSN) / (tot * (1.0f / SW) + EPSN));
#pragma unroll
            for (int nt = 0; nt < 2; ++nt)
#pragma unroll
                for (int rg = 0; rg < 4; ++rg) { const int n0 = nb + 32 * nt + 8 * rg + 4 * hi; const f32x4 g4 = *(const f32x4*)(a.in[19] + n0);
                    u32x2 w; w.x = pkbf(acc[nt][tt][4 * rg] * rstd * g4[0], acc[nt][tt][4 * rg + 1] * rstd * g4[1]); w.y = pkbf(acc[nt][tt][4 * rg + 2] * rstd * g4[2], acc[nt][tt][4 * rg + 3] * rstd * g4[3]);
                    *(LAS u32x2*)(TILE + t * 520 + n0) = w; } }
        __syncthreads();
#pragma unroll
        for (int i = 0; i < 8; ++i) { const int id = tid + 512 * i, row = id >> 6, ch = id & 63;
            const u32x4 o8 = *(const LAS u32x4*)(TILE + row * 520 + ch * 8);
            const u32x4 z8 = zpre[i];
            u32x4 w;
            w.x = pkbf(bflo(o8.x) * bflo(z8.x), bfhi(o8.x) * bfhi(z8.x)); w.y = pkbf(bflo(o8.y) * bflo(z8.y), bfhi(o8.y) * bfhi(z8.y));
            w.z = pkbf(bflo(o8.z) * bflo(z8.z), bfhi(o8.z) * bfhi(z8.z)); w.w = pkbf(bflo(o8.w) * bflo(z8.w), bfhi(o8.w) * bfhi(z8.w));
#ifdef DBG_NO_SSM
            w = (u32x4){0u, 0u, 0u, 0u};
#endif
#ifdef DBG_SAN_SSM
            { unsigned* wp = (unsigned*)&w; for (int e = 0; e < 4; ++e) { unsigned x = wp[e]; if ((x & 0x7f80u) == 0x7f80u) x &= 0xffff0000u; if ((x & 0x7f800000u) == 0x7f800000u) x &= 0xffffu; wp[e] = x; } }
#endif
            *(u32x4*)(mixed + (tok0 + row) * DM + AW + ch * 8) = w; }
        __syncthreads();
        if (next_u >= 0) { const size_t tokn = (size_t)(next_u / NCH) * SEQ + 64 * (next_u % NCH);
#pragma unroll
            for (int i = 0; i < 8; ++i) { const int id = tid + 512 * i, row = id >> 6, ch = id & 63;
                *(LAS u32x4*)(TILE + row * 520 + ch * 8) = *(const u32x4*)(proj + (tokn + row) * NP + COL_U + ch * 8); } }
        }
    }
}

__device__ __forceinline__ void phase_carry(const Args& a, LAS unsigned char* lds, int blk, int wid, int lane) {
    if (blk >= NB * 32) return;
    const int b = blk >> 5, g = blk & 31;
    const f32x2 aa = *(const f32x2*)((const float*)(a.ws + WS_A64) + (size_t)(g * 64 + lane) * 2);
    const f32x2* Sc = (const f32x2*)(a.ws + WS_SC); f32x2* Hc = (f32x2*)(a.ws + WS_HC);
    LAS f32x2* E = (LAS f32x2*)lds;
    const size_t base = ((size_t)(b * NCH + 32 * wid) * 32 + g) * 64 + lane;
    f32x2 s[32];
#pragma unroll
    for (int i = 0; i < 32; ++i) s[i] = Sc[base + (size_t)i * 2048];
    float hr = 0.f, hq = 0.f;
#pragma unroll
    for (int i = 0; i < 32; ++i) { const float sr = s[i][0], si = s[i][1]; s[i] = (f32x2){hr, hq};
        const float nr = fmaf(aa[0], hr, fmaf(-aa[1], hq, sr)), ni = fmaf(aa[0], hq, fmaf(aa[1], hr, si)); hr = nr; hq = ni; }
    E[wid * 64 + lane] = (f32x2){hr, hq};
    float pr = aa[0], pi = aa[1];
#pragma unroll
    for (int q = 0; q < 5; ++q) { const float tr = pr * pr - pi * pi, ti = 2.0f * pr * pi; pr = tr; pi = ti; }
    __syncthreads();
    float cr = 0.f, ci = 0.f;
    for (int v = 0; v < wid; ++v) { const f32x2 e = E[v * 64 + lane]; const float nr = fmaf(pr, cr, fmaf(-pi, ci, e[0])), ni = fmaf(pr, ci, fmaf(pi, cr, e[1])); cr = nr; ci = ni; }
#pragma unroll
    for (int i = 0; i < 32; ++i) { Hc[base + (size_t)i * 2048] = (f32x2){s[i][0] + cr, s[i][1] + ci};
        const float nr = aa[0] * cr - aa[1] * ci, ni = aa[0] * ci + aa[1] * cr; cr = nr; ci = ni; }
    __syncthreads();
}

__device__ __forceinline__ void phase_final(const Args& a, int G, int blk, int wid, int lane) {
    const float* ssqo = (const float*)(a.ws + WS_SSQO); const float* fg = a.in[21]; float* out = a.out;
    f32x4 g4[8];
#pragma unroll
    for (int i = 0; i < 8; ++i) g4[i] = *((const f32x4*)fg + lane + 64 * i);
    for (int r = blk * 8 + wid; r < MTOK; r += G * 8) {
        float s = lane < 32 ? ssqo[(size_t)lane * MTOK + r] : 0.f;
        const float rstd = 1.0f / sqrtf(wave_sum(s) * (1.0f / DM) + EPSN);
        f32x4* o = (f32x4*)(out + (size_t)r * DM) + lane;
#pragma unroll
        for (int i = 0; i < 8; ++i) { const f32x4 v = o[64 * i]; o[64 * i] = v * rstd * g4[i]; }
    }
}

__global__ void __launch_bounds__(512, 2) mk_fwd(Args a) {
    extern __shared__ __attribute__((aligned(16))) unsigned char lds_raw[];
    LAS unsigned char* lds = (LAS unsigned char*)lds_raw;
    cg::grid_group grid = cg::this_grid();
    const int tid = threadIdx.x, lane = tid & 63, wid = __builtin_amdgcn_readfirstlane(tid >> 6);
    const int G = gridDim.x, blk = blockIdx.x;
    const int lo = a.ph_lo, hi_ph = a.ph_hi;
    if (tid < 16) ((LAS unsigned*)(lds + LDS_ST_OFF))[tid] = 0u;
    __syncthreads();
    XcdBarrier bar = xcd_barrier_post((unsigned*)(a.ws + WS_BAR), (volatile LAS unsigned*)(lds + LDS_ST_OFF));
    if (hi_ph > 1000) grid.sync();
#define IN(k) (lo <= (k) && (k) < hi_ph)
#define SEAM(k) do { if ((k) + 1 < hi_ph) xcd_barrier(bar); } while (0)
#ifndef REPMASK
#define REPMASK 0
#endif
#define NREP(k) (((REPMASK >> (k)) & 1) ? 2 : 1)
    if (IN(0)) for (int rep_ = 0; rep_ < NREP(0); ++rep_) { if (rep_) xcd_barrier(bar);
#ifndef OFF_P0
        phase0(a, lds, G, blk, tid, wid, lane);
#endif
        SEAM(0); }
#ifdef EXTRA_SYNCS
    for (int es_ = 0; es_ < EXTRA_SYNCS; ++es_) xcd_barrier(bar);
#endif
    if (IN(1)) for (int rep_ = 0; rep_ < NREP(1); ++rep_) { if (rep_) xcd_barrier(bar);
#ifndef OFF_P1
        phase1(a, lds, G, blk, tid, wid, lane);
#endif
        SEAM(1); }
    if (IN(2)) for (int rep_ = 0; rep_ < NREP(2); ++rep_) { if (rep_) xcd_barrier(bar);
#ifndef OFF_P2
        pg8::Gemm g{(const bf16_t*)(a.ws + WS_HB), (const bf16_t*)(a.ws + WS_WIN), MTOK, NP, DM}; pg8::StaticOrder S; S.init(MTOK, NP, G, blk);
        pg8::EpiProj E{(bf16_t*)(a.ws + WS_PROJ), NP, (const float*)(a.ws + WS_BIASP), QSCALE};
        pg8::gemm_phase<pg8::EpiProj, pg8::StaticOrder, true, true>(lds, g, S, E);
#endif
        SEAM(2); }
    if (IN(3)) for (int rep_ = 0; rep_ < NREP(3); ++rep_) { if (rep_) xcd_barrier(bar);
        constexpr int NATT = NB * 3 * (SEQ / 128), NSSM = NB * NCH;
#ifndef OFF_P3A
        for (int L = blk; L < NATT; L += G) { const int qb = L % (SEQ / 128), r = L / (SEQ / 128), kvh = r % 3, b = r / 3; attn_unit(a, lds, b, kvh, qb, tid, wid, lane); }
#endif
#ifndef OFF_P3B
        for (int u = blk; u < NSSM; u += G) ssm_unit<false>(a, lds, u / NCH, u % NCH, tid, wid, lane);
#endif
        SEAM(3); }
    if (IN(4)) for (int rep_ = 0; rep_ < NREP(4); ++rep_) { if (rep_) xcd_barrier(bar);
#ifndef OFF_P4
        phase_carry(a, lds, blk, wid, lane);
#endif
        if (blk < NB * NCH) {
            const bf16_t* proj = (const bf16_t*)(a.ws + WS_PROJ); const size_t tok0 = (size_t)(blk / NCH) * SEQ + 64 * (blk % NCH);
#pragma unroll
            for (int i = 0; i < 8; ++i) { const int id = tid + 512 * i, row = id >> 6, ch = id & 63;
                *(LAS u32x4*)((LAS bf16_t*)(lds + 69632) + row * 520 + ch * 8) = *(const u32x4*)(proj + (tok0 + row) * NP + COL_U + ch * 8); }
        }
        SEAM(4); }
    if (IN(5)) for (int rep_ = 0; rep_ < NREP(5); ++rep_) { if (rep_) xcd_barrier(bar);
#ifndef OFF_P5
        for (int u = blk; u < NB * NCH; u += G) ssm_unit<true>(a, lds, u / NCH, u % NCH, tid, wid, lane, (u + G < NB * NCH) ? u + G : -1);
#endif
        SEAM(5); }
    if (IN(6)) for (int rep_ = 0; rep_ < NREP(6); ++rep_) { if (rep_) xcd_barrier(bar);
#ifndef OFF_P6
        pg8::Gemm g{(const bf16_t*)(a.ws + WS_HB), (const bf16_t*)(a.ws + WS_WOUT), MTOK, DM, DM};
#if MK_FUSE_FINAL
        pg8::OutOrder S{blk};
        pg8::EpiOutFused E{a.in[0], a.out, (const float*)(a.ws + WS_GATE), (const float*)(a.ws + WS_SSQA), a.in[21], (float*)(a.ws + WS_XSLOT), (unsigned*)(a.ws + WS_PCNT), MTOK, DM, SEQ};
        pg8::gemm_phase<pg8::EpiOutFused, pg8::OutOrder, true, true>(lds, g, S, E);
#else
        pg8::StaticOrder S; S.init(MTOK, DM, G, blk);
        pg8::EpiOut E{a.in[0], a.out, (const float*)(a.ws + WS_GATE), (const float*)(a.ws + WS_SSQA), (float*)(a.ws + WS_SSQO), MTOK, DM, SEQ};
        pg8::gemm_phase<pg8::EpiOut, pg8::StaticOrder, true, true>(lds, g, S, E);
#endif
#endif
        SEAM(6); }
    if (IN(7)) {
#if !defined(OFF_P7) && !MK_FUSE_FINAL
        phase_final(a, G, blk, wid, lane);
#endif
    }
#undef IN
#undef SEAM
}

extern "C" void kernel_launch(void* const* d_in, const int* in_sizes, int n_in, void* d_out, int out_size, void* d_ws, size_t ws_size, hipStream_t stream) {
    static int grid = 0;
    if (grid == 0) {
        int dev = 0, cus = 0, per_cu = 0;
        if (n_in != 22 || ws_size < WS_END) { fprintf(stderr, "kernel_launch: unexpected n_in %d / ws_size %zu\n", n_in, ws_size); grid = -1; return; }
        (void)hipGetDevice(&dev); (void)hipDeviceGetAttribute(&cus, hipDeviceAttributeMultiprocessorCount, dev);
        if (hipFuncSetAttribute((const void*)mk_fwd, hipFuncAttributeMaxDynamicSharedMemorySize, LDS_BYTES) != hipSuccess) { fprintf(stderr, "kernel_launch: hipFuncSetAttribute failed\n"); grid = -1; return; }
        if (hipOccupancyMaxActiveBlocksPerMultiprocessor(&per_cu, (const void*)mk_fwd, 512, LDS_BYTES) != hipSuccess || per_cu < 1) { fprintf(stderr, "kernel_launch: occupancy query gave %d\n", per_cu); per_cu = 1; (void)hipGetLastError(); }
        grid = cus * per_cu;
        while (grid > 0 && (MTOK % grid != 0 || SEQ % (MTOK / grid) != 0)) --grid;
    }
    if (grid <= 0) return;
#if MK_FUSE_FINAL
    if (grid != 256) { fprintf(stderr, "kernel_launch: the fused final-norm epilogue needs a 256-workgroup grid, got %d\n", grid); return; }
#endif
    (void)hipMemsetAsync((unsigned char*)d_ws + WS_BAR, 0, 16384 + 32768, stream);
    Args a{};
    for (int i = 0; i < 22; ++i) a.in[i] = (const float*)d_in[i];
    a.out = (float*)d_out; a.ws = (unsigned char*)d_ws;
#if MK_ONE_LAUNCH
    a.ph_lo = 0; a.ph_hi = NPHASE;
    void* args[] = {&a};
    hipError_t e = hipLaunchCooperativeKernel((const void*)mk_fwd, dim3(grid), dim3(512), args, LDS_BYTES, stream);
    if (e != hipSuccess) fprintf(stderr, "cooperative launch failed: %s (grid %d)\n", hipGetErrorString(e), grid);
#else
    for (int p = 0; p < NPHASE; ++p) { a.ph_lo = p; a.ph_hi = p + 1; hipLaunchKernelGGL(mk_fwd, dim3(grid), dim3(512), LDS_BYTES, stream, a); }
#endif
}
```

```cpp
#include <hip/hip_runtime.h>
#include <hip/hip_cooperative_groups.h>
#include <cstdio>
#include <cstdint>
namespace cg = cooperative_groups;
#define MK_ONE_LAUNCH 1
namespace pg8 {
#define PG8_LAS __attribute__((address_space(3)))
typedef unsigned short bf16_t;
typedef short bf16x8 __attribute__((ext_vector_type(8)));
typedef float f32x4 __attribute__((ext_vector_type(4)));
typedef unsigned u32x4 __attribute__((ext_vector_type(4)));
constexpr int BM = 256, BK = 64, HALF = 128, HTB = HALF * BK * 2  , STAGE_BYTES = 8 * HTB, NXCD = 8, WGM = 8;

__host__ __device__ __forceinline__ int lds_byte(int r, int c) { const int st = (r >> 4) * 2 + (c >> 5), rr = r & 15, cc = c & 31, ob = rr * 64 + cc * 2; return st * 1024 + (ob ^ (((ob >> 9) & 1) << 5)); }
__host__ __device__ __forceinline__ void stage_rc(int b, int& R, int& C) { const int st = b / 1024, sb = b % 1024, swz = sb ^ (((sb >> 9) & 1) << 5); R = (st >> 1) * 16 + swz / 64; C = (st & 1) * 32 + (swz % 64) / 2; }
__host__ __device__ __forceinline__ int perm32(int rho) { const int n = rho >> 4, i = rho & 15; return 8 * (i >> 2) + 4 * n + (i & 3); }

struct Unit { int pm, pn; };
struct Gemm { const bf16_t* A; const bf16_t* Bt; int M, N, K; };

struct StaticOrder {
    int nM, nN, nwg, G, c;
    __host__ __device__ void init(int M, int N, int G_, int c_) { nM = M / BM; nN = N / BM; nwg = nM * nN; G = G_; c = c_; }
    __host__ __device__ bool next(int i, Unit& u) const {
        const long L = (long)i * G + c; if (L >= nwg) return false;
        int wgid = (int)L; { const int q = nwg / NXCD, r = nwg % NXCD, xcd = wgid % NXCD, off = wgid / NXCD; wgid = (xcd < r ? xcd * (q + 1) : r * (q + 1) + (xcd - r) * q) + off; }
        const int nig = WGM * nN, gid = wgid / nig, fm = gid * WGM, gsz = (nM - fm) < WGM ? (nM - fm) : WGM;
        u.pm = fm + ((wgid % nig) % gsz); u.pn = (wgid % nig) / gsz; return true;
    }
    __device__ __forceinline__ void a_ready(const Unit&) const {}
    __device__ __forceinline__ void done(const Unit&) const {}
};

__device__ __forceinline__ unsigned cvt_pk_bf16(float lo, float hi) { unsigned r; asm volatile("v_cvt_pk_bf16_f32 %0, %1, %2" : "=v"(r) : "v"(lo), "v"(hi)); return r; }
#ifdef DBG_STAGE
#define DBG_MIX(x) ((f32x4){0.f, 0.f, 0.f, 0.f})
#else
#define DBG_MIX(x) (x)
#endif
typedef unsigned u32x4 __attribute__((ext_vector_type(4)));
__device__ __forceinline__ float silu_f(float v) { return v * __builtin_amdgcn_rcpf(1.0f + __builtin_amdgcn_exp2f(-1.4426950408889634f * v)); }
struct EpiProj {
    static constexpr bool PERM = true, AFTER_DRAIN = false, XCHG = false;
    bf16_t* O; int ldc; const float* bias; float qscale;
    __device__ __forceinline__ void operator()(const f32x4 (&acc)[2][2][4][2], const Unit& u, int wr, int wc, int fr, int fq) const {
        asm volatile("" : "+v"(fr), "+v"(fq));
        const int row0 = u.pm * BM + wr * 64 + fr; const int pn = u.pn;
        const int mode = (pn < 6) ? 1 : (((pn >= 8 && pn < 14) || pn >= 16) ? 2 : 0);
        const float sc = mode == 1 ? qscale : 1.f;
        const int col0 = pn * BM + wc * 32 + 8 * fq;
        f32x4 bv[2][2];
#pragma unroll
        for (int bj = 0; bj < 2; ++bj)
#pragma unroll
            for (int n = 0; n < 2; ++n) bv[bj][n] = *(const f32x4*)(bias + col0 + bj * HALF + 4 * n);
#pragma unroll
        for (int ai = 0; ai < 2; ++ai)
#pragma unroll
            for (int m = 0; m < 4; ++m) { bf16_t* rowp = O + (size_t)(row0 + ai * HALF + m * 16) * ldc + col0;
#pragma unroll
                for (int bj = 0; bj < 2; ++bj) { f32x4 v0 = acc[ai][bj][m][0] + bv[bj][0], v1 = acc[ai][bj][m][1] + bv[bj][1];
                    if (mode == 2) {
#pragma unroll
                        for (int e = 0; e < 4; ++e) { v0[e] = silu_f(v0[e]); v1[e] = silu_f(v1[e]); } }
                    v0 = v0 * sc; v1 = v1 * sc; u32x4 w; w.x = cvt_pk_bf16(v0[0], v0[1]); w.y = cvt_pk_bf16(v0[2], v0[3]); w.z = cvt_pk_bf16(v1[0], v1[1]); w.w = cvt_pk_bf16(v1[2], v1[3]);
                    __builtin_nontemporal_store(w, (u32x4*)(rowp + bj * HALF)); } }
    }
};
struct EpiOut {
    static constexpr bool PERM = true, AFTER_DRAIN = false, XCHG = false;
    const float* x; float* out; const float* gate; const float* ssqa; float* ssqo; int M_, ldc, seq;
    __device__ __forceinline__ void operator()(const f32x4 (&acc)[2][2][4][2], const Unit& u, int wr, int wc, int fr, int fq) const {
        const int col0 = u.pn * BM + wc * 32 + 8 * fq; const int batch = (u.pm * BM) / seq;
        f32x4 gv[2][2];
#pragma unroll
        for (int bj = 0; bj < 2; ++bj)
#pragma unroll
            for (int n = 0; n < 2; ++n) gv[bj][n] = *(const f32x4*)(gate + batch * ldc + col0 + bj * HALF + n * 4);
#pragma unroll
        for (int ai = 0; ai < 2; ++ai)
#pragma unroll
            for (int m = 0; m < 4; ++m) { const int row = u.pm * BM + ai * HALF + wr * 64 + m * 16 + fr; const size_t off = (size_t)row * ldc + col0; float ss = 0.f;
                const float ra = __builtin_amdgcn_rsqf(((ssqa[row] + ssqa[M_ + row]) + ssqa[2 * M_ + row]) * (1.0f / 1536.0f) + 1e-5f);
#pragma unroll
                for (int bj = 0; bj < 2; ++bj)
#pragma unroll
                    for (int n = 0; n < 2; ++n) { const f32x4 xv = *(const f32x4*)(x + off + bj * HALF + n * 4); const f32x4 y = xv + DBG_MIX(gv[bj][n] * (acc[ai][bj][m][n] * ra));
                        *(f32x4*)(out + off + bj * HALF + n * 4) = y; ss += (y[0] * y[0] + y[1] * y[1]) + (y[2] * y[2] + y[3] * y[3]); }
                ss += __shfl_xor(ss, 16); ss += __shfl_xor(ss, 32);
                if (fq == 0) ssqo[(size_t)(u.pn * 4 + wc) * M_ + row] = ss;
                asm volatile("" ::: "memory"); }
    }
};

struct OutOrder {
    int c;
    __device__ __forceinline__ bool next(int i, Unit& u) const { if (i >= 4) return false; const int x = c & 7, j = c >> 3; u.pm = (i * 8 + x) * 4 + (j >> 3); u.pn = j & 7; return true; }
    __device__ __forceinline__ void a_ready(const Unit&) const {}
    __device__ __forceinline__ void done(const Unit&) const {}
};
struct EpiOutFused {
    static constexpr bool PERM = true, AFTER_DRAIN = false, XCHG = true;
    __device__ __forceinline__ void touch(int pm, int pn, int tid) const {
        asm volatile("" : "+v"(tid));
        const unsigned o = (unsigned)((pm * BM + (tid >> 3)) * ldc + pn * BM + (tid & 7) * 32), st = 64u * (unsigned)ldc;
        const float t = (x[o] + x[o + st]) + (x[o + 2u * st] + x[o + 3u * st]);
        if (t == 1.2345678e-33f) out[0] = t;
    }
    const float* x; float* out; const float* gate; const float* ssqa; const float* fgain; float* slots; unsigned* cnt; int M_, ldc, seq;
    __device__ __forceinline__ void xchg(f32x4 (&acc)[2][2][4][2], const Unit& u, int wr, int wc, int fr, int fq, PG8_LAS unsigned char* xl, int wid, int lane) const {
        asm volatile("" : "+v"(fr), "+v"(fq), "+v"(lane));
        PG8_LAS float* P = (PG8_LAS float*)xl;
        PG8_LAS float* S = (PG8_LAS float*)(xl + 4096);
        asm volatile("" ::: "memory");
        const int col0 = u.pn * BM + wc * 32 + 8 * fq; const int batch = (u.pm * BM) / seq;
        {
            f32x4 gv[2][2];
#pragma unroll
            for (int bj = 0; bj < 2; ++bj)
#pragma unroll
                for (int n = 0; n < 2; ++n) gv[bj][n] = *(const f32x4*)(gate + batch * ldc + col0 + bj * HALF + n * 4);
#pragma unroll
            for (int ai = 0; ai < 2; ++ai)
#pragma unroll
                for (int m = 0; m < 4; ++m) { const int lrow = ai * HALF + wr * 64 + m * 16 + fr, row = u.pm * BM + lrow; const size_t off = (size_t)row * ldc + col0; float ss = 0.f;
                    const float ra = __builtin_amdgcn_rsqf(((ssqa[row] + ssqa[M_ + row]) + ssqa[2 * M_ + row]) * (1.0f / 1536.0f) + 1e-5f);
#pragma unroll
                    for (int bj = 0; bj < 2; ++bj)
#pragma unroll
                        for (int n = 0; n < 2; ++n) { const f32x4 xv = __builtin_nontemporal_load((const f32x4*)(x + off + bj * HALF + n * 4)); const f32x4 y = xv + gv[bj][n] * (acc[ai][bj][m][n] * ra);
                            acc[ai][bj][m][n] = y; ss += (y[0] * y[0] + y[1] * y[1]) + (y[2] * y[2] + y[3] * y[3]); }
                    ss += __shfl_xor(ss, 16); ss += __shfl_xor(ss, 32);
                    if (fq == 0) P[lrow * 4 + wc] = ss;
                    asm volatile("" ::: "memory"); }
        }
        asm volatile("s_waitcnt lgkmcnt(0)" ::: "memory"); __builtin_amdgcn_s_barrier(); asm volatile("" ::: "memory");
        const int tid = wid * 64 + lane;
        if (wid < 4) {
            const float s = (P[tid * 4 + 0] + P[tid * 4 + 1]) + (P[tid * 4 + 2] + P[tid * 4 + 3]);
            __hip_atomic_store(slots + ((size_t)(u.pm * BM + tid) * 8 + u.pn), s, __ATOMIC_RELAXED, __HIP_MEMORY_SCOPE_AGENT);
            asm volatile("s_waitcnt vmcnt(0)" ::: "memory");
            if (lane == 0) __hip_atomic_fetch_add(cnt + 64 * u.pm, 1u, __ATOMIC_RELAXED, __HIP_MEMORY_SCOPE_AGENT);
        }
        if (wid == 0) {
            unsigned sp = 0;
            while ((unsigned)__builtin_amdgcn_readfirstlane(__hip_atomic_load(cnt + 64 * u.pm, __ATOMIC_RELAXED, __HIP_MEMORY_SCOPE_AGENT)) < 32u) { __builtin_amdgcn_s_sleep(2); if (++sp > (1u << 22)) break; }
            __builtin_amdgcn_fence(__ATOMIC_ACQUIRE, "agent");
        }
        asm volatile("s_waitcnt vmcnt(0) lgkmcnt(0)" ::: "memory"); __builtin_amdgcn_s_barrier(); asm volatile("" ::: "memory");
        if (wid < 4) {
            const float* sl = slots + (size_t)(u.pm * BM + tid) * 8; float t = 0.f;
#pragma unroll
            for (int k = 0; k < 8; ++k) t += __hip_atomic_load(sl + k, __ATOMIC_RELAXED, __HIP_MEMORY_SCOPE_AGENT);
            S[tid] = __builtin_amdgcn_rsqf(t * (1.0f / 2048.0f) + 1e-5f);
        }
        asm volatile("s_waitcnt lgkmcnt(0)" ::: "memory"); __builtin_amdgcn_s_barrier(); asm volatile("" ::: "memory");
#pragma unroll
        for (int ai = 0; ai < 2; ++ai)
#pragma unroll
            for (int m = 0; m < 4; ++m) { const int lrow = ai * HALF + wr * 64 + m * 16 + fr; const float r = S[lrow]; const size_t off = (size_t)(u.pm * BM + lrow) * ldc + col0;
#pragma unroll
                for (int bj = 0; bj < 2; ++bj)
#pragma unroll
                    for (int n = 0; n < 2; ++n) *(f32x4*)(out + off + bj * HALF + n * 4) = acc[ai][bj][m][n] * r * *(const f32x4*)(fgain + col0 + bj * HALF + n * 4); }
    }
};
template <class Epi, class Sched, bool ALIGN_EPI = false, bool SP2 = false>
__device__ __forceinline__ void gemm_phase(PG8_LAS unsigned char* lds, const Gemm g, const Sched& S, const Epi& E) {
    const int tid = threadIdx.x, wid = __builtin_amdgcn_readfirstlane(tid >> 6), lane = tid & 63, wr = wid >> 2, wc = wid & 3, fr = lane & 15, fq = lane >> 4;
    const int K = g.K, nt = K / BK;
    unsigned voffA[2], voffB[2];
#pragma unroll
    for (int i = 0; i < 2; ++i) { int R, C; stage_rc(tid * 16 + i * 8192, R, C); const int Rb = Epi::PERM ? ((R & ~31) + perm32(R & 31)) : R;
        voffA[i] = (unsigned)(R * K + C) * 2u; voffB[i] = (unsigned)(Rb * K + C) * 2u; }
    const size_t kstep = (size_t)(BK * 2);
    const size_t hstep = (size_t)HALF * K * 2;
    const size_t tstep = 2 * hstep;
    const unsigned ldsw = (unsigned)wid * 1024u;
    const int aoff = lds_byte(wr * 64 + fr, fq * 8), boff = lds_byte(wc * 32 + fr, fq * 8);
#define PG8_SA(b, h) (((b) * 2 + (h)) * HTB)
#define PG8_SB(b, h) ((4 + (b) * 2 + (h)) * HTB)
#define PG8_STAGE(bufoff, gbase, voff) do { _Pragma("unroll") for (int _i = 0; _i < 2; ++_i) \
        __builtin_amdgcn_global_load_lds((const unsigned*)((const char*)(gbase) + (voff)[_i]), (PG8_LAS unsigned*)(lds + (bufoff) + ldsw + _i * 8192), 16, 0, 0); } while (0)
#define PG8_LDA(dst, b, h) do { _Pragma("unroll") for (int m = 0; m < 4; ++m) _Pragma("unroll") for (int k = 0; k < 2; ++k) dst[m][k] = *(const PG8_LAS bf16x8*)(lds + PG8_SA(b, h) + aoff + m * 2048 + k * 1024); } while (0)
#define PG8_LDB(dst, b, h) do { _Pragma("unroll") for (int n = 0; n < 2; ++n) _Pragma("unroll") for (int k = 0; k < 2; ++k) dst[n][k] = *(const PG8_LAS bf16x8*)(lds + PG8_SB(b, h) + boff + n * 2048 + k * 1024); } while (0)
#define PG8_MMA(ai, bj, At, Bt) do { __builtin_amdgcn_s_setprio(1); _Pragma("unroll") for (int m = 0; m < 4; ++m) _Pragma("unroll") for (int n = 0; n < 2; ++n) _Pragma("unroll") for (int k = 0; k < 2; ++k) \
        acc[ai][bj][m][n] = __builtin_amdgcn_mfma_f32_16x16x32_bf16(Bt[n][k], At[m][k], acc[ai][bj][m][n], 0, 0, 0); __builtin_amdgcn_s_setprio(0); } while (0)
#define PG8_WAIT_V(n) asm volatile("s_waitcnt vmcnt(" #n ")" ::: "memory")
#define PG8_WAIT_L(n) asm volatile("s_waitcnt lgkmcnt(" #n ")" ::: "memory")
#define PG8_BAR __builtin_amdgcn_s_barrier()
#define PG8_SCHED __builtin_amdgcn_sched_barrier(0)
    Unit cur, nxt; int ui = 0;
    if (!S.next(0, cur)) return;
    f32x4 acc[2][2][4][2];
#pragma unroll
    for (int a = 0; a < 2; ++a)
#pragma unroll
        for (int b = 0; b < 2; ++b)
#pragma unroll
            for (int m = 0; m < 4; ++m)
#pragma unroll
                for (int n = 0; n < 2; ++n) acc[a][b][m][n] = (f32x4){0.f, 0.f, 0.f, 0.f};
    bf16x8 At[4][2], B0[2][2], B1[2][2];
    const char* cA = (const char*)g.A + (size_t)cur.pm * tstep; const char* cB = (const char*)g.Bt + (size_t)cur.pn * tstep;
    S.a_ready(cur);
    if constexpr (SP2) {
        PG8_STAGE(PG8_SB(0, 0), cB, voffB); PG8_STAGE(PG8_SB(0, 1), cB + hstep, voffB); PG8_STAGE(PG8_SA(0, 0), cA, voffA); PG8_STAGE(PG8_SA(0, 1), cA + hstep, voffA);
        if (wr == 1) PG8_BAR;
        PG8_WAIT_V(2); PG8_BAR;
        PG8_STAGE(PG8_SB(1, 0), cB + kstep, voffB); PG8_STAGE(PG8_SA(1, 0), cA + kstep, voffA); PG8_STAGE(PG8_SB(1, 1), cB + hstep + kstep, voffB);
        PG8_WAIT_V(6); PG8_BAR;
    } else {
        PG8_STAGE(PG8_SB(0, 0), cB, voffB); PG8_STAGE(PG8_SA(0, 0), cA, voffA); PG8_STAGE(PG8_SB(0, 1), cB + hstep, voffB); PG8_STAGE(PG8_SA(0, 1), cA + hstep, voffA);
        if (wr == 1) PG8_BAR;
        PG8_WAIT_V(4); PG8_BAR;
        PG8_STAGE(PG8_SB(1, 0), cB + kstep, voffB); PG8_STAGE(PG8_SA(1, 0), cA + kstep, voffA); PG8_STAGE(PG8_SB(1, 1), cB + hstep + kstep, voffB);
        PG8_WAIT_V(6); PG8_BAR;
    }
    for (;;) {
        const bool has_next = S.next(ui + 1, nxt);
        const char* nA = has_next ? (const char*)g.A + (size_t)nxt.pm * tstep : cA; const char* nB = has_next ? (const char*)g.Bt + (size_t)nxt.pn * tstep : cB;
        for (int t = 0; t < nt; t += 2) {
            const bool last = (t == nt - 2);
            const char* a1 = cA + (size_t)(t + 1) * kstep;
            const char* a2 = last ? nA : cA + (size_t)(t + 2) * kstep; const char* b2 = last ? nB : cB + (size_t)(t + 2) * kstep;
            const char* a3 = a2 + kstep; const char* b3 = b2 + kstep;
            if (last && has_next) S.a_ready(nxt);
            if constexpr (SP2) {
            PG8_LDB(B0, 0, 0); PG8_LDB(B1, 0, 1); PG8_SCHED; PG8_LDA(At, 0, 0); PG8_STAGE(PG8_SA(1, 1), a1 + hstep, voffA);
            PG8_WAIT_V(8); PG8_WAIT_L(0); PG8_BAR; PG8_MMA(0, 0, At, B0); PG8_MMA(0, 1, At, B1); PG8_BAR; PG8_SCHED;
            PG8_LDA(At, 0, 1); PG8_STAGE(PG8_SB(0, 0), b2, voffB); PG8_STAGE(PG8_SB(0, 1), b2 + hstep, voffB); PG8_STAGE(PG8_SA(0, 0), a2, voffA);
            PG8_WAIT_V(8); PG8_WAIT_L(0); PG8_BAR; PG8_MMA(1, 0, At, B0); PG8_MMA(1, 1, At, B1); PG8_BAR; PG8_SCHED;
            PG8_LDB(B0, 1, 0); PG8_LDB(B1, 1, 1); PG8_SCHED; PG8_LDA(At, 1, 0); PG8_STAGE(PG8_SA(0, 1), a2 + hstep, voffA);
            PG8_WAIT_V(8); PG8_WAIT_L(0); PG8_BAR; PG8_MMA(0, 0, At, B0); PG8_MMA(0, 1, At, B1); PG8_BAR; PG8_SCHED;
            PG8_LDA(At, 1, 1); PG8_STAGE(PG8_SB(1, 0), b3, voffB); PG8_STAGE(PG8_SB(1, 1), b3 + hstep, voffB); PG8_STAGE(PG8_SA(1, 0), a3, voffA);
            PG8_WAIT_V(8); PG8_WAIT_L(0); PG8_BAR; PG8_MMA(1, 0, At, B0); PG8_MMA(1, 1, At, B1); PG8_BAR; PG8_SCHED;
            } else {
            PG8_LDB(B0, 0, 0); PG8_SCHED; PG8_LDA(At, 0, 0); PG8_STAGE(PG8_SA(1, 1), a1 + hstep, voffA);
            PG8_WAIT_L(8); PG8_BAR; PG8_WAIT_L(0); PG8_MMA(0, 0, At, B0); PG8_BAR; PG8_SCHED;
            PG8_LDB(B1, 0, 1); PG8_STAGE(PG8_SB(0, 0), b2, voffB);
            PG8_BAR; PG8_WAIT_L(0); PG8_MMA(0, 1, At, B1); PG8_BAR;
            PG8_LDA(At, 0, 1); PG8_STAGE(PG8_SA(0, 0), a2, voffA);
            PG8_BAR; PG8_WAIT_L(0); PG8_MMA(1, 0, At, B0); PG8_BAR; PG8_SCHED;
            PG8_STAGE(PG8_SB(0, 1), b2 + hstep, voffB);
            PG8_WAIT_V(6); PG8_BAR; PG8_MMA(1, 1, At, B1); PG8_BAR;
            PG8_LDB(B0, 1, 0); PG8_SCHED; PG8_LDA(At, 1, 0); PG8_STAGE(PG8_SA(0, 1), a2 + hstep, voffA);
            PG8_WAIT_L(8); PG8_BAR; PG8_WAIT_L(0); PG8_MMA(0, 0, At, B0); PG8_BAR; PG8_SCHED;
            PG8_LDB(B1, 1, 1); PG8_STAGE(PG8_SB(1, 0), b3, voffB);
            PG8_BAR; PG8_WAIT_L(0); PG8_MMA(0, 1, At, B1); PG8_BAR;
            PG8_LDA(At, 1, 1); PG8_STAGE(PG8_SA(1, 0), a3, voffA);
            PG8_BAR; PG8_WAIT_L(0); PG8_MMA(1, 0, At, B0); PG8_BAR; PG8_SCHED;
            PG8_STAGE(PG8_SB(1, 1), b3 + hstep, voffB);
            PG8_WAIT_V(6); PG8_BAR; PG8_MMA(1, 1, At, B1); PG8_BAR;
            }
        }
        if constexpr (ALIGN_EPI) { if (wr == 0) PG8_BAR; }
        if constexpr (!Epi::AFTER_DRAIN) { if constexpr (Epi::XCHG) E.xchg(acc, cur, wr, wc, fr, fq, lds + STAGE_BYTES, wid, lane); else E(acc, cur, wr, wc, fr, fq); S.done(cur); }
        if (!has_next) break;
#pragma unroll
        for (int a = 0; a < 2; ++a)
#pragma unroll
            for (int b = 0; b < 2; ++b)
#pragma unroll
                for (int m = 0; m < 4; ++m)
#pragma unroll
                    for (int n = 0; n < 2; ++n) acc[a][b][m][n] = (f32x4){0.f, 0.f, 0.f, 0.f};
        cur = nxt; cA = nA; cB = nB; ++ui;
        if constexpr (ALIGN_EPI) { if (wr == 1) PG8_BAR; }
    }
    PG8_WAIT_V(0);
    if constexpr (!ALIGN_EPI) { if (wr == 0) PG8_BAR; }
    PG8_BAR;
    if constexpr (Epi::AFTER_DRAIN) { E.fused(acc, cur, wr, wc, fr, fq, lds, wid, lane); S.done(cur); }
#undef PG8_SA
#undef PG8_SB
#undef PG8_STAGE
#undef PG8_LDA
#undef PG8_LDB
#undef PG8_MMA
#undef PG8_WAIT_V
#undef PG8_WAIT_L
#undef PG8_BAR
#undef PG8_SCHED
}
}
#define LAS __attribute__((address_space(3)))
typedef unsigned short bf16_t;
typedef short bf16x8 __attribute__((ext_vector_type(8)));
typedef float f32x4 __attribute__((ext_vector_type(4)));
typedef float f32x2 __attribute__((ext_vector_type(2)));
typedef float f32x16 __attribute__((ext_vector_type(16)));
typedef unsigned u32x4 __attribute__((ext_vector_type(4)));
typedef unsigned u32x2 __attribute__((ext_vector_type(2)));
constexpr int NB = 2, SEQ = 16384, MTOK = NB * SEQ, DM = 2048, NP = 4608, INW = 4480, AW = 1536, SW = 512;
constexpr int COL_Q = 0, COL_K = 1536, COL_V = 1728, COL_ZA = 2048, COL_U = 3584, COL_ZS = 4096;
constexpr int NCH = SEQ / 64;
constexpr float EPSN = 1e-5f, LOG2E = 1.4426950408889634f, QSCALE = 0.125f * LOG2E;
constexpr int KPARTS = 16;
constexpr size_t MiB = 1u << 20;
constexpr size_t WS_WIN = 0, WS_WOUT = 18 * MiB, WS_GLU = 26 * MiB, WS_MODP = 27 * MiB, WS_GATE = 28 * MiB, WS_BIASP = 28 * MiB + 65536,
                 WS_ABAR = 28 * MiB + 131072, WS_A64 = WS_ABAR + 16384, WS_BCAT = 28 * MiB + 196608, WS_CCAT = WS_BCAT + 131072,
                 WS_SSQA = 29 * MiB, WS_SSQO = 30 * MiB, WS_SC = 34 * MiB, WS_HC = 42 * MiB, WS_HB = 64 * MiB, WS_PROJ = 192 * MiB, WS_END = 480 * MiB;
constexpr int LDS_BYTES = 147456;
#ifndef MK_FUSE_FINAL
#define MK_FUSE_FINAL 1
#endif
constexpr int NPHASE = MK_FUSE_FINAL ? 7 : 8;
#ifndef MK_ONE_LAUNCH
#define MK_ONE_LAUNCH 1
#endif

typedef __bf16 bf16x2_t __attribute__((ext_vector_type(2)));
__device__ __forceinline__ unsigned pkbf(float lo, float hi) { const f32x2 v = {lo, hi}; const bf16x2_t b = __builtin_convertvector(v, bf16x2_t); return __builtin_bit_cast(unsigned, b); }
__device__ __forceinline__ float bflo(unsigned v) { return __uint_as_float(v << 16); }
__device__ __forceinline__ float bfhi(unsigned v) { return __uint_as_float(v & 0xffff0000u); }
__device__ __forceinline__ float wave_sum(float v) {
#pragma unroll
    for (int o = 1; o < 64; o <<= 1) v += __shfl_xor(v, o);
    return v;
}
#define LDS_WAIT() asm volatile("s_waitcnt lgkmcnt(0)" ::: "memory")

constexpr size_t WS_BAR = 51 * MiB, WS_PCNT = WS_BAR + 16384, WS_XSLOT = 52 * MiB; constexpr int LDS_ST_OFF = LDS_BYTES - 64;
#define XB_TMO      128
#define XB_XCNT(j)  (256  + 64 * (j))
#define XB_XSUB(j)  (1280 + 64 * (j))
#define XB_XGEN(j)  (2304 + 64 * (j))
#define XB_TOP      3328
#define XB_TOPGEN   3392
#define XCD_BAR_WORDS 3456
#define XB_SPIN_CAP (1u << 18)

__device__ __forceinline__ unsigned xb_ld(unsigned* p)              { return __hip_atomic_load(p, __ATOMIC_RELAXED, __HIP_MEMORY_SCOPE_AGENT); }
__device__ __forceinline__ unsigned xb_add(unsigned* p, unsigned v) { return __hip_atomic_fetch_add(p, v, __ATOMIC_RELAXED, __HIP_MEMORY_SCOPE_AGENT); }
__device__ __forceinline__ unsigned xb_xcc_id() { return (unsigned)__builtin_amdgcn_s_getreg((3 << 11) | 20) & 0xFu; }
#define XB_SPIN(cond, bar) do { unsigned _sp = 0; while (cond) { __builtin_amdgcn_s_sleep(1); \
    if ((++_sp & 255u) == 0u) { if (xb_ld(&(bar)[XB_TMO])) break; if (_sp > XB_SPIN_CAP) { atomicAdd(&(bar)[XB_TMO], 1u); break; } } } } while (0)

struct XcdBarrier {
    unsigned* bar; unsigned x;
    volatile LAS unsigned* st;
};

__device__ __forceinline__ XcdBarrier xcd_barrier_post(unsigned* bar, volatile LAS unsigned* st) {
    XcdBarrier b; b.bar = bar; b.x = xb_xcc_id(); b.st = st;
    if (threadIdx.x == 0) (void)xb_add(&bar[XB_XCNT(b.x)], 1u);
    return b;
}
__device__ __forceinline__ void xcd_barrier_complete(unsigned* bar, unsigned x, unsigned& nloc, unsigned& nx) {
    const unsigned G = gridDim.x * gridDim.y * gridDim.z;
    unsigned sum, cnt, mine, sp = 0u;
    for (;;) {
        sum = 0u; cnt = 0u; mine = 0u;
#pragma unroll
        for (unsigned j = 0; j < 16; ++j) { const unsigned c = xb_ld(&bar[XB_XCNT(j)]); sum += c; cnt += (c > 0u) ? 1u : 0u; mine = (j == x) ? c : mine; }
        if (sum == G) break;
        __builtin_amdgcn_s_sleep(1);
        if ((++sp & 255u) == 0u) { if (xb_ld(&bar[XB_TMO])) break; if (sp > XB_SPIN_CAP) { atomicAdd(&bar[XB_TMO], 1u); break; } }
    }
    nloc = mine > 0u ? mine : 1u; nx = cnt > 0u ? cnt : 1u;
}

__device__ __forceinline__ void xcd_barrier(const XcdBarrier& b) {
    asm volatile("s_waitcnt vmcnt(0)" ::: "memory");
    __syncthreads();
    if (threadIdx.x == 0) {
        unsigned* bar = b.bar;
        __builtin_amdgcn_s_waitcnt(0);
        unsigned nloc = b.st[0], nx = b.st[1];
        if (nloc == 0u) { xcd_barrier_complete(bar, b.x, nloc, nx); b.st[0] = nloc; b.st[1] = nx; }
        const unsigned old = xb_add(&bar[XB_XSUB(b.x)], 1u);
        const unsigned gen = old / nloc;
        if (old + 1u == (gen + 1u) * nloc) {
            __builtin_amdgcn_fence(__ATOMIC_RELEASE, "agent");
            asm volatile("s_waitcnt vmcnt(0)" ::: "memory");
            const unsigned og = xb_add(&bar[XB_TOP], 1u);
            const unsigned tg = og / nx;
            if (og + 1u == (tg + 1u) * nx) xb_add(&bar[XB_TOPGEN], 1u);
            else XB_SPIN(xb_ld(&bar[XB_TOPGEN]) == tg, bar);
            __builtin_amdgcn_fence(__ATOMIC_ACQUIRE, "agent");
            xb_add(&bar[XB_XGEN(b.x)], 1u);
            asm volatile("s_waitcnt vmcnt(0)" ::: "memory");
        } else {
            XB_SPIN(xb_ld(&bar[XB_XGEN(b.x)]) == gen, bar);
            __builtin_amdgcn_fence(__ATOMIC_ACQUIRE, "agent");
            asm volatile("s_waitcnt vmcnt(0)" ::: "memory");
        }
    }
    __syncthreads();
}


struct Args { const float* in[22]; float* out; unsigned char* ws; int ph_lo, ph_hi; };

__device__ __forceinline__ void transpose_item(const float* W, int ldw, int src_n0, int k0, bf16_t* WT, int K, int dst_n0, LAS float* scr, int lane) {
    if (src_n0 >= 0) {
#pragma unroll
        for (int i = 0; i < 32; ++i) { const int kk = 2 * i + (lane >> 5); scr[kk * 33 + (lane & 31)] = __builtin_nontemporal_load(W + (size_t)(k0 + kk) * ldw + src_n0 + (lane & 31)); }
    }
    LDS_WAIT();
    const int c = lane & 7;
#pragma unroll
    for (int j = 0; j < 4; ++j) { const int n = (lane >> 3) + 8 * j; const LAS float* s = scr + (8 * c) * 33 + n;
        u32x4 o = (u32x4){0u, 0u, 0u, 0u};
        if (src_n0 >= 0) { o.x = pkbf(s[0 * 33], s[1 * 33]); o.y = pkbf(s[2 * 33], s[3 * 33]); o.z = pkbf(s[4 * 33], s[5 * 33]); o.w = pkbf(s[6 * 33], s[7 * 33]); }
        *(u32x4*)(WT + (size_t)(dst_n0 + n) * K + k0 + 8 * c) = o; }
    LDS_WAIT();
}

__device__ __forceinline__ void phase0(const Args& a, LAS unsigned char* lds, int G, int blk, int tid, int wid, int lane) {
    unsigned char* ws = a.ws;
    LAS float* scr = (LAS float*)(lds + wid * 8448);
    LAS float* sil = (LAS float*)(lds + 69632);
    const int gw = blk * 8 + wid, NGW = G * 8;
    for (int k = tid; k < 2 * DM; k += 512) { const float cv = a.in[1][k]; sil[k] = cv / (1.0f + __expf(-cv)); }
    __syncthreads();
    {
        const float* wa = a.in[2]; const float* ba = a.in[3]; float* modp = (float*)(ws + WS_MODP);
        constexpr int NJ = 3 * DM / 64, KL = DM / KPARTS;
        for (int it = gw; it < NJ * KPARTS; it += NGW) {
            const int jg = it % NJ, kp = it / NJ, j = 64 * jg + lane; float a0 = 0.f, a1 = 0.f;
            const float* wp = wa + (size_t)(kp * KL) * (3 * DM) + j;
#pragma unroll 32
            for (int k = 0; k < KL; ++k) { const float w = __builtin_nontemporal_load(wp + (size_t)k * (3 * DM)); a0 += sil[kp * KL + k] * w; a1 += sil[DM + kp * KL + k] * w; }
            if (kp == 0) { const float bb = ba[j]; a0 += bb; a1 += bb; }
            modp[(size_t)(kp * 2 + 0) * (3 * DM) + j] = a0; modp[(size_t)(kp * 2 + 1) * (3 * DM) + j] = a1;
        }
    }
    { float* bp = (float*)(ws + WS_BIASP); const float* bi = a.in[6];
      for (int n = blk * 512 + tid; n < NP; n += G * 512) bp[n] = n < 1920 ? bi[n] : (n < 2048 ? 0.f : bi[n - 128]); }
    {
        const float *lre = a.in[9], *lim = a.in[10], *lst = a.in[11], *bre = a.in[12], *bim = a.in[13], *cre = a.in[14], *cim = a.in[15];
        float* abar = (float*)(ws + WS_ABAR); float* a64 = (float*)(ws + WS_A64); bf16_t* Bcat = (bf16_t*)(ws + WS_BCAT); bf16_t* Ccat = (bf16_t*)(ws + WS_CCAT);
        for (int e = (G - 1 - blk) * 512 + tid; e < 32 * 64 * 16; e += G * 512) {
            const int gp = e >> 4, cch = e & 15, g = gp >> 6, p = gp & 63;
            const float step = expf(lst[g]), lr = lre[gp], li = lim[gp];
            const float decay = expf(lr * step); const float ar = decay * cosf(li * step), ai = decay * sinf(li * step);
            const float den = lr * lr + li * li, nr = ar - 1.0f, ni = ai;
            const float cr_ = (nr * lr + ni * li) / den, ci_ = (ni * lr - nr * li) / den;
            if (cch == 0) { abar[2 * gp] = ar; abar[2 * gp + 1] = ai; float pr = ar, pi = ai;
#pragma unroll
                for (int s = 0; s < 6; ++s) { const float tr = pr * pr - pi * pi, ti = 2.0f * pr * pi; pr = tr; pi = ti; }
                a64[2 * gp] = pr; a64[2 * gp + 1] = pi; }
            const float br = bre[e], bi = bim[e];
            const float xr = cr_ * br - ci_ * bi, xi = cr_ * bi + ci_ * br;
            Bcat[((size_t)g * 128 + 2 * p) * 16 + cch] = (bf16_t)(pkbf(xr, 0.f) & 0xffffu);
            Bcat[((size_t)g * 128 + 2 * p + 1) * 16 + cch] = (bf16_t)(pkbf(xi, 0.f) & 0xffffu);
            const float c_r = cre[((size_t)g * 16 + cch) * 64 + p], c_i = cim[((size_t)g * 16 + cch) * 64 + p];
            *(unsigned*)(Ccat + ((size_t)g * 16 + cch) * 128 + 2 * p) = pkbf(c_r, -c_i);
        }
    }
}

__device__ __forceinline__ void phase1(const Args& a, LAS unsigned char* lds, int G, int blk, int tid, int wid, int lane) {
    unsigned char* ws = a.ws;
    const int rpb = MTOK / G, row_lo = blk * rpb, batch = row_lo / SEQ;
    LAS float* gs = (LAS float*)lds; LAS float* sh = gs + DM;
    const float* modp = (const float*)(ws + WS_MODP); const float* ng = a.in[4];
    for (int j = tid; j < DM; j += 512) { float s0 = 0.f, s1 = 0.f, s2 = 0.f;
#pragma unroll
        for (int kp = 0; kp < KPARTS; ++kp) { const float* mp = modp + (size_t)(kp * 2 + batch) * (3 * DM); s0 += mp[j]; s1 += mp[DM + j]; s2 += mp[2 * DM + j]; }
        gs[j] = ng[j] * (1.0f + s1); sh[j] = s0;
        if (row_lo % SEQ == 0) ((float*)(ws + WS_GATE))[batch * DM + j] = s2; }
    __syncthreads();
    if (wid >= 4) {
        LAS float* scr = (LAS float*)(lds + 16384 + (wid - 4) * 8448);
        const int gw = blk * 4 + (wid - 4), NGW = G * 4;
    constexpr int I_IN = (DM / 64) * (NP / 32), I_OUT = (DM / 64) * (DM / 32), I_GLU = (SW / 64) * (SW / 32);
    for (int it = gw; it < I_IN + I_OUT + I_GLU; it += NGW) {
        int r = it;
        if (r < I_IN) { const int nblk = NP / 32, kb = r / nblk, nb = r % nblk, n0 = 32 * nb; const int src = n0 < 1920 ? n0 : (n0 < 2048 ? -1 : n0 - 128);
            transpose_item(a.in[5], INW, src, 64 * kb, (bf16_t*)(ws + WS_WIN), DM, n0, scr, lane); continue; }
        r -= I_IN;
        if (r < I_OUT) { const int nblk = DM / 32, kb = r / nblk, nb = r % nblk; transpose_item(a.in[20], DM, 32 * nb, 64 * kb, (bf16_t*)(ws + WS_WOUT), DM, 32 * nb, scr, lane); continue; }
        r -= I_OUT;
        { const int nblk = SW / 32, kb = r / nblk, nb = r % nblk; transpose_item(a.in[17], SW, 32 * nb, 64 * kb, (bf16_t*)(ws + WS_GLU), SW, 32 * nb, scr, lane); }
    }
        return;
    }
    const float* x = a.in[0]; bf16_t* hb = (bf16_t*)(ws + WS_HB);
    for (int r = row_lo + 2 * wid; r < row_lo + rpb; r += 8) {
        const f32x4* xr = (const f32x4*)(x + (size_t)r * DM) + lane; f32x4 v[2][8]; float ss[2] = {0.f, 0.f};
#pragma unroll
        for (int q = 0; q < 2; ++q)
#pragma unroll
            for (int i = 0; i < 8; ++i) v[q][i] = __builtin_nontemporal_load(xr + q * (DM / 4) + 64 * i);
#pragma unroll
        for (int q = 0; q < 2; ++q)
#pragma unroll
            for (int i = 0; i < 8; ++i) ss[q] += (v[q][i][0] * v[q][i][0] + v[q][i][1] * v[q][i][1]) + (v[q][i][2] * v[q][i][2] + v[q][i][3] * v[q][i][3]);
#pragma unroll
        for (int q = 0; q < 2; ++q) {
            const float rstd = 1.0f / sqrtf(wave_sum(ss[q]) * (1.0f / DM) + EPSN);
            u32x2* o = (u32x2*)(hb + (size_t)(r + q) * DM) + lane;
#pragma unroll
            for (int i = 0; i < 8; ++i) { const f32x4 g4 = *(const LAS f32x4*)(gs + 4 * (lane + 64 * i)), s4 = *(const LAS f32x4*)(sh + 4 * (lane + 64 * i));
                const f32x4 h = v[q][i] * rstd * g4 + s4; u32x2 w; w.x = pkbf(h[0], h[1]); w.y = pkbf(h[2], h[3]); o[64 * i] = w; }
        }
    }
}

#define MFMA32(A, B, C) __builtin_amdgcn_mfma_f32_32x32x16_bf16(A, B, C, 0, 0, 0)
#define MFMA16(A, B, C) __builtin_amdgcn_mfma_f32_16x16x32_bf16(A, B, C, 0, 0, 0)
__device__ __forceinline__ void attn_unit(const Args& a, LAS unsigned char* lds, int b, int kvh, int qb, int tid, int wid, int lane) {
    const bf16_t* proj = (const bf16_t*)(a.ws + WS_PROJ); bf16_t* mixed = (bf16_t*)(a.ws + WS_HB); float* ssqa = (float*)(a.ws + WS_SSQA);
    const int r32 = lane & 31, hi = lane >> 5;
    LAS bf16_t* KS = (LAS bf16_t*)lds;
    LAS bf16_t* VT = (LAS bf16_t*)(lds + 36864);
    LAS bf16_t* OST = (LAS bf16_t*)(lds + 70656 + wid * 4608);
    LAS float* SSQ = (LAS float*)(lds + 107520);
    const long tok0 = (long)b * SEQ + qb * 128;
#pragma unroll
    for (int i = 0; i < 4; ++i) { const int id = tid + 512 * i, row = id >> 3, ch = id & 7;
        u32x4 v = (u32x4){0u, 0u, 0u, 0u};
        if (qb > 0 || row >= 128) v = *(const u32x4*)(proj + (size_t)(tok0 - 128 + row) * NP + COL_K + kvh * 64 + ch * 8);
        *(LAS u32x4*)(KS + row * 72 + ch * 8) = v; }
#pragma unroll
    for (int i = 0; i < 4; ++i) { const int id = tid + 512 * i, row = id & 255, ch = id >> 8;
        u32x4 v = (u32x4){0u, 0u, 0u, 0u};
        if (qb > 0 || row >= 128) v = *(const u32x4*)(proj + (size_t)(tok0 - 128 + row) * NP + COL_V + kvh * 64 + ch * 8);
#pragma unroll
        for (int e = 0; e < 8; ++e) VT[(ch * 8 + e) * 264 + row] = (bf16_t)((v[e >> 1] >> (16 * (e & 1))) & 0xffffu); }
    const int head = kvh * 8 + wid;
    bf16x8 qn[4];
#pragma unroll
    for (int ds = 0; ds < 4; ++ds) qn[ds] = __builtin_nontemporal_load((const bf16x8*)(proj + (size_t)(tok0 + r32) * NP + COL_Q + head * 64 + 16 * ds + 8 * hi));
    __syncthreads();
    const float sink2 = a.in[7][head] * LOG2E;
    const int oc = (lane & 7) * 8;
    const f32x4 g0 = *(const f32x4*)(a.in[8] + head * 64 + oc), g1 = *(const f32x4*)(a.in[8] + head * 64 + oc + 4);
    const float NEG = -1.0e30f;
    for (int s = 0; s < 4; ++s) {
        bf16x8 qf[4];
#pragma unroll
        for (int ds = 0; ds < 4; ++ds) qf[ds] = qn[ds];
        if (s < 3) { const size_t qtok = (size_t)(tok0 + 32 * (s + 1) + r32);
#pragma unroll
            for (int ds = 0; ds < 4; ++ds) qn[ds] = __builtin_nontemporal_load((const bf16x8*)(proj + qtok * NP + COL_Q + head * 64 + 16 * ds + 8 * hi)); }
        u32x4 zp[4];
#pragma unroll
        for (int i = 0; i < 4; ++i) zp[i] = __builtin_nontemporal_load((const u32x4*)(proj + (size_t)(tok0 + 32 * s + 8 * i + (lane >> 3)) * NP + COL_ZA + head * 64 + oc));
        f32x16 S[5];
#pragma unroll
        for (int j = 0; j < 5; ++j) { const int kb0 = 32 * (s + j); f32x16 acc = {};
#pragma unroll
            for (int ds = 0; ds < 4; ++ds) { const bf16x8 kf = *(const LAS bf16x8*)(KS + (kb0 + r32) * 72 + 16 * ds + 8 * hi); acc = MFMA32(kf, qf[ds], acc); }
            S[j] = acc; }
#pragma unroll
        for (int r = 0; r < 16; ++r) { const int kk = (r & 3) + 8 * (r >> 2) + 4 * hi; if (kk <= r32) S[0][r] = NEG; if (kk > r32) S[4][r] = NEG; }
        if (qb == 0) {
#pragma unroll
            for (int j = 0; j < 4; ++j) if (s + j < 4) {
#pragma unroll
                for (int r = 0; r < 16; ++r) S[j][r] = NEG; } }
        float m = NEG;
#pragma unroll
        for (int j = 0; j < 5; ++j)
#pragma unroll
            for (int r = 0; r < 16; ++r) m = fmaxf(m, S[j][r]);
        m = fmaxf(m, __shfl_xor(m, 32));
        float l = 0.f;
#pragma unroll
        for (int j = 0; j < 5; ++j)
#pragma unroll
            for (int r = 0; r < 16; ++r) { const float p = __builtin_amdgcn_exp2f(S[j][r] - m); S[j][r] = p; l += p; }
        l += __shfl_xor(l, 32); l += __builtin_amdgcn_exp2f(sink2 - m);
        f32x16 O[2]; O[0] = (f32x16){}; O[1] = (f32x16){};
#pragma unroll
        for (int j = 0; j < 5; ++j)
#pragma unroll
            for (int s2 = 0; s2 < 2; ++s2) {
                u32x4 pw; pw.x = pkbf(S[j][8 * s2 + 0], S[j][8 * s2 + 1]); pw.y = pkbf(S[j][8 * s2 + 2], S[j][8 * s2 + 3]); pw.z = pkbf(S[j][8 * s2 + 4], S[j][8 * s2 + 5]); pw.w = pkbf(S[j][8 * s2 + 6], S[j][8 * s2 + 7]);
                const bf16x8 pf = __builtin_bit_cast(bf16x8, pw);
                const int kv0 = 32 * (s + j) + 16 * s2 + 4 * hi;
#pragma unroll
                for (int dt = 0; dt < 2; ++dt) { const int d = 32 * dt + r32;
                    const u32x2 lo = *(const LAS u32x2*)(VT + d * 264 + kv0), hh = *(const LAS u32x2*)(VT + d * 264 + kv0 + 8);
                    const u32x4 vw = (u32x4){lo.x, lo.y, hh.x, hh.y};
                    O[dt] = MFMA32(__builtin_bit_cast(bf16x8, vw), pf, O[dt]); }
            }
        const float inv = 1.0f / l; float ss = 0.f;
#pragma unroll
        for (int dt = 0; dt < 2; ++dt)
#pragma unroll
            for (int r = 0; r < 16; ++r) { const float o = O[dt][r] * inv; O[dt][r] = o; ss += o * o; }
        ss += __shfl_xor(ss, 32);
        if (hi == 0) SSQ[wid * 128 + 32 * s + r32] = ss;
#pragma unroll
        for (int dt = 0; dt < 2; ++dt)
#pragma unroll
            for (int rg = 0; rg < 4; ++rg) { u32x2 w; w.x = pkbf(O[dt][4 * rg], O[dt][4 * rg + 1]); w.y = pkbf(O[dt][4 * rg + 2], O[dt][4 * rg + 3]);
                *(LAS u32x2*)(OST + r32 * 72 + 32 * dt + 8 * rg + 4 * hi) = w; }
        LDS_WAIT();
#pragma unroll
        for (int i = 0; i < 4; ++i) { const int row = 8 * i + (lane >> 3); const size_t tok = (size_t)(tok0 + 32 * s + row);
            const u32x4 o8 = *(const LAS u32x4*)(OST + row * 72 + oc);
            const u32x4 z8 = zp[i];
            u32x4 w;
            w.x = pkbf(bflo(o8.x) * g0[0] * bflo(z8.x), bfhi(o8.x) * g0[1] * bfhi(z8.x));
            w.y = pkbf(bflo(o8.y) * g0[2] * bflo(z8.y), bfhi(o8.y) * g0[3] * bfhi(z8.y));
            w.z = pkbf(bflo(o8.z) * g1[0] * bflo(z8.z), bfhi(o8.z) * g1[1] * bfhi(z8.z));
            w.w = pkbf(bflo(o8.w) * g1[2] * bflo(z8.w), bfhi(o8.w) * g1[3] * bfhi(z8.w));
#ifdef DBG_NO_ATTN
            w = (u32x4){0u, 0u, 0u, 0u};
#endif
            *(u32x4*)(mixed + tok * DM + head * 64 + oc) = w; }
        LDS_WAIT();
    }
    __syncthreads();
    if (tid < 128) { float t = 0.f;
#pragma unroll
        for (int w = 0; w < 8; ++w) t += SSQ[w * 128 + tid];
        ssqa[(size_t)kvh * MTOK + tok0 + tid] = t; }
    __syncthreads();
}

__device__ __forceinline__ f32x2 gelu_pk(f32x2 v) {
    const f32x2 av = __builtin_elementwise_abs(v), d = av * 0.2316418882f + 1.0f;
    f32x2 t; t.x = __builtin_amdgcn_rcpf(d.x); t.y = __builtin_amdgcn_rcpf(d.y);
    f32x2 q = t * 0.5307027145f + (-0.7265760135f); q = q * t + 0.7107068705f; q = q * t + (-0.142248368f); q = q * t + 0.127414796f; q = q * t;
    const f32x2 s = (v * v) * (-0.72134752044f);
    f32x2 e; e.x = __builtin_amdgcn_exp2f(s.x); e.y = __builtin_amdgcn_exp2f(s.y);
    const f32x2 mm = v * (q * e), r = v - mm;
    f32x2 o; o.x = v.x < 0.f ? mm.x : r.x; o.y = v.y < 0.f ? mm.y : r.y; return o;
}
template <bool FINAL>
__device__ __forceinline__ void ssm_unit(const Args& a, LAS unsigned char* lds, int b, int c64, int tid, int wid, int lane, int next_u = -1) {
    const bf16_t* proj = (const bf16_t*)(a.ws + WS_PROJ); bf16_t* mixed = (bf16_t*)(a.ws + WS_HB);
    const float* abar = (const float*)(a.ws + WS_ABAR); const bf16_t* Bcat = (const bf16_t*)(a.ws + WS_BCAT); const bf16_t* Ccat = (const bf16_t*)(a.ws + WS_CCAT);
    f32x2* Sc = (f32x2*)(a.ws + WS_SC); const f32x2* Hc = (const f32x2*)(a.ws + WS_HC);
    LAS bf16_t* BUF = (LAS bf16_t*)(lds + wid * 8704);
    LAS bf16_t* TILE = (LAS bf16_t*)(lds + 69632);
    LAS float* SSQ2 = (LAS float*)(lds + 136192);
    const size_t tok0 = (size_t)b * SEQ + 64 * c64;
    const int r32 = lane & 31, hi = lane >> 5, r16 = lane & 15, q4 = lane >> 4;
#if defined(PROBE_P5) && PROBE_P5 == 2
    for (int rp_ = 0; rp_ < (FINAL ? 2 : 1); ++rp_) {
    if (rp_) __syncthreads();
#else
    {
#endif
    if (!FINAL) {
#pragma unroll
    for (int i = 0; i < 8; ++i) { const int id = tid + 512 * i, row = id >> 6, ch = id & 63;
        *(LAS u32x4*)(TILE + row * 520 + ch * 8) = *(const u32x4*)(proj + (tok0 + row) * NP + COL_U + ch * 8); }
    }
    bf16x8 bcN[4], ccN[4]; f32x2 abN, h0N = {0.f, 0.f}; f32x4 d4N = {0.f, 0.f, 0.f, 0.f};
#define SSM_LOADC(G_) do { const int g_ = (G_); \
        _Pragma("unroll") for (int jt = 0; jt < 4; ++jt) bcN[jt] = *(const bf16x8*)(Bcat + ((size_t)(g_ * 128 + 32 * jt + r32) * 16 + 8 * hi)); \
        abN = *(const f32x2*)(abar + (size_t)(g_ * 64 + lane) * 2); \
        if (FINAL) { h0N = Hc[((size_t)(b * NCH + c64) * 32 + g_) * 64 + lane]; d4N = *(const f32x4*)(a.in[16] + g_ * 16 + 4 * q4); \
            _Pragma("unroll") for (int ks = 0; ks < 4; ++ks) ccN[ks] = *(const bf16x8*)(Ccat + ((size_t)(g_ * 16 + r16) * 128 + 32 * ks + 8 * q4)); } } while (0)
    SSM_LOADC(wid);
    __syncthreads();
    for (int gi = 0; gi < 4; ++gi) {
        const int g = wid + 8 * gi;
        bf16x8 bc[4], cc[4];
#pragma unroll
        for (int i = 0; i < 4; ++i) { bc[i] = bcN[i]; cc[i] = ccN[i]; }
        const float ar = abN[0], ai = abN[1]; float hr = h0N[0], hq = h0N[1]; const f32x4 d4 = d4N;
        const size_t sidx = ((size_t)(b * NCH + c64) * 32 + g) * 64 + lane;
        if (gi < 3) SSM_LOADC(g + 8);
        for (int hh = 0; hh < 2; ++hh) {
            const bf16x8 uf = *(const LAS bf16x8*)(TILE + (32 * hh + r32) * 520 + g * 16 + 8 * hi);
#pragma unroll
            for (int jt = 0; jt < 4; ++jt) { f32x16 d = {}; d = MFMA32(bc[jt], uf, d);
#pragma unroll
                for (int rg = 0; rg < 4; ++rg) { u32x2 w; w.x = pkbf(d[4 * rg], d[4 * rg + 1]); w.y = pkbf(d[4 * rg + 2], d[4 * rg + 3]);
                    *(LAS u32x2*)(BUF + r32 * 136 + 32 * jt + 8 * rg + 4 * hi) = w; } }
            LDS_WAIT();
#pragma unroll
            for (int t0 = 0; t0 < 32; t0 += 8) { unsigned v[8];
#pragma unroll
                for (int i = 0; i < 8; ++i) v[i] = *(const LAS unsigned*)(BUF + (t0 + i) * 136 + 2 * lane);
#pragma unroll
                for (int i = 0; i < 8; ++i) { const float bur = bflo(v[i]), bui = bfhi(v[i]);
                    const float nr = fmaf(ar, hr, fmaf(-ai, hq, bur)), ni = fmaf(ar, hq, fmaf(ai, hr, bui)); hr = nr; hq = ni;
                    if (FINAL) *(LAS unsigned*)(BUF + (t0 + i) * 136 + 2 * lane) = pkbf(hr, hq); } }
            if (FINAL) {
                LDS_WAIT();
#pragma unroll
                for (int tt = 0; tt < 2; ++tt) { f32x4 y = {};
#pragma unroll
                    for (int ks = 0; ks < 4; ++ks) { const bf16x8 hf = *(const LAS bf16x8*)(BUF + (16 * tt + r16) * 136 + 32 * ks + 8 * q4); y = MFMA16(cc[ks], hf, y); }
                    const int tl = 32 * hh + 16 * tt + r16;
                    const u32x2 u4 = *(const LAS u32x2*)(TILE + tl * 520 + g * 16 + 4 * q4);
                    const f32x2 ga = gelu_pk((f32x2){y[0] + d4[0] * bflo(u4.x), y[1] + d4[1] * bfhi(u4.x)}), gb = gelu_pk((f32x2){y[2] + d4[2] * bflo(u4.y), y[3] + d4[3] * bfhi(u4.y)});
                    u32x2 w; w.x = pkbf(ga.x, ga.y); w.y = pkbf(gb.x, gb.y);
                    *(LAS u32x2*)(TILE + tl * 520 + g * 16 + 4 * q4) = w; }
                LDS_WAIT();
            }
        }
        if (!FINAL) Sc[sidx] = (f32x2){hr, hq};
    }
    }
#undef SSM_LOADC
    if (!FINAL) __syncthreads();
    if (FINAL) {
        const bf16_t* glu = (const bf16_t*)(a.ws + WS_GLU);
        __syncthreads();
#if defined(PROBE_P5) && PROBE_P5 == 3
        for (int i = tid; i < 64 * 65; i += 512) ((LAS u32x4*)lds)[i] = ((const LAS u32x4*)(lds + 69632))[i];
        __syncthreads();
        _Pragma("nounroll") for (int rp3_ = 0; rp3_ < a.ph_hi - 5; ++rp3_) {
        if (rp3_) { for (int i = tid; i < 64 * 65; i += 512) ((LAS u32x4*)(lds + 69632))[i] = ((const LAS u32x4*)lds)[i]; __syncthreads(); }
#else
        {
#endif
        f32x16 acc[2][2];
#pragma unroll
        for (int i = 0; i < 2; ++i)
#pragma unroll
            for (int j = 0; j < 2; ++j) acc[i][j] = (f32x16){};
        const int nb = 64 * wid;
        bf16x8 gA0[4][2], gA1[4][2];
        const bf16_t* gl0 = glu + (size_t)(nb + r32) * SW + 8 * hi;
#define GLU_LOAD(BUFV, c) do { _Pragma("unroll") for (int k4 = 0; k4 < 4; ++k4) { BUFV[k4][0] = *(const bf16x8*)(gl0 + 16 * (4 * (c) + k4)); BUFV[k4][1] = *(const bf16x8*)(gl0 + 32 * SW + 16 * (4 * (c) + k4)); } } while (0)
#define GLU_MMA(BUFV, c) do { _Pragma("unroll") for (int k4 = 0; k4 < 4; ++k4) { const int ks = 4 * (c) + k4; bf16x8 bf[2]; \
            _Pragma("unroll") for (int tt = 0; tt < 2; ++tt) bf[tt] = *(const LAS bf16x8*)(TILE + (32 * tt + r32) * 520 + 16 * ks + 8 * hi); \
            _Pragma("unroll") for (int nt = 0; nt < 2; ++nt) _Pragma("unroll") for (int tt = 0; tt < 2; ++tt) acc[nt][tt] = MFMA32(BUFV[k4][nt], bf[tt], acc[nt][tt]); } } while (0)
#if defined(PROBE_P5) && PROBE_P5 == 1
        for (int rp_ = 0; rp_ < 2; ++rp_) {
        for (int i = 0; i < 2; ++i) for (int j = 0; j < 2; ++j) acc[i][j] = (f32x16){};
#else
        {
#endif
        GLU_LOAD(gA0, 0);
#pragma unroll 1
        for (int c = 0; c < 8; c += 2) {
            GLU_LOAD(gA1, c + 1);
            asm volatile("" ::: "memory");
            GLU_MMA(gA0, c);
            if (c + 2 < 8) GLU_LOAD(gA0, c + 2);
            asm volatile("" ::: "memory");
            GLU_MMA(gA1, c + 1);
        }
        }
#undef GLU_LOAD
#undef GLU_MMA
#pragma unroll
        for (int tt = 0; tt < 2; ++tt) { const int t = 32 * tt + r32; float ss = 0.f;
#pragma unroll
            for (int nt = 0; nt < 2; ++nt)
#pragma unroll
                for (int rg = 0; rg < 4; ++rg) { const int n0 = nb + 32 * nt + 8 * rg + 4 * hi;
                    const u32x2 s4 = *(const LAS u32x2*)(TILE + t * 520 + n0); const f32x4 b4 = *(const f32x4*)(a.in[18] + n0);
                    const float sv[4] = {bflo(s4.x), bfhi(s4.x), bflo(s4.y), bfhi(s4.y)};
#pragma unroll
                    for (int e = 0; e < 4; ++e) { const float gl = acc[nt][tt][4 * rg + e] + b4[e]; const float gv = sv[e] * __builtin_amdgcn_rcpf(1.0f + __builtin_amdgcn_exp2f(-LOG2E * gl));
                        acc[nt][tt][4 * rg + e] = gv; ss += gv * gv; } }
            ss += __shfl_xor(ss, 32);
            if (hi == 0) SSQ2[wid * 64 + t] = ss; }
        u32x4 zpre[8];
#pragma unroll
        for (int i = 0; i < 8; ++i) { const int id = tid + 512 * i, row = id >> 6, ch = id & 63; zpre[i] = __builtin_nontemporal_load((const u32x4*)(proj + (tok0 + row) * NP + COL_ZS + ch * 8)); }
        __syncthreads();
#pragma unroll
        for (int tt = 0; tt < 2; ++tt) { const int t = 32 * tt + r32; float tot = 0.f;
#pragma unroll
            for (int w = 0; w < 8; ++w) tot += SSQ2[w * 64 + t];
            const float* sq = (const float*)(a.ws + WS_SSQA) + tok0 + t;
            const float rstd = sqrtf((((sq[0] + sq[MTOK]) + sq[2 * MTOK]) * (1.0f / AW) + EPSN) / (tot * (1.0f / SW) + EPSN));
#pragma unroll
            for (int nt = 0; nt < 2; ++nt)
#pragma unroll
                for (int rg = 0; rg < 4; ++rg) { const int n0 = nb + 32 * nt + 8 * rg + 4 * hi; const f32x4 g4 = *(const f32x4*)(a.in[19] + n0);
                    u32x2 w; w.x = pkbf(acc[nt][tt][4 * rg] * rstd * g4[0], acc[nt][tt][4 * rg + 1] * rstd * g4[1]); w.y = pkbf(acc[nt][tt][4 * rg + 2] * rstd * g4[2], acc[nt][tt][4 * rg + 3] * rstd * g4[3]);
                    *(LAS u32x2*)(TILE + t * 520 + n0) = w; } }
        __syncthreads();
#pragma unroll
        for (int i = 0; i < 8; ++i) { const int id = tid + 512 * i, row = id >> 6, ch = id & 63;
            const u32x4 o8 = *(const LAS u32x4*)(TILE + row * 520 + ch * 8);
            const u32x4 z8 = zpre[i];
            u32x4 w;
            w.x = pkbf(bflo(o8.x) * bflo(z8.x), bfhi(o8.x) * bfhi(z8.x)); w.y = pkbf(bflo(o8.y) * bflo(z8.y), bfhi(o8.y) * bfhi(z8.y));
            w.z = pkbf(bflo(o8.z) * bflo(z8.z), bfhi(o8.z) * bfhi(z8.z)); w.w = pkbf(bflo(o8.w) * bflo(z8.w), bfhi(o8.w) * bfhi(z8.w));
#ifdef DBG_NO_SSM
            w = (u32x4){0u, 0u, 0u, 0u};
#endif
#ifdef DBG_SAN_SSM
            { unsigned* wp = (unsigned*)&w; for (int e = 0; e < 4; ++e) { unsigned x = wp[e]; if ((x & 0x7f80u) == 0x7f80u) x &= 0xffff0000u; if ((x & 0x7f800000u) == 0x7f800000u) x &= 0xffffu; wp[e] = x; } }
#endif
            *(u32x4*)(mixed + (tok0 + row) * DM + AW + ch * 8) = w; }
        __syncthreads();
        if (next_u >= 0) { const size_t tokn = (size_t)(next_u / NCH) * SEQ + 64 * (next_u % NCH);
#pragma unroll
            for (int i = 0; i < 8; ++i) { const int id = tid + 512 * i, row = id >> 6, ch = id & 63;
                *(LAS u32x4*)(TILE + row * 520 + ch * 8) = *(const u32x4*)(proj + (tokn + row) * NP + COL_U + ch * 8); } }
        }
    }
}

__device__ __forceinline__ void ssm_local_unit2(const Args& a, LAS unsigned char* lds, int b, int c64, int wid, int lane) {
    const bf16_t* proj = (const bf16_t*)(a.ws + WS_PROJ);
    const float* abar = (const float*)(a.ws + WS_ABAR); const bf16_t* Bcat = (const bf16_t*)(a.ws + WS_BCAT);
    f32x2* Sc = (f32x2*)(a.ws + WS_SC);
    LAS bf16_t* BA = (LAS bf16_t*)(lds + wid * 17408);
    LAS bf16_t* BB = BA + 32 * 136;
    const size_t tok0 = (size_t)b * SEQ + 64 * c64;
    const int r32 = lane & 31, hi = lane >> 5;
    bf16x8 uf[4][2];
#pragma unroll
    for (int gi = 0; gi < 4; ++gi)
#pragma unroll
        for (int hh = 0; hh < 2; ++hh) uf[gi][hh] = *(const bf16x8*)(proj + (tok0 + 32 * hh + r32) * NP + COL_U + (wid + 8 * gi) * 16 + 8 * hi);
#pragma unroll
    for (int pr = 0; pr < 2; ++pr) {
        const int gA = wid + 16 * pr, gB = gA + 8;
        bf16x8 bcA[4], bcB[4];
#pragma unroll
        for (int jt = 0; jt < 4; ++jt) { bcA[jt] = *(const bf16x8*)(Bcat + ((size_t)(gA * 128 + 32 * jt + r32) * 16 + 8 * hi)); bcB[jt] = *(const bf16x8*)(Bcat + ((size_t)(gB * 128 + 32 * jt + r32) * 16 + 8 * hi)); }
        const f32x2 aA = *(const f32x2*)(abar + (size_t)(gA * 64 + lane) * 2), aB = *(const f32x2*)(abar + (size_t)(gB * 64 + lane) * 2);
        float hrA = 0.f, hqA = 0.f, hrB = 0.f, hqB = 0.f;
#pragma unroll
        for (int hh = 0; hh < 2; ++hh) {
#pragma unroll
            for (int jt = 0; jt < 4; ++jt) { f32x16 dA = {}, dB = {}; dA = MFMA32(bcA[jt], uf[2 * pr][hh], dA); dB = MFMA32(bcB[jt], uf[2 * pr + 1][hh], dB);
#pragma unroll
                for (int rg = 0; rg < 4; ++rg) { u32x2 w; w.x = pkbf(dA[4 * rg], dA[4 * rg + 1]); w.y = pkbf(dA[4 * rg + 2], dA[4 * rg + 3]);
                    *(LAS u32x2*)(BA + r32 * 136 + 32 * jt + 8 * rg + 4 * hi) = w;
                    u32x2 x; x.x = pkbf(dB[4 * rg], dB[4 * rg + 1]); x.y = pkbf(dB[4 * rg + 2], dB[4 * rg + 3]);
                    *(LAS u32x2*)(BB + r32 * 136 + 32 * jt + 8 * rg + 4 * hi) = x; } }
            LDS_WAIT();
#pragma unroll
            for (int t0 = 0; t0 < 32; t0 += 8) { unsigned vA[8], vB[8];
#pragma unroll
                for (int i = 0; i < 8; ++i) { vA[i] = *(const LAS unsigned*)(BA + (t0 + i) * 136 + 2 * lane); vB[i] = *(const LAS unsigned*)(BB + (t0 + i) * 136 + 2 * lane); }
#pragma unroll
                for (int i = 0; i < 8; ++i) {
                    const float nrA = fmaf(aA[0], hrA, fmaf(-aA[1], hqA, bflo(vA[i]))), niA = fmaf(aA[0], hqA, fmaf(aA[1], hrA, bfhi(vA[i]))); hrA = nrA; hqA = niA;
                    const float nrB = fmaf(aB[0], hrB, fmaf(-aB[1], hqB, bflo(vB[i]))), niB = fmaf(aB[0], hqB, fmaf(aB[1], hrB, bfhi(vB[i]))); hrB = nrB; hqB = niB; } }
            LDS_WAIT();
        }
        Sc[((size_t)(b * NCH + c64) * 32 + gA) * 64 + lane] = (f32x2){hrA, hqA};
        Sc[((size_t)(b * NCH + c64) * 32 + gB) * 64 + lane] = (f32x2){hrB, hqB};
    }
}

__device__ __forceinline__ void phase_carry(const Args& a, LAS unsigned char* lds, int blk, int wid, int lane) {
    if (blk >= NB * 32) return;
    const int b = blk >> 5, g = blk & 31;
    const f32x2 aa = *(const f32x2*)((const float*)(a.ws + WS_A64) + (size_t)(g * 64 + lane) * 2);
    const f32x2* Sc = (const f32x2*)(a.ws + WS_SC); f32x2* Hc = (f32x2*)(a.ws + WS_HC);
    LAS f32x2* E = (LAS f32x2*)lds;
    const size_t base = ((size_t)(b * NCH + 32 * wid) * 32 + g) * 64 + lane;
    f32x2 s[32];
#pragma unroll
    for (int i = 0; i < 32; ++i) s[i] = Sc[base + (size_t)i * 2048];
    float hr = 0.f, hq = 0.f;
#pragma unroll
    for (int i = 0; i < 32; ++i) { const float sr = s[i][0], si = s[i][1]; s[i] = (f32x2){hr, hq};
        const float nr = fmaf(aa[0], hr, fmaf(-aa[1], hq, sr)), ni = fmaf(aa[0], hq, fmaf(aa[1], hr, si)); hr = nr; hq = ni; }
    E[wid * 64 + lane] = (f32x2){hr, hq};
    float pr = aa[0], pi = aa[1];
#pragma unroll
    for (int q = 0; q < 5; ++q) { const float tr = pr * pr - pi * pi, ti = 2.0f * pr * pi; pr = tr; pi = ti; }
    __syncthreads();
    float cr = 0.f, ci = 0.f;
    for (int v = 0; v < wid; ++v) { const f32x2 e = E[v * 64 + lane]; const float nr = fmaf(pr, cr, fmaf(-pi, ci, e[0])), ni = fmaf(pr, ci, fmaf(pi, cr, e[1])); cr = nr; ci = ni; }
#pragma unroll
    for (int i = 0; i < 32; ++i) { Hc[base + (size_t)i * 2048] = (f32x2){s[i][0] + cr, s[i][1] + ci};
        const float nr = aa[0] * cr - aa[1] * ci, ni = aa[0] * ci + aa[1] * cr; cr = nr; ci = ni; }
    __syncthreads();
}

__device__ __forceinline__ void phase_final(const Args& a, int G, int blk, int wid, int lane) {
    const float* ssqo = (const float*)(a.ws + WS_SSQO); const float* fg = a.in[21]; float* out = a.out;
    f32x4 g4[8];
#pragma unroll
    for (int i = 0; i < 8; ++i) g4[i] = *((const f32x4*)fg + lane + 64 * i);
    for (int r = blk * 8 + wid; r < MTOK; r += G * 8) {
        float s = lane < 32 ? ssqo[(size_t)lane * MTOK + r] : 0.f;
        const float rstd = 1.0f / sqrtf(wave_sum(s) * (1.0f / DM) + EPSN);
        f32x4* o = (f32x4*)(out + (size_t)r * DM) + lane;
#pragma unroll
        for (int i = 0; i < 8; ++i) { const f32x4 v = o[64 * i]; o[64 * i] = v * rstd * g4[i]; }
    }
}

__global__ void __launch_bounds__(512, 2) mk_fwd(Args a) {
    extern __shared__ __attribute__((aligned(16))) unsigned char lds_raw[];
    LAS unsigned char* lds = (LAS unsigned char*)lds_raw;
    cg::grid_group grid = cg::this_grid();
    const int tid = threadIdx.x, lane = tid & 63, wid = __builtin_amdgcn_readfirstlane(tid >> 6);
    const int G = gridDim.x, blk = blockIdx.x;
    const int lo = a.ph_lo, hi_ph = a.ph_hi;
    if (tid < 16) ((LAS unsigned*)(lds + LDS_ST_OFF))[tid] = 0u;
    __syncthreads();
    XcdBarrier bar = xcd_barrier_post((unsigned*)(a.ws + WS_BAR), (volatile LAS unsigned*)(lds + LDS_ST_OFF));
    if (hi_ph > 1000) grid.sync();
#define IN(k) (lo <= (k) && (k) < hi_ph)
#define SEAM(k) do { if ((k) + 1 < hi_ph) xcd_barrier(bar); } while (0)
#ifndef REPMASK
#define REPMASK 0
#endif
#define NREP(k) (((REPMASK >> (k)) & 1) ? 2 : 1)
    if (IN(0)) for (int rep_ = 0; rep_ < NREP(0); ++rep_) { if (rep_) xcd_barrier(bar);
#ifndef OFF_P0
        phase0(a, lds, G, blk, tid, wid, lane);
#endif
        SEAM(0); }
#ifdef EXTRA_SYNCS
    for (int es_ = 0; es_ < EXTRA_SYNCS; ++es_) xcd_barrier(bar);
#endif
    if (IN(1)) for (int rep_ = 0; rep_ < NREP(1); ++rep_) { if (rep_) xcd_barrier(bar);
#ifndef OFF_P1
        phase1(a, lds, G, blk, tid, wid, lane);
#endif
        SEAM(1); }
    if (IN(2)) for (int rep_ = 0; rep_ < NREP(2); ++rep_) { if (rep_) xcd_barrier(bar);
#ifndef OFF_P2
        pg8::Gemm g{(const bf16_t*)(a.ws + WS_HB), (const bf16_t*)(a.ws + WS_WIN), MTOK, NP, DM}; pg8::StaticOrder S; S.init(MTOK, NP, G, blk);
        pg8::EpiProj E{(bf16_t*)(a.ws + WS_PROJ), NP, (const float*)(a.ws + WS_BIASP), QSCALE};
        pg8::gemm_phase<pg8::EpiProj, pg8::StaticOrder, true, true>(lds, g, S, E);
#endif
        SEAM(2); }
    if (IN(3)) for (int rep_ = 0; rep_ < NREP(3); ++rep_) { if (rep_) xcd_barrier(bar);
        constexpr int NATT = NB * 3 * (SEQ / 128), NSSM = NB * NCH;
#ifndef OFF_P3A
        for (int L = blk; L < NATT; L += G) { const int qb = L % (SEQ / 128), r = L / (SEQ / 128), kvh = r % 3, b = r / 3; attn_unit(a, lds, b, kvh, qb, tid, wid, lane); }
#endif
#ifndef OFF_P3B
        for (int u = blk; u < NSSM; u += G) ssm_local_unit2(a, lds, u / NCH, u % NCH, wid, lane);
        __syncthreads();
#endif
        SEAM(3); }
    if (IN(4)) for (int rep_ = 0; rep_ < NREP(4); ++rep_) { if (rep_) xcd_barrier(bar);
#ifndef OFF_P4
        phase_carry(a, lds, blk, wid, lane);
#endif
        if (blk < NB * NCH) {
            const bf16_t* proj = (const bf16_t*)(a.ws + WS_PROJ); const size_t tok0 = (size_t)(blk / NCH) * SEQ + 64 * (blk % NCH);
#pragma unroll
            for (int i = 0; i < 8; ++i) { const int id = tid + 512 * i, row = id >> 6, ch = id & 63;
                *(LAS u32x4*)((LAS bf16_t*)(lds + 69632) + row * 520 + ch * 8) = *(const u32x4*)(proj + (tok0 + row) * NP + COL_U + ch * 8); }
        }
        SEAM(4); }
    if (IN(5)) for (int rep_ = 0; rep_ < NREP(5); ++rep_) { if (rep_) xcd_barrier(bar);
#ifndef OFF_P5
        for (int u = blk; u < NB * NCH; u += G) ssm_unit<true>(a, lds, u / NCH, u % NCH, tid, wid, lane, (u + G < NB * NCH) ? u + G : -1);
#endif
        SEAM(5); }
    if (IN(6)) for (int rep_ = 0; rep_ < NREP(6); ++rep_) { if (rep_) xcd_barrier(bar);
#ifndef OFF_P6
        pg8::Gemm g{(const bf16_t*)(a.ws + WS_HB), (const bf16_t*)(a.ws + WS_WOUT), MTOK, DM, DM};
#if MK_FUSE_FINAL
        pg8::OutOrder S{blk};
        pg8::EpiOutFused E{a.in[0], a.out, (const float*)(a.ws + WS_GATE), (const float*)(a.ws + WS_SSQA), a.in[21], (float*)(a.ws + WS_XSLOT), (unsigned*)(a.ws + WS_PCNT), MTOK, DM, SEQ};
        pg8::gemm_phase<pg8::EpiOutFused, pg8::OutOrder, true, true>(lds, g, S, E);
#else
        pg8::StaticOrder S; S.init(MTOK, DM, G, blk);
        pg8::EpiOut E{a.in[0], a.out, (const float*)(a.ws + WS_GATE), (const float*)(a.ws + WS_SSQA), (float*)(a.ws + WS_SSQO), MTOK, DM, SEQ};
        pg8::gemm_phase<pg8::EpiOut, pg8::StaticOrder, true, true>(lds, g, S, E);
#endif
#endif
        SEAM(6); }
    if (IN(7)) {
#if !defined(OFF_P7) && !MK_FUSE_FINAL
        phase_final(a, G, blk, wid, lane);
#endif
    }
#undef IN
#undef SEAM
}

extern "C" void kernel_launch(void* const* d_in, const int* in_sizes, int n_in, void* d_out, int out_size, void* d_ws, size_t ws_size, hipStream_t stream) {
    static int grid = 0;
    if (grid == 0) {
        int dev = 0, cus = 0, per_cu = 0;
        if (n_in != 22 || ws_size < WS_END) { fprintf(stderr, "kernel_launch: unexpected n_in %d / ws_size %zu\n", n_in, ws_size); grid = -1; return; }
        (void)hipGetDevice(&dev); (void)hipDeviceGetAttribute(&cus, hipDeviceAttributeMultiprocessorCount, dev);
        if (hipFuncSetAttribute((const void*)mk_fwd, hipFuncAttributeMaxDynamicSharedMemorySize, LDS_BYTES) != hipSuccess) { fprintf(stderr, "kernel_launch: hipFuncSetAttribute failed\n"); grid = -1; return; }
        if (hipOccupancyMaxActiveBlocksPerMultiprocessor(&per_cu, (const void*)mk_fwd, 512, LDS_BYTES) != hipSuccess || per_cu < 1) { fprintf(stderr, "kernel_launch: occupancy query gave %d\n", per_cu); per_cu = 1; (void)hipGetLastError(); }
        grid = cus * per_cu;
        while (grid > 0 && (MTOK % grid != 0 || SEQ % (MTOK / grid) != 0)) --grid;
    }
    if (grid <= 0) return;
#if MK_FUSE_FINAL
    if (grid != 256) { fprintf(stderr, "kernel_launch: the fused final-norm epilogue needs a 256-workgroup grid, got %d\n", grid); return; }
#endif
    (void)hipMemsetAsync((unsigned char*)d_ws + WS_BAR, 0, 16384 + 32768, stream);
    Args a{};
    for (int i = 0; i < 22; ++i) a.in[i] = (const float*)d_in[i];
    a.out = (float*)d_out; a.ws = (unsigned char*)d_ws;
#if MK_ONE_LAUNCH
    a.ph_lo = 0; a.ph_hi = NPHASE;
    void* args[] = {&a};
    hipError_t e = hipLaunchCooperativeKernel((const void*)mk_fwd, dim3(grid), dim3(512), args, LDS_BYTES, stream);
    if (e != hipSuccess) fprintf(stderr, "cooperative launch failed: %s (grid %d)\n", hipGetErrorString(e), grid);
#else
    for (int p = 0; p < NPHASE; ++p) { a.ph_lo = p; a.ph_hi = p + 1; hipLaunchKernelGGL(mk_fwd, dim3(grid), dim3(512), LDS_BYTES, stream, a); }
#endif
}
```
